# Optimizing an MI355X kernel written in HIP

```python
import math
import jax
import jax.numpy as jnp
from jax import lax
import numpy as np

D_MODEL = 1024
BATCH = 16
SEQ = 256
DEPTH = 4
DEC_BATCH = 2
DEC_SEQ = 4096
PAST_LEN = 512

GRID_W = 64
N_MIXERS = 3
CHUNK = 64
SHORT_CONV = 3
NORM_EPS = 1e-6
D_FF = 2816

SSM_DI = 2 * D_MODEL
SSM_HEADDIM = 64
SSM_HEADS = SSM_DI // SSM_HEADDIM
SSM_GROUPS = 8
SSM_HPG = SSM_HEADS // SSM_GROUPS
SSM_STATE = 128
SSM_GN = SSM_GROUPS * SSM_STATE
SSM_CONV_DIM = SSM_DI + 2 * SSM_GN
SSM_PROJ = SSM_DI + SSM_CONV_DIM + 2 * SSM_HEADS

GLA_HEADS = 4
GLA_K = D_MODEL // 2
GLA_V = D_MODEL
GLA_DK = GLA_K // GLA_HEADS
GLA_DV = GLA_V // GLA_HEADS
GLA_RANK = 16
GLA_NORMALIZER = 16.0
GLA_PROJ = 2 * GLA_K + 2 * GLA_V

GDN_HEADS = 8
GDN_DK = 128
GDN_DV = 256
GDN_K = GDN_HEADS * GDN_DK
GDN_V = GDN_HEADS * GDN_DV
GDN_CONV_DIM = 2 * GDN_K + GDN_V
GDN_PROJ = GDN_CONV_DIM + GDN_V + 4 * GDN_HEADS

N_SSM_LAYERS = (DEPTH + N_MIXERS - 1) // N_MIXERS
N_GLA_LAYERS = (DEPTH + N_MIXERS - 2) // N_MIXERS
N_GDN_LAYERS = DEPTH // N_MIXERS

kernel_name = 'bidir_hybrid_ssd_gla_gdn_prefix_step'


def rmsnorm(x, w):
    xf = x.astype(jnp.float32)
    y = xf * lax.rsqrt(jnp.mean(xf * xf, axis=-1, keepdims=True) + NORM_EPS)
    return (y * w.astype(jnp.float32)).astype(x.dtype)


def l2norm(x):
    xf = x.astype(jnp.float32)
    return xf * lax.rsqrt(jnp.sum(xf * xf, axis=-1, keepdims=True) + 1e-6)


def modulate(x, norm_w, shift, scale):
    return rmsnorm(x, norm_w) * (1.0 + scale[:, None]) + shift[:, None]


def dwconv1d(x, w, b=None):
    k, L = w.shape[0], x.shape[1]
    pad = k // 2
    xp = jnp.pad(x, ((0, 0), (pad, k - 1 - pad), (0, 0)))
    y = xp[:, 0:L] * w[0]
    for i in range(1, k):
        y = y + xp[:, i:i + L] * w[i]
    return y if b is None else y + b


def dwconv2d_grid(x, w, b):
    bsz, L, C = x.shape
    rows = L // GRID_W
    img = x.reshape(bsz, rows, GRID_W, C)
    y = lax.conv_general_dilated(img, w[:, :, None, :].astype(x.dtype), (1, 1), 'SAME',
                                 dimension_numbers=('NHWC', 'HWIO', 'NHWC'), feature_group_count=C)
    return y.reshape(bsz, L, C) + b


def _chunk(t, nc):
    return t.reshape(t.shape[0], nc, CHUNK, *t.shape[2:])


def _bidir(scan_fn, fwd_inputs, bwd_inputs, h0):
    y_f, s_f = scan_fn(*fwd_inputs, h0[:, 0])
    y_b, s_b = scan_fn(*(jnp.flip(t, axis=1) for t in bwd_inputs), h0[:, 1])
    return y_f + jnp.flip(y_b, axis=1), jnp.stack([s_f, s_b], axis=1)


def ssd_chunked(xv, loga, bm, cm, h0):
    f32 = jnp.float32
    bsz, L = xv.shape[:2]
    nc = L // CHUNK
    xv, loga, bm, cm = (_chunk(t.astype(f32), nc) for t in (xv, loga, bm, cm))
    causal = jnp.tril(jnp.ones((CHUNK, CHUNK), dtype=bool))
    cs = jnp.cumsum(loga, axis=2)
    seg = cs[:, :, :, None] - cs[:, :, None, :]
    decay = jnp.exp(jnp.where(causal[:, :, None, None], seg, -jnp.inf))
    scores = jnp.einsum('bcign,bcjgn->bcijg', cm, bm)
    y_intra = jnp.einsum('bcijgr,bcjgrp->bcigrp', scores[..., None] * decay, xv)
    xw = xv * jnp.exp(cs[:, :, -1:] - cs)[..., None]

    def step(h, inp):
        cm_c, bm_c, xw_c, cs_c = inp
        y_c = jnp.einsum('bign,bgrnp->bigrp', cm_c, h) * jnp.exp(cs_c)[..., None]
        h = h * jnp.exp(cs_c[:, -1])[..., None, None] + jnp.einsum('bjgn,bjgrp->bgrnp', bm_c, xw_c)
        return h, y_c

    h_last, y_inter = lax.scan(step, h0.astype(f32), tuple(jnp.moveaxis(t, 1, 0) for t in (cm, bm, xw, cs)))
    y = y_intra + jnp.moveaxis(y_inter, 0, 1)
    return y.reshape(bsz, L, *y.shape[3:]), h_last


def gla_chunked(q, k, v, logg, h0):
    f32 = jnp.float32
    bsz, L = q.shape[:2]
    nc = L // CHUNK
    q, k, v, logg = (_chunk(t.astype(f32), nc) for t in (q, k, v, logg))
    causal = jnp.tril(jnp.ones((CHUNK, CHUNK), dtype=bool))
    cs = jnp.cumsum(logg, axis=2)
    qg = q * jnp.exp(cs)
    kg = k * jnp.exp(-cs)
    scores = jnp.where(causal[:, :, None], jnp.einsum('bcihd,bcjhd->bcijh', qg, kg), 0.0)
    y_intra = jnp.einsum('bcijh,bcjhe->bcihe', scores, v)
    kw = k * jnp.exp(cs[:, :, -1:] - cs)

    def step(s, inp):
        qg_c, kw_c, v_c, cs_c = inp
        y_c = jnp.einsum('bihd,bhde->bihe', qg_c, s)
        s = s * jnp.exp(cs_c[:, -1])[..., None] + jnp.einsum('bjhd,bjhe->bhde', kw_c, v_c)
        return s, y_c

    s_last, y_inter = lax.scan(step, h0.astype(f32), tuple(jnp.moveaxis(t, 1, 0) for t in (qg, kw, v, cs)))
    y = y_intra + jnp.moveaxis(y_inter, 0, 1)
    return y.reshape(bsz, L, *y.shape[3:]), s_last


def gated_delta_chunked(q, k, v, beta, logg, h0):
    f32 = jnp.float32
    bsz, L = q.shape[:2]
    nc = L // CHUNK
    q, k, v, beta, logg = (_chunk(t.astype(f32), nc) for t in (q, k, v, beta, logg))
    incl = jnp.tril(jnp.ones((CHUNK, CHUNK), dtype=bool))
    strict = jnp.tril(jnp.ones((CHUNK, CHUNK), dtype=bool), -1)
    eye = jnp.eye(CHUNK, dtype=f32)
    cs = jnp.cumsum(logg, axis=2)
    seg = cs[:, :, :, None] - cs[:, :, None, :]
    lmask = jnp.moveaxis(jnp.exp(jnp.where(incl[:, :, None], seg, -jnp.inf)), -1, 2)
    kb = k * beta[..., None]
    m = jnp.where(strict, jnp.einsum('bcihd,bcjhd->bchij', kb, k) * lmask, 0.0)
    t_inv = lax.linalg.triangular_solve(m + eye, jnp.broadcast_to(eye, m.shape),
                                        left_side=True, lower=True, unit_diagonal=True)
    u = jnp.einsum('bchij,bcjhe->bcihe', t_inv, v * beta[..., None])
    wk = jnp.einsum('bchij,bcjhd->bcihd', t_inv, kb * jnp.exp(cs)[..., None])
    a_intra = jnp.einsum('bcihd,bcjhd->bchij', q, k) * lmask
    qd = q * jnp.exp(cs)[..., None]
    kd = k * jnp.exp(cs[:, :, -1:] - cs)[..., None]

    def step(s, inp):
        qd_c, kd_c, u_c, w_c, a_c, cs_c = inp
        v_new = u_c - jnp.einsum('bihd,bhde->bihe', w_c, s)
        o_c = jnp.einsum('bihd,bhde->bihe', qd_c, s) + jnp.einsum('bhij,bjhe->bihe', a_c, v_new)
        s = s * jnp.exp(cs_c[:, -1])[..., None, None] + jnp.einsum('bjhd,bjhe->bhde', kd_c, v_new)
        return s, o_c

    s_last, o = lax.scan(step, h0.astype(f32),
                         tuple(jnp.moveaxis(t, 1, 0) for t in (qd, kd, u, wk, a_intra, cs)))
    o = jnp.moveaxis(o, 0, 1)
    return o.reshape(bsz, L, *o.shape[3:]), s_last


def mamba2_mixer(h, in_w, conv_w, conv_b, dt_bias, a_log, d_skip, norm_w, out_w, h0):
    bsz, L, _ = h.shape
    G, R, N, P = SSM_GROUPS, SSM_HPG, SSM_STATE, SSM_HEADDIM
    z, xbc, dt_raw = jnp.split(h @ in_w, [SSM_DI, SSM_DI + SSM_CONV_DIM], axis=-1)
    xbc = jax.nn.silu(dwconv1d(xbc, conv_w, conv_b))
    xs, bm, cm = jnp.split(xbc, [SSM_DI, SSM_DI + SSM_GN], axis=-1)
    xs = xs.reshape(bsz, L, G, R, P)
    bm = bm.reshape(bsz, L, G, N)
    cm = cm.reshape(bsz, L, G, N)
    dt = jax.nn.softplus((dt_raw.reshape(bsz, L, 2, SSM_HEADS) + dt_bias).astype(jnp.float32))
    dt = dt.reshape(bsz, L, 2, G, R)
    loga = dt * (-jnp.exp(a_log.astype(jnp.float32))).reshape(2, G, R)
    if h0 is None:
        h0 = jnp.zeros((bsz, 2, SSM_HEADS, N, P), jnp.float32)
    h0 = h0.reshape(bsz, 2, G, R, N, P)
    y, state = _bidir(ssd_chunked,
                      (xs * dt[:, :, 0][..., None], loga[:, :, 0], bm, cm),
                      (xs * dt[:, :, 1][..., None], loga[:, :, 1], bm, cm), h0)
    y = (y + xs * d_skip.reshape(G, R, 1)).reshape(bsz, L, SSM_DI).astype(h.dtype) * jax.nn.silu(z)
    y = rmsnorm(y.reshape(bsz, L, G, SSM_DI // G), norm_w.reshape(G, SSM_DI // G)).reshape(bsz, L, SSM_DI)
    return y @ out_w, state.reshape(bsz, 2, SSM_HEADS, N, P).astype(h.dtype)


def gla_mixer(h, in_w, gate_w1, gate_w2, gate_b, norm_w, out_w, h0):
    bsz, L, _ = h.shape
    q, k, v, r = jnp.split(h @ in_w, [GLA_K, 2 * GLA_K, 2 * GLA_K + GLA_V], axis=-1)
    q = q.reshape(bsz, L, GLA_HEADS, GLA_DK) * GLA_DK ** -0.5
    k = k.reshape(bsz, L, GLA_HEADS, GLA_DK)
    v = v.reshape(bsz, L, GLA_HEADS, GLA_DV)
    gate_lr = jnp.einsum('bld,edr->bler', h, gate_w1)
    gate_logit = jnp.einsum('bler,erk->blek', gate_lr, gate_w2) + gate_b
    logg = jax.nn.log_sigmoid(gate_logit.astype(jnp.float32)) / GLA_NORMALIZER
    logg = logg.reshape(bsz, L, 2, GLA_HEADS, GLA_DK)
    if h0 is None:
        h0 = jnp.zeros((bsz, 2, GLA_HEADS, GLA_DK, GLA_DV), jnp.float32)
    o, state = _bidir(gla_chunked, (q, k, v, logg[:, :, 0]), (q, k, v, logg[:, :, 1]), h0)
    o = rmsnorm(o.astype(h.dtype), norm_w) * jax.nn.silu(r.reshape(bsz, L, GLA_HEADS, GLA_DV))
    return o.reshape(bsz, L, GLA_V) @ out_w, state.astype(h.dtype)


def gdn_mixer(h, in_w, conv_w, dt_bias, a_log, norm_w, out_w, h0):
    bsz, L, _ = h.shape
    qkv, z, a_raw, b_raw = jnp.split(h @ in_w, [GDN_CONV_DIM, GDN_CONV_DIM + GDN_V,
                                                GDN_CONV_DIM + GDN_V + 2 * GDN_HEADS], axis=-1)
    qkv = jax.nn.silu(dwconv1d(qkv, conv_w))
    q, k, v = jnp.split(qkv, [GDN_K, 2 * GDN_K], axis=-1)
    q = l2norm(q.reshape(bsz, L, GDN_HEADS, GDN_DK)) * GDN_DK ** -0.5
    k = l2norm(k.reshape(bsz, L, GDN_HEADS, GDN_DK))
    v = v.reshape(bsz, L, GDN_HEADS, GDN_DV)
    beta = jax.nn.sigmoid(b_raw.reshape(bsz, L, 2, GDN_HEADS).astype(jnp.float32))
    logg = -jnp.exp(a_log.astype(jnp.float32)) * jax.nn.softplus(
        (a_raw.reshape(bsz, L, 2, GDN_HEADS) + dt_bias).astype(jnp.float32))
    if h0 is None:
        h0 = jnp.zeros((bsz, 2, GDN_HEADS, GDN_DK, GDN_DV), jnp.float32)
    o, state = _bidir(gated_delta_chunked, (q, k, v, beta[:, :, 0], logg[:, :, 0]),
                      (q, k, v, beta[:, :, 1], logg[:, :, 1]), h0)
    o = rmsnorm(o.astype(h.dtype), norm_w) * jax.nn.silu(z.reshape(bsz, L, GDN_HEADS, GDN_DV))
    return o.reshape(bsz, L, GDN_V) @ out_w, state.astype(h.dtype)


def conv_glu(h, in_w, conv_w, conv_b, out_w, on_grid):
    a, v = jnp.split(h @ in_w, 2, axis=-1)
    a = dwconv2d_grid(a, conv_w, conv_b) if on_grid else dwconv1d(a, conv_w[1], conv_b)
    return (jax.nn.silu(a) * v) @ out_w


def run_trunk(x, cond, ssm_state, gla_state, gdn_state, on_grid, w):
    new_ssm, new_gla, new_gdn = [], [], []
    cond_act = jax.nn.silu(cond)
    for i in range(DEPTH):
        mod = cond_act @ w['ada_w'][i] + w['ada_b'][i]
        sh1, sc1, g1, sh2, sc2, g2 = jnp.split(mod, 6, axis=-1)
        h = modulate(x, w['norm_mix_w'][i], sh1, sc1)
        kind, j = i % N_MIXERS, i // N_MIXERS
        if kind == 0:
            y, st = mamba2_mixer(h, w['ssm_in_w'][j], w['ssm_conv_w'][j], w['ssm_conv_b'][j],
                                 w['ssm_dt_bias'][j], w['ssm_a_log'][j], w['ssm_d'][j],
                                 w['ssm_norm_w'][j], w['ssm_out_w'][j],
                                 None if ssm_state is None else ssm_state[:, j])
            new_ssm.append(st)
        elif kind == 1:
            y, st = gla_mixer(h, w['gla_in_w'][j], w['gla_gate_w1'][j], w['gla_gate_w2'][j],
                              w['gla_gate_b'][j], w['gla_norm_w'][j], w['gla_out_w'][j],
                              None if gla_state is None else gla_state[:, j])
            new_gla.append(st)
        else:
            y, st = gdn_mixer(h, w['gdn_in_w'][j], w['gdn_conv_w'][j], w['gdn_dt_bias'][j],
                              w['gdn_a_log'][j], w['gdn_norm_w'][j], w['gdn_out_w'][j],
                              None if gdn_state is None else gdn_state[:, j])
            new_gdn.append(st)
        x = x + g1[:, None] * y
        h = modulate(x, w['norm_ffn_w'][i], sh2, sc2)
        x = x + g2[:, None] * conv_glu(h, w['ffn_in_w'][i], w['ffn_conv_w'][i], w['ffn_conv_b'][i],
                                       w['ffn_out_w'][i], on_grid)
    return (rmsnorm(x, w['final_norm_w']), jnp.stack(new_ssm, axis=1),
            jnp.stack(new_gla, axis=1), jnp.stack(new_gdn, axis=1))


def setup_inputs(seed: int = 0) -> dict:
    key = jax.random.key(seed)
    keys = iter(jax.random.split(key, 48))
    f32 = jnp.float32
    D = D_MODEL
    nA, nB, nC = N_SSM_LAYERS, N_GLA_LAYERS, N_GDN_LAYERS

    def normal(shape, scale):
        return jax.random.normal(next(keys), shape, f32) * scale

    def gain(shape):
        return 1.0 + normal(shape, 0.02)

    def dt_bias(shape):
        dt = jnp.exp(jax.random.uniform(next(keys), shape, f32, math.log(1e-3), math.log(1e-1)))
        return dt + jnp.log(-jnp.expm1(-dt))

    def a_log(shape):
        return jnp.log(jax.random.uniform(next(keys), shape, f32, 1.0, 16.0))

    return {
        'x_prompt': normal((BATCH, SEQ, D), 1.0),
        'x_sample': normal((DEC_BATCH, DEC_SEQ, D), 1.0),
        'state_ssm': normal((DEC_BATCH, nA, 2, SSM_HEADS, SSM_STATE, SSM_HEADDIM), 0.1),
        'state_gla': normal((DEC_BATCH, nB, 2, GLA_HEADS, GLA_DK, GLA_DV), 0.1),
        'state_gdn': normal((DEC_BATCH, nC, 2, GDN_HEADS, GDN_DK, GDN_DV), 0.1),
        'c': normal((DEC_BATCH, D), 1.0),
        'c_ctx': normal((D,), 1.0),
        'norm_mix_w': gain((DEPTH, D)),
        'norm_ffn_w': gain((DEPTH, D)),
        'ada_w': normal((DEPTH, D, 6 * D), 0.5 * D ** -0.5),
        'ada_b': normal((DEPTH, 6 * D), 0.02),
        'ffn_in_w': normal((DEPTH, D, 2 * D_FF), D ** -0.5),
        'ffn_conv_w': normal((DEPTH, 3, 3, D_FF), 1.0 / 3.0),
        'ffn_conv_b': normal((DEPTH, D_FF), 0.02),
        'ffn_out_w': normal((DEPTH, D_FF, D), D_FF ** -0.5),
        'ssm_in_w': normal((nA, D, SSM_PROJ), D ** -0.5),
        'ssm_conv_w': normal((nA, SHORT_CONV, SSM_CONV_DIM), SHORT_CONV ** -0.5),
        'ssm_conv_b': normal((nA, SSM_CONV_DIM), 0.02),
        'ssm_dt_bias': dt_bias((nA, 2, SSM_HEADS)),
        'ssm_a_log': a_log((nA, 2, SSM_HEADS)),
        'ssm_d': gain((nA, SSM_HEADS)),
        'ssm_norm_w': gain((nA, SSM_DI)),
        'ssm_out_w': normal((nA, SSM_DI, D), SSM_DI ** -0.5),
        'gla_in_w': normal((nB, D, GLA_PROJ), D ** -0.5),
        'gla_gate_w1': normal((nB, 2, D, GLA_RANK), D ** -0.5),
        'gla_gate_w2': normal((nB, 2, GLA_RANK, GLA_K), GLA_RANK ** -0.5),
        'gla_gate_b': normal((nB, 2, GLA_K), 0.1),
        'gla_norm_w': gain((nB, GLA_DV)),
        'gla_out_w': normal((nB, GLA_V, D), GLA_V ** -0.5),
        'gdn_in_w': normal((nC, D, GDN_PROJ), D ** -0.5),
        'gdn_conv_w': normal((nC, SHORT_CONV, GDN_CONV_DIM), SHORT_CONV ** -0.5),
        'gdn_dt_bias': dt_bias((nC, 2, GDN_HEADS)),
        'gdn_a_log': a_log((nC, 2, GDN_HEADS)),
        'gdn_norm_w': gain((nC, GDN_DV)),
        'gdn_out_w': normal((nC, GDN_V, D), GDN_V ** -0.5),
        'final_norm_w': gain((D,)),
    }


def reference(x_prompt, x_sample, state_ssm, state_gla, state_gdn, c, c_ctx,
              norm_mix_w, norm_ffn_w, ada_w, ada_b, ffn_in_w, ffn_conv_w, ffn_conv_b, ffn_out_w,
              ssm_in_w, ssm_conv_w, ssm_conv_b, ssm_dt_bias, ssm_a_log, ssm_d, ssm_norm_w, ssm_out_w,
              gla_in_w, gla_gate_w1, gla_gate_w2, gla_gate_b, gla_norm_w, gla_out_w,
              gdn_in_w, gdn_conv_w, gdn_dt_bias, gdn_a_log, gdn_norm_w, gdn_out_w,
              final_norm_w):
    w = dict(norm_mix_w=norm_mix_w, norm_ffn_w=norm_ffn_w, ada_w=ada_w, ada_b=ada_b,
             ffn_in_w=ffn_in_w, ffn_conv_w=ffn_conv_w, ffn_conv_b=ffn_conv_b, ffn_out_w=ffn_out_w,
             ssm_in_w=ssm_in_w, ssm_conv_w=ssm_conv_w, ssm_conv_b=ssm_conv_b, ssm_dt_bias=ssm_dt_bias,
             ssm_a_log=ssm_a_log, ssm_d=ssm_d, ssm_norm_w=ssm_norm_w, ssm_out_w=ssm_out_w,
             gla_in_w=gla_in_w, gla_gate_w1=gla_gate_w1, gla_gate_w2=gla_gate_w2, gla_gate_b=gla_gate_b,
             gla_norm_w=gla_norm_w, gla_out_w=gla_out_w,
             gdn_in_w=gdn_in_w, gdn_conv_w=gdn_conv_w, gdn_dt_bias=gdn_dt_bias, gdn_a_log=gdn_a_log,
             gdn_norm_w=gdn_norm_w, gdn_out_w=gdn_out_w, final_norm_w=final_norm_w)
    cond_ctx = jnp.broadcast_to(c_ctx, (x_prompt.shape[0], c_ctx.shape[0]))
    y_prompt, new_state_ssm, new_state_gla, new_state_gdn = run_trunk(
        x_prompt, cond_ctx, None, None, None, False, w)
    y_sample, _, _, _ = run_trunk(x_sample, c, state_ssm, state_gla, state_gdn, True, w)
    return (y_prompt, y_sample, new_state_ssm, new_state_gla, new_state_gdn)
```

```cpp
#include <hip/hip_runtime.h>
#include <cstdio>

typedef unsigned short bf16_t;
typedef short bf16x8 __attribute__((ext_vector_type(8)));
typedef float f32x4 __attribute__((ext_vector_type(4)));
typedef unsigned u32x2 __attribute__((ext_vector_type(2)));
typedef unsigned u32x4 __attribute__((ext_vector_type(4)));

#define NT 512
#define CH_BARRIER() do { asm volatile("s_waitcnt lgkmcnt(0)" ::: "memory"); __builtin_amdgcn_s_barrier(); asm volatile("" ::: "memory"); } while (0)
#define LAS __attribute__((address_space(3)))
#define T_TOK 12288
#define T_CTX 4096
#define DM 1024
#define DFF 2816
#define EPS 1e-6f

struct P {
  const float *x_prompt, *x_sample, *state_ssm, *state_gla, *state_gdn, *c, *c_ctx;
  const float *norm_mix_w, *norm_ffn_w, *ada_w, *ada_b, *ffn_in_w, *ffn_conv_w, *ffn_conv_b, *ffn_out_w;
  const float *ssm_in_w, *ssm_conv_w, *ssm_conv_b, *ssm_dt_bias, *ssm_a_log, *ssm_d, *ssm_norm_w, *ssm_out_w;
  const float *gla_in_w, *gla_gate_w1, *gla_gate_w2, *gla_gate_b, *gla_norm_w, *gla_out_w;
  const float *gdn_in_w, *gdn_conv_w, *gdn_dt_bias, *gdn_a_log, *gdn_norm_w, *gdn_out_w, *final_norm_w;
  float* out;
  bf16_t *Win, *Wout, *Wfi, *Wfo;
  bf16_t *H;
  bf16_t *Pz, *Pxbc;
  bf16_t *A;
  float *small, *small2, *adap, *mod;
  bf16_t *XT, *Gm, *BT; float* VEC;
  unsigned* bar;
  int wq, pad_;
};

__device__ __forceinline__ bf16_t f2bf(float f) {
  unsigned u = __float_as_uint(f);
  u += 0x7fffu + ((u >> 16) & 1u);
  return (bf16_t)(u >> 16);
}
__device__ __forceinline__ float bf2f(bf16_t b) { return __uint_as_float(((unsigned)b) << 16); }
__device__ __forceinline__ float bflo(unsigned u) { return __uint_as_float(u << 16); }
__device__ __forceinline__ float bfhi(unsigned u) { return __uint_as_float(u & 0xffff0000u); }
__device__ __forceinline__ unsigned cvt2(float a, float b);
__device__ __forceinline__ unsigned pack2(float a, float b) { return cvt2(a, b); }

typedef float f32x2 __attribute__((ext_vector_type(2)));
typedef float f32x16 __attribute__((ext_vector_type(16)));
typedef __bf16 hwbf16x2 __attribute__((ext_vector_type(2)));
__device__ __forceinline__ unsigned cvt2(float a, float b) { f32x2 v = {a, b}; return __builtin_bit_cast(unsigned, __builtin_convertvector(v, hwbf16x2)); }
__device__ __forceinline__ bf16x8 mk8(unsigned a, unsigned b, unsigned c, unsigned d) { u32x4 u = {a, b, c, d}; return __builtin_bit_cast(bf16x8, u); }
#define MFMA32(a, b, c) __builtin_amdgcn_mfma_f32_32x32x16_bf16((a), (b), (c), 0, 0, 0)
__device__ __forceinline__ int kperm(int k) { const int g4 = (k >> 2) & 3; return (k & ~12) | ((((g4 & 1) << 1) | (g4 >> 1)) << 2); }
__device__ __forceinline__ bf16x8 pack_half(const f32x16& x, int half) {
  return half == 0 ? mk8(cvt2(x[0], x[1]), cvt2(x[2], x[3]), cvt2(x[4], x[5]), cvt2(x[6], x[7]))
                   : mk8(cvt2(x[8], x[9]), cvt2(x[10], x[11]), cvt2(x[12], x[13]), cvt2(x[14], x[15]));
}
__device__ __forceinline__ float silu_f(float x) { return x * __builtin_amdgcn_rcpf(1.f + __expf(-x)); }
__device__ __forceinline__ float softplus_f(float x) { return fmaxf(x, 0.f) + log1pf(__expf(-fabsf(x))); }
__device__ __forceinline__ float sigmoid_f(float x) { return __builtin_amdgcn_rcpf(1.f + __expf(-x)); }
__device__ __forceinline__ float softplus_fast(float x) { return fmaxf(x, 0.f) + __logf(1.f + __expf(-fabsf(x))); }
__device__ __forceinline__ float dpp_row_shr(float v, int n) {
  const int iv = __builtin_bit_cast(int, v); int r;
  switch (n) { case 1: r = __builtin_amdgcn_update_dpp(0, iv, 0x111, 0xf, 0xf, true); break; case 2: r = __builtin_amdgcn_update_dpp(0, iv, 0x112, 0xf, 0xf, true); break;
               case 4: r = __builtin_amdgcn_update_dpp(0, iv, 0x114, 0xf, 0xf, true); break; default: r = __builtin_amdgcn_update_dpp(0, iv, 0x118, 0xf, 0xf, true); break; }
  return __builtin_bit_cast(float, r);
}
__device__ __forceinline__ float wave_scan_incl(float v) {
  v += dpp_row_shr(v, 1); v += dpp_row_shr(v, 2); v += dpp_row_shr(v, 4); v += dpp_row_shr(v, 8);
  v += __builtin_bit_cast(float, __builtin_amdgcn_update_dpp(0, __builtin_bit_cast(int, v), 0x142, 0xa, 0xf, false));
  v += __builtin_bit_cast(float, __builtin_amdgcn_update_dpp(0, __builtin_bit_cast(int, v), 0x143, 0xc, 0xf, false));
  return v;
}
__device__ __forceinline__ float row16_allsum(float v) {
  v += __builtin_bit_cast(float, __builtin_amdgcn_update_dpp(0, __builtin_bit_cast(int, v), 0xB1, 0xf, 0xf, false));
  v += __builtin_bit_cast(float, __builtin_amdgcn_update_dpp(0, __builtin_bit_cast(int, v), 0x4E, 0xf, 0xf, false));
  v += __builtin_bit_cast(float, __builtin_amdgcn_update_dpp(0, __builtin_bit_cast(int, v), 0x141, 0xf, 0xf, false));
  v += __builtin_bit_cast(float, __builtin_amdgcn_update_dpp(0, __builtin_bit_cast(int, v), 0x140, 0xf, 0xf, false));
  return v;
}
__device__ __forceinline__ float xor16_sum(float x) {
  const auto r = __builtin_amdgcn_permlane16_swap(__builtin_bit_cast(unsigned, x), __builtin_bit_cast(unsigned, x), false, false);
  return __builtin_bit_cast(float, r[0]) + __builtin_bit_cast(float, r[1]);
}
__device__ __forceinline__ float xor32_sum(float x) {
  const auto r = __builtin_amdgcn_permlane32_swap(__builtin_bit_cast(unsigned, x), __builtin_bit_cast(unsigned, x), false, false);
  return __builtin_bit_cast(float, r[0]) + __builtin_bit_cast(float, r[1]);
}
__device__ __forceinline__ float wave_sum(float v) {
  v += dpp_row_shr(v, 1); v += dpp_row_shr(v, 2); v += dpp_row_shr(v, 4); v += dpp_row_shr(v, 8);
  v += __builtin_bit_cast(float, __builtin_amdgcn_update_dpp(0, __builtin_bit_cast(int, v), 0x142, 0xa, 0xf, false));
  v += __builtin_bit_cast(float, __builtin_amdgcn_update_dpp(0, __builtin_bit_cast(int, v), 0x143, 0xc, 0xf, false));
  return __builtin_bit_cast(float, __builtin_amdgcn_readlane(__builtin_bit_cast(int, v), 63));
}
__device__ __forceinline__ int tidw(int wq) { int l; asm volatile("v_mbcnt_lo_u32_b32 %0, -1, 0\n\tv_mbcnt_hi_u32_b32 %0, -1, %0" : "=v"(l)); return (wq << 6) | l; }
__device__ __forceinline__ void tok_info(int t, int& t0, int& L, int& cond) {
  if (t < T_CTX) { t0 = t & ~255; L = 256; cond = 0; }
  else { int b = (t - T_CTX) >> 12; t0 = T_CTX + (b << 12); L = 4096; cond = 1 + b; }
}

__device__ __forceinline__ void convert_wt(const float* __restrict__ W, int K, int N, bf16_t* __restrict__ Wt, int row0, int ncover, float* tile  , int wq, int bid, int nb) {
  const int tk = K / 64, tn = ncover / 64, ntile = tk * tn;
  const int tid = tidw(wq);
  const int r = tid >> 4, c4 = (tid & 15) * 4;
  for (int ti0 = bid * 4; ti0 < ntile; ti0 += nb * 4) {
    f32x4 v[4][2];
#pragma unroll
    for (int u = 0; u < 4; ++u) {
      const int ti = ti0 + u, kt = ti % tk, nt = ti / tk;
#pragma unroll
      for (int h = 0; h < 2; ++h) {
        const int k = kt * 64 + r + h * 32, n = nt * 64 + c4;
        v[u][h] = (f32x4){0.f, 0.f, 0.f, 0.f};
        if (ti < ntile && n < N) v[u][h] = *(const f32x4*)(W + (size_t)k * N + n);
      }
    }
#pragma unroll
    for (int u = 0; u < 4; ++u) {
      float* tl = tile + u * (64 * 65);
#pragma unroll
      for (int h = 0; h < 2; ++h) { float* d = tl + (r + h * 32) * 65 + c4; d[0] = v[u][h][0]; d[1] = v[u][h][1]; d[2] = v[u][h][2]; d[3] = v[u][h][3]; }
    }
    __syncthreads();
#pragma unroll
    for (int u = 0; u < 4; ++u) {
      const int ti = ti0 + u, kt = ti % tk, nt = ti / tk;
      if (ti < ntile) {
        const float* tl = tile + u * (64 * 65);
        const int n = tid >> 3, k8 = (tid & 7) * 8;
        u32x4 o;
        o[0] = pack2(tl[(k8 + 0) * 65 + n], tl[(k8 + 1) * 65 + n]);
        o[1] = pack2(tl[(k8 + 2) * 65 + n], tl[(k8 + 3) * 65 + n]);
        o[2] = pack2(tl[(k8 + 4) * 65 + n], tl[(k8 + 5) * 65 + n]);
        o[3] = pack2(tl[(k8 + 6) * 65 + n], tl[(k8 + 7) * 65 + n]);
        *(u32x4*)(Wt + (size_t)(row0 + nt * 64 + n) * K + kt * 64 + k8) = o;
      }
    }
    __syncthreads();
  }
}

__device__ __forceinline__ void ph_convert(const P& p, int layer, int which, float* tile, int bid, int nb) {
  const int kind = layer % 3, j = layer / 3;
  if (kind == 0) {
    if (which & 1) convert_wt(p.ssm_in_w + (size_t)j * 1024 * 6208, 1024, 6208, p.Win, 0, 6400, tile, p.wq, bid, nb);
    if (which & 2) convert_wt(p.ssm_out_w + (size_t)j * 2048 * 1024, 2048, 1024, p.Wout, 0, 1024, tile, p.wq, bid, nb);
  } else if (kind == 1) {
    if (which & 1) {
      convert_wt(p.gla_in_w, 1024, 3072, p.Win, 0, 3072, tile, p.wq, bid, nb);
      {
        const int tid_ = tidw(p.wq);
        for (int it = bid * NT + tid_; it < 1024 * 128; it += nb * NT) {
          const int n = it >> 7, k8 = (it & 127) * 8, e = n >> 9, kk = n & 511;
          float w2c[16];
#pragma unroll
          for (int r = 0; r < 16; ++r) w2c[r] = p.gla_gate_w2[(size_t)e * 16 * 512 + r * 512 + kk];
          float o[8];
#pragma unroll
          for (int q = 0; q < 8; ++q) {
            const float* w1 = p.gla_gate_w1 + ((size_t)e * 1024 + k8 + q) * 16;
            const f32x4 a0 = *(const f32x4*)(w1), a1 = *(const f32x4*)(w1 + 4), a2 = *(const f32x4*)(w1 + 8), a3 = *(const f32x4*)(w1 + 12);
            o[q] = (a0[0] * w2c[0] + a0[1] * w2c[1] + a0[2] * w2c[2] + a0[3] * w2c[3]) + (a1[0] * w2c[4] + a1[1] * w2c[5] + a1[2] * w2c[6] + a1[3] * w2c[7])
                 + (a2[0] * w2c[8] + a2[1] * w2c[9] + a2[2] * w2c[10] + a2[3] * w2c[11]) + (a3[0] * w2c[12] + a3[1] * w2c[13] + a3[2] * w2c[14] + a3[3] * w2c[15]);
          }
          u32x4 ov = {pack2(o[0], o[1]), pack2(o[2], o[3]), pack2(o[4], o[5]), pack2(o[6], o[7])};
          *(u32x4*)(p.Win + (size_t)(3072 + n) * 1024 + k8) = ov;
        }
      }
    }
    if (which & 2) convert_wt(p.gla_out_w, 1024, 1024, p.Wout, 0, 1024, tile, p.wq, bid, nb);
  } else {
    if (which & 1) convert_wt(p.gdn_in_w, 1024, 6176, p.Win, 0, 6400, tile, p.wq, bid, nb);
    if (which & 2) convert_wt(p.gdn_out_w, 2048, 1024, p.Wout, 0, 1024, tile, p.wq, bid, nb);
  }
  if (which & (4 | 8)) convert_wt(p.ffn_in_w + (size_t)layer * 1024 * 5632, 1024, 5632, p.Wfi, 0, 5632, tile, p.wq, bid, nb);
  if (which & (4 | 16)) convert_wt(p.ffn_out_w + (size_t)layer * 2816 * 1024, 2816, 1024, p.Wfo, 0, 1024, tile, p.wq, bid, nb);
}

__device__ __forceinline__ void ph_ada_partial(const P& p) {
  const int gtid = blockIdx.x * NT + tidw(p.wq), gsz = gridDim.x * NT;
  for (int it = gtid; it < 4 * 16 * 1536; it += gsz) {
    const int n4 = it % 1536, kp = (it / 1536) & 15, l = it / (1536 * 16);
    const float* w = p.ada_w + (size_t)l * 1024 * 6144 + (size_t)(kp * 64) * 6144 + n4 * 4;
    f32x4 a0 = {0.f, 0.f, 0.f, 0.f}, a1 = a0, a2 = a0;
#pragma unroll 8
    for (int k = 0; k < 64; ++k) {
      const int kk = kp * 64 + k;
      const float c0 = silu_f(p.c_ctx[kk]), c1 = silu_f(p.c[kk]), c2 = silu_f(p.c[1024 + kk]);
      const f32x4 wv = *(const f32x4*)(w + (size_t)k * 6144);
      a0 += c0 * wv; a1 += c1 * wv; a2 += c2 * wv;
    }
    float* d = p.adap + ((size_t)(kp * 4 + l) * 3) * 6144 + n4 * 4;
    *(f32x4*)(d) = a0; *(f32x4*)(d + 6144) = a1; *(f32x4*)(d + 2 * 6144) = a2;
  }
}
__device__ __forceinline__ void ph_ada_reduce(const P& p) {
  const int gtid = blockIdx.x * NT + tidw(p.wq), gsz = gridDim.x * NT;
  for (int it = gtid; it < 4 * 3 * 6144; it += gsz) {
    const int n = it % 6144, lc = it / 6144, l = lc / 3;
    float s = p.ada_b[l * 6144 + n];
#pragma unroll
    for (int kp = 0; kp < 16; ++kp) s += p.adap[(size_t)(kp * 12 + lc) * 6144 + n];
    p.mod[it] = s;
  }
}
__device__ __forceinline__ void ph_ada_direct(const P& p, int l_lo, int l_hi, unsigned char* shm, int bid, int nb) {
  const int tid = tidw(p.wq), part = tid >> 3, l8 = tid & 7;
  float* red = (float*)shm;
  const int nitem = (l_hi - l_lo) * 192;
  for (int item = bid; item < nitem; item += nb) {
    const int l = l_lo + item / 192, cg = item % 192;
    const float* w = p.ada_w + ((size_t)l * 1024 + part * 16) * 6144 + cg * 32 + l8 * 4;
    f32x4 wv[16];
#pragma unroll
    for (int k = 0; k < 16; ++k) wv[k] = *(const f32x4*)(w + (size_t)k * 6144);
    f32x4 a0 = {0.f, 0.f, 0.f, 0.f}, a1 = a0, a2 = a0;
#pragma unroll
    for (int k = 0; k < 16; ++k) {
      const int kk = part * 16 + k;
      const float c0 = silu_f(p.c_ctx[kk]), c1 = silu_f(p.c[kk]), c2 = silu_f(p.c[1024 + kk]);
      a0 += c0 * wv[k]; a1 += c1 * wv[k]; a2 += c2 * wv[k];
    }
    float* r = red + (part * 3) * 32 + l8 * 4;
    *(f32x4*)(r) = a0; *(f32x4*)(r + 32) = a1; *(f32x4*)(r + 64) = a2;
    __syncthreads();
    if (tid < 96) {
      const int cond = tid >> 5, n = tid & 31;
      float sacc = p.ada_b[l * 6144 + cg * 32 + n];
#pragma unroll 16
      for (int q = 0; q < 64; ++q) sacc += red[(q * 3 + cond) * 32 + n];
      p.mod[((size_t)l * 3 + cond) * 6144 + cg * 32 + n] = sacc;
    }
    __syncthreads();
  }
}
__device__ __forceinline__ void ph_copy_x(const P& p) {
  const int gtid = blockIdx.x * NT + tidw(p.wq), gsz = gridDim.x * NT;
  const int n1 = T_CTX * DM / 4, n2 = T_TOK * DM / 4;
  f32x4* o = (f32x4*)p.out;
  for (int i = gtid; i < n2; i += gsz) o[i] = (i < n1) ? ((const f32x4*)p.x_prompt)[i] : ((const f32x4*)p.x_sample)[i - n1];
}

template <bool FROM_INPUT>
__device__ __forceinline__ void ph_norm_mod(const P& p, const float* __restrict__ nw, const float* __restrict__ modl  , int sh_off, int sc_off, bf16_t* __restrict__ hout) {
  const int wave = tidw(p.wq) >> 6, lane = tidw(p.wq) & 63;
  const int gw = blockIdx.x * 8 + wave, nw_ = gridDim.x * 8;
  const float* x = p.out;
  for (int tb = gw; tb < T_TOK; tb += 3 * nw_) {
    f32x4 v[3][4]; float ss[3];
#pragma unroll
    for (int j = 0; j < 3; ++j) {
      const int t = tb + j * nw_; ss[j] = 0.f;
      if (t < T_TOK) {
        const float* xr = FROM_INPUT ? ((t < T_CTX) ? p.x_prompt + (size_t)t * DM : p.x_sample + (size_t)(t - T_CTX) * DM) : x + (size_t)t * DM;
#pragma unroll
        for (int i = 0; i < 4; ++i) v[j][i] = *(const f32x4*)(xr + i * 256 + lane * 4);
      }
    }
#pragma unroll
    for (int j = 0; j < 3; ++j) {
      const int t = tb + j * nw_;
      if (t < T_TOK) {
#pragma unroll
        for (int i = 0; i < 4; ++i) { ss[j] += v[j][i][0] * v[j][i][0] + v[j][i][1] * v[j][i][1] + v[j][i][2] * v[j][i][2] + v[j][i][3] * v[j][i][3];
          if (FROM_INPUT) *(f32x4*)(p.out + (size_t)t * DM + i * 256 + lane * 4) = v[j][i]; }
      }
    }
#pragma unroll
    for (int j = 0; j < 3; ++j) {
      const int t = tb + j * nw_;
      if (t < T_TOK) {
        int t0, L, cond; tok_info(t, t0, L, cond);
        const float rstd = rsqrtf(wave_sum(ss[j]) * (1.f / DM) + EPS);
        const float* mr = modl + cond * 6144;
#pragma unroll
        for (int i = 0; i < 4; ++i) {
          const int d = i * 256 + lane * 4;
          const f32x4 w = *(const f32x4*)(nw + d), sc = *(const f32x4*)(mr + sc_off + d), sh = *(const f32x4*)(mr + sh_off + d);
          float o0 = v[j][i][0] * rstd * w[0] * (1.f + sc[0]) + sh[0];
          float o1 = v[j][i][1] * rstd * w[1] * (1.f + sc[1]) + sh[1];
          float o2 = v[j][i][2] * rstd * w[2] * (1.f + sc[2]) + sh[2];
          float o3 = v[j][i][3] * rstd * w[3] * (1.f + sc[3]) + sh[3];
          u32x2 o; o[0] = pack2(o0, o1); o[1] = pack2(o2, o3);
          *(u32x2*)(hout + (size_t)t * DM + d) = o;
        }
      }
    }
  }
}

namespace pg8 {
#define PG8_LAS __attribute__((address_space(3)))
typedef unsigned short bf16_t;
typedef short bf16x8 __attribute__((ext_vector_type(8)));
typedef float f32x4 __attribute__((ext_vector_type(4)));
typedef unsigned u32x4 __attribute__((ext_vector_type(4)));
constexpr int BM = 256, BK = 64, HALF = 128, HTB = HALF * BK * 2  , STAGE_BYTES = 8 * HTB, NXCD = 8, WGM = 8;

__host__ __device__ __forceinline__ int lds_byte(int r, int c) { const int st = (r >> 4) * 2 + (c >> 5), rr = r & 15, cc = c & 31, ob = rr * 64 + cc * 2; return st * 1024 + (ob ^ (((ob >> 9) & 1) << 5)); }
__host__ __device__ __forceinline__ void stage_rc(int b, int& R, int& C) { const int st = b / 1024, sb = b % 1024, swz = sb ^ (((sb >> 9) & 1) << 5); R = (st >> 1) * 16 + swz / 64; C = (st & 1) * 32 + (swz % 64) / 2; }
__host__ __device__ __forceinline__ int perm32(int rho) { const int n = rho >> 4, i = rho & 15; return 8 * (i >> 2) + 4 * n + (i & 3); }

struct Unit { int pm, pn; };
struct Gemm { const bf16_t* A; const bf16_t* Bt; int M, N, K; };

struct StaticOrder {
    int nM, nN, nwg, G, c;
    __host__ __device__ void init(int M, int N, int G_, int c_, int bm = BM) { nM = M / bm; nN = N / BM; nwg = nM * nN; G = G_; c = c_; }
    __host__ __device__ bool next(int i, Unit& u) const {
        const long L = (long)i * G + c; if (L >= nwg) return false;
        int wgid = (int)L; { const int q = nwg / NXCD, r = nwg % NXCD, xcd = wgid % NXCD, off = wgid / NXCD; wgid = (xcd < r ? xcd * (q + 1) : r * (q + 1) + (xcd - r) * q) + off; }
        const int nig = WGM * nN, gid = wgid / nig, fm = gid * WGM, gsz = (nM - fm) < WGM ? (nM - fm) : WGM;
        u.pm = fm + ((wgid % nig) % gsz); u.pn = (wgid % nig) / gsz; return true;
    }
    __device__ __forceinline__ void a_ready(const Unit&) const {}
    __device__ __forceinline__ void done(const Unit&) const {}
};
template <class Epi, class Sched, bool ALIGN_EPI = false, bool SP2 = false, int BMR = 256, bool ONE_UNIT = false>
__device__ __forceinline__ void gemm_phase(PG8_LAS unsigned char* lds, const Gemm g, const Sched& S, const Epi& E, const int tid) {
    constexpr int HR = BMR / 2, MF = HR / 32;
    const int wid = __builtin_amdgcn_readfirstlane(tid >> 6), lane = tid & 63, wr = wid >> 2, wc = wid & 3, fr = lane & 15, fq = lane >> 4;
    const int K = g.K, nt = K / BK;
    unsigned voffA[2], voffB[2];
#pragma unroll
    for (int i = 0; i < 2; ++i) { int R, C; stage_rc(tid * 16 + i * 8192, R, C); const int Rb = Epi::PERM ? ((R & ~31) + perm32(R & 31)) : R;
        voffA[i] = (unsigned)(R * K + C) * 2u; voffB[i] = (unsigned)(Rb * K + C) * 2u; }
    const size_t kstep = (size_t)(BK * 2);
    const size_t hstep = (size_t)HALF * K * 2;
    const size_t tstep = 2 * hstep;
    const size_t hstepA = (size_t)HR * K * 2, tstepA = 2 * hstepA;
    const unsigned ldsw = (unsigned)wid * 1024u;
    const int aoff = lds_byte(wr * (HR / 2) + fr, fq * 8), boff = lds_byte(wc * 32 + fr, fq * 8);
#define PG8_SA(b, h) (((b) * 2 + (h)) * HTB)
#define PG8_SB(b, h) ((4 + (b) * 2 + (h)) * HTB)
#define PG8_STAGE(bufoff, gbase, voff) do { _Pragma("unroll") for (int _i = 0; _i < 2; ++_i) \
        __builtin_amdgcn_global_load_lds((const unsigned*)((const char*)(gbase) + (voff)[_i]), (PG8_LAS unsigned*)(lds + (bufoff) + ldsw + _i * 8192), 16, 0, 0); } while (0)
#define PG8_LDA(dst, b, h) do { _Pragma("unroll") for (int m = 0; m < MF; ++m) _Pragma("unroll") for (int k = 0; k < 2; ++k) dst[m][k] = *(const PG8_LAS bf16x8*)(lds + PG8_SA(b, h) + aoff + m * 2048 + k * 1024); } while (0)
#define PG8_LDB(dst, b, h) do { _Pragma("unroll") for (int n = 0; n < 2; ++n) _Pragma("unroll") for (int k = 0; k < 2; ++k) dst[n][k] = *(const PG8_LAS bf16x8*)(lds + PG8_SB(b, h) + boff + n * 2048 + k * 1024); } while (0)
#define PG8_MMA(ai, bj, At, Bt) do { __builtin_amdgcn_s_setprio(1); _Pragma("unroll") for (int m = 0; m < MF; ++m) _Pragma("unroll") for (int n = 0; n < 2; ++n) _Pragma("unroll") for (int k = 0; k < 2; ++k) \
        acc[ai][bj][m][n] = __builtin_amdgcn_mfma_f32_16x16x32_bf16(Bt[n][k], At[m][k], acc[ai][bj][m][n], 0, 0, 0); __builtin_amdgcn_s_setprio(0); } while (0)
#define PG8_WAIT_V(n) asm volatile("s_waitcnt vmcnt(" #n ")" ::: "memory")
#define PG8_WAIT_L(n) asm volatile("s_waitcnt lgkmcnt(" #n ")" ::: "memory")
#define PG8_BAR __builtin_amdgcn_s_barrier()
#define PG8_SCHED __builtin_amdgcn_sched_barrier(0)
    Unit cur, nxt; int ui = 0;
    if (!S.next(0, cur)) return;
    f32x4 acc[2][2][MF][2];
#pragma unroll
    for (int a = 0; a < 2; ++a)
#pragma unroll
        for (int b = 0; b < 2; ++b)
#pragma unroll
            for (int m = 0; m < MF; ++m)
#pragma unroll
                for (int n = 0; n < 2; ++n) acc[a][b][m][n] = (f32x4){0.f, 0.f, 0.f, 0.f};
    bf16x8 At[MF][2], B0[2][2], B1[2][2];
    const char* cA = (const char*)g.A + (size_t)cur.pm * tstepA; const char* cB = (const char*)g.Bt + (size_t)cur.pn * tstep;
    S.a_ready(cur);
    if constexpr (SP2) {
        PG8_STAGE(PG8_SB(0, 0), cB, voffB); PG8_STAGE(PG8_SB(0, 1), cB + hstep, voffB); PG8_STAGE(PG8_SA(0, 0), cA, voffA); PG8_STAGE(PG8_SA(0, 1), cA + hstepA, voffA);
        if (wr == 1) PG8_BAR;
        PG8_WAIT_V(2); PG8_BAR;
        PG8_STAGE(PG8_SB(1, 0), cB + kstep, voffB); PG8_STAGE(PG8_SA(1, 0), cA + kstep, voffA); PG8_STAGE(PG8_SB(1, 1), cB + hstep + kstep, voffB);
        PG8_WAIT_V(6); PG8_BAR;
    } else {
        PG8_STAGE(PG8_SB(0, 0), cB, voffB); PG8_STAGE(PG8_SA(0, 0), cA, voffA); PG8_STAGE(PG8_SB(0, 1), cB + hstep, voffB); PG8_STAGE(PG8_SA(0, 1), cA + hstepA, voffA);
        if (wr == 1) PG8_BAR;
        PG8_WAIT_V(4); PG8_BAR;
        PG8_STAGE(PG8_SB(1, 0), cB + kstep, voffB); PG8_STAGE(PG8_SA(1, 0), cA + kstep, voffA); PG8_STAGE(PG8_SB(1, 1), cB + hstep + kstep, voffB);
        PG8_WAIT_V(6); PG8_BAR;
    }
    for (;;) {
        const bool has_next = ONE_UNIT ? false : S.next(ui + 1, nxt);
        const char* nA = has_next ? (const char*)g.A + (size_t)nxt.pm * tstepA : cA; const char* nB = has_next ? (const char*)g.Bt + (size_t)nxt.pn * tstep : cB;
        for (int t = 0; t < nt; t += 2) {
            const bool last = (t == nt - 2);
            const char* a1 = cA + (size_t)(t + 1) * kstep;
            const char* a2 = last ? nA : cA + (size_t)(t + 2) * kstep; const char* b2 = last ? nB : cB + (size_t)(t + 2) * kstep;
            const char* a3 = a2 + kstep; const char* b3 = b2 + kstep;
            if (last && has_next) S.a_ready(nxt);
            if constexpr (SP2) {
            PG8_LDB(B0, 0, 0); PG8_LDB(B1, 0, 1); PG8_SCHED; PG8_LDA(At, 0, 0); PG8_STAGE(PG8_SA(1, 1), a1 + hstepA, voffA);
            PG8_WAIT_V(8); PG8_WAIT_L(0); PG8_BAR; PG8_MMA(0, 0, At, B0); PG8_MMA(0, 1, At, B1); PG8_BAR; PG8_SCHED;
            PG8_LDA(At, 0, 1); PG8_STAGE(PG8_SB(0, 0), b2, voffB); PG8_STAGE(PG8_SB(0, 1), b2 + hstep, voffB); PG8_STAGE(PG8_SA(0, 0), a2, voffA);
            PG8_WAIT_V(8); PG8_WAIT_L(0); PG8_BAR; PG8_MMA(1, 0, At, B0); PG8_MMA(1, 1, At, B1); PG8_BAR; PG8_SCHED;
            PG8_LDB(B0, 1, 0); PG8_LDB(B1, 1, 1); PG8_SCHED; PG8_LDA(At, 1, 0); PG8_STAGE(PG8_SA(0, 1), a2 + hstepA, voffA);
            PG8_WAIT_V(8); PG8_WAIT_L(0); PG8_BAR; PG8_MMA(0, 0, At, B0); PG8_MMA(0, 1, At, B1); PG8_BAR; PG8_SCHED;
            PG8_LDA(At, 1, 1); PG8_STAGE(PG8_SB(1, 0), b3, voffB); PG8_STAGE(PG8_SB(1, 1), b3 + hstep, voffB); PG8_STAGE(PG8_SA(1, 0), a3, voffA);
            PG8_WAIT_V(8); PG8_WAIT_L(0); PG8_BAR; PG8_MMA(1, 0, At, B0); PG8_MMA(1, 1, At, B1); PG8_BAR; PG8_SCHED;
            } else {
            PG8_LDB(B0, 0, 0); PG8_SCHED; PG8_LDA(At, 0, 0); PG8_STAGE(PG8_SA(1, 1), a1 + hstepA, voffA);
            PG8_WAIT_L(8); PG8_BAR; PG8_WAIT_L(0); PG8_MMA(0, 0, At, B0); PG8_BAR; PG8_SCHED;
            PG8_LDB(B1, 0, 1); PG8_STAGE(PG8_SB(0, 0), b2, voffB);
            PG8_BAR; PG8_WAIT_L(0); PG8_MMA(0, 1, At, B1); PG8_BAR;
            PG8_LDA(At, 0, 1); PG8_STAGE(PG8_SA(0, 0), a2, voffA);
            PG8_BAR; PG8_WAIT_L(0); PG8_MMA(1, 0, At, B0); PG8_BAR; PG8_SCHED;
            PG8_STAGE(PG8_SB(0, 1), b2 + hstep, voffB);
            PG8_WAIT_V(6); PG8_BAR; PG8_MMA(1, 1, At, B1); PG8_BAR;
            PG8_LDB(B0, 1, 0); PG8_SCHED; PG8_LDA(At, 1, 0); PG8_STAGE(PG8_SA(0, 1), a2 + hstepA, voffA);
            PG8_WAIT_L(8); PG8_BAR; PG8_WAIT_L(0); PG8_MMA(0, 0, At, B0); PG8_BAR; PG8_SCHED;
            PG8_LDB(B1, 1, 1); PG8_STAGE(PG8_SB(1, 0), b3, voffB);
            PG8_BAR; PG8_WAIT_L(0); PG8_MMA(0, 1, At, B1); PG8_BAR;
            PG8_LDA(At, 1, 1); PG8_STAGE(PG8_SA(1, 0), a3, voffA);
            PG8_BAR; PG8_WAIT_L(0); PG8_MMA(1, 0, At, B0); PG8_BAR; PG8_SCHED;
            PG8_STAGE(PG8_SB(1, 1), b3 + hstep, voffB);
            PG8_WAIT_V(6); PG8_BAR; PG8_MMA(1, 1, At, B1); PG8_BAR;
            }
        }
        if constexpr (ALIGN_EPI) { if (wr == 0) PG8_BAR; }
        if constexpr (!Epi::AFTER_DRAIN) { E(acc, cur, wr, wc, fr, fq); S.done(cur); }
        if (!has_next) break;
#pragma unroll
        for (int a = 0; a < 2; ++a)
#pragma unroll
            for (int b = 0; b < 2; ++b)
#pragma unroll
                for (int m = 0; m < MF; ++m)
#pragma unroll
                    for (int n = 0; n < 2; ++n) acc[a][b][m][n] = (f32x4){0.f, 0.f, 0.f, 0.f};
        cur = nxt; cA = nA; cB = nB; ++ui;
        if constexpr (ALIGN_EPI) { if (wr == 1) PG8_BAR; }
    }
    PG8_WAIT_V(0);
    if constexpr (!ALIGN_EPI) { if (wr == 0) PG8_BAR; }
    PG8_BAR;
    if constexpr (Epi::AFTER_DRAIN) { E.fused(acc, cur, wr, wc, fr, fq, lds, wid, lane); S.done(cur); }
#undef PG8_SA
#undef PG8_SB
#undef PG8_STAGE
#undef PG8_LDA
#undef PG8_LDB
#undef PG8_MMA
#undef PG8_WAIT_V
#undef PG8_WAIT_L
#undef PG8_BAR
#undef PG8_SCHED
}
}

#define LDS_BYTES 147456
typedef __attribute__((address_space(3))) unsigned char lds_u8;
template <class F> struct EpiAdapt {
  static constexpr bool PERM = false, AFTER_DRAIN = false;
  F f;
  __device__ __forceinline__ void operator()(const f32x4 (&acc)[2][2][4][2], const pg8::Unit& u, int wr, int wc, int fr, int fq) const {
#pragma unroll
    for (int ai = 0; ai < 2; ++ai)
#pragma unroll
      for (int m = 0; m < 4; ++m) {
        const int row = u.pm * 256 + ai * 128 + wr * 64 + m * 16 + fr;
#pragma unroll
        for (int bj = 0; bj < 2; ++bj)
#pragma unroll
          for (int n = 0; n < 2; ++n) f(row, u.pn * 256 + bj * 128 + wc * 32 + n * 16 + fq * 4, acc[ai][bj][m][n]);
        asm volatile("" ::: "memory");
      }
  }
};
template <class F>
__device__ __forceinline__ void gemm_phase(lds_u8* lds, const bf16_t* A, const bf16_t* Bt, int M, int Npad, int K, const F& f, int wq) {
  pg8::Gemm g{A, Bt, M, Npad, K};
  pg8::StaticOrder S; S.init(M, Npad, (int)gridDim.x, (int)blockIdx.x);
  EpiAdapt<F> E{f};
  pg8::gemm_phase<EpiAdapt<F>, pg8::StaticOrder, false, true>(lds, g, S, E, tidw(wq));
  __syncthreads();
}

struct EpiResidP {
  static constexpr bool PERM = false, AFTER_DRAIN = false;
  float* x; const float* g;
  __device__ __forceinline__ void operator()(const f32x4 (&acc)[2][2][4][2], const pg8::Unit& u, int wr, int wc, int fr, int fq) const {
    const int cond = (u.pm < 16) ? 0 : ((u.pm < 32) ? 1 : 2);
    const int col0 = u.pn * 256 + wc * 32 + 4 * fq;
    f32x4 gv[2][2];
#pragma unroll
    for (int bj = 0; bj < 2; ++bj)
#pragma unroll
      for (int n = 0; n < 2; ++n) gv[bj][n] = *(const f32x4*)(g + cond * 6144 + col0 + bj * 128 + n * 16);
#pragma unroll
    for (int ai = 0; ai < 2; ++ai) {
      float* xb = x + (size_t)(u.pm * 256 + ai * 128 + wr * 64 + fr) * DM + col0;
      f32x4 xv[4][2][2];
#pragma unroll
      for (int m = 0; m < 4; ++m)
#pragma unroll
        for (int bj = 0; bj < 2; ++bj)
#pragma unroll
          for (int n = 0; n < 2; ++n) xv[m][bj][n] = *(const f32x4*)(xb + (size_t)m * 16 * DM + bj * 128 + n * 16);
#pragma unroll
      for (int m = 0; m < 4; ++m)
#pragma unroll
        for (int bj = 0; bj < 2; ++bj)
#pragma unroll
          for (int n = 0; n < 2; ++n) *(f32x4*)(xb + (size_t)m * 16 * DM + bj * 128 + n * 16) = xv[m][bj][n] + gv[bj][n] * acc[ai][bj][m][n];
      asm volatile("" ::: "memory");
    }
  }
};
struct EpiResidP192 {
  static constexpr bool PERM = false, AFTER_DRAIN = false;
  float* x; const float* g;
  __device__ __forceinline__ void operator()(const f32x4 (&acc)[2][2][3][2], const pg8::Unit& u, int wr, int wc, int fr, int fq) const {
    const int col0 = u.pn * 256 + wc * 32 + 4 * fq;
#pragma unroll
    for (int ai = 0; ai < 2; ++ai) {
      const int row0 = u.pm * 192 + ai * 96 + wr * 48;
      float* xb = x + (size_t)(row0 + fr) * DM + col0;
      f32x4 xv[3][2][2], gv[3][2][2];
#pragma unroll
      for (int m = 0; m < 3; ++m) {
        const int rf = row0 + m * 16, cond = (rf < T_CTX) ? 0 : 1 + ((rf - T_CTX) >> 12);
#pragma unroll
        for (int bj = 0; bj < 2; ++bj)
#pragma unroll
          for (int n = 0; n < 2; ++n) { xv[m][bj][n] = *(const f32x4*)(xb + (size_t)m * 16 * DM + bj * 128 + n * 16); gv[m][bj][n] = *(const f32x4*)(g + cond * 6144 + col0 + bj * 128 + n * 16); }
      }
#pragma unroll
      for (int m = 0; m < 3; ++m)
#pragma unroll
        for (int bj = 0; bj < 2; ++bj)
#pragma unroll
          for (int n = 0; n < 2; ++n) *(f32x4*)(xb + (size_t)m * 16 * DM + bj * 128 + n * 16) = xv[m][bj][n] + gv[m][bj][n] * acc[ai][bj][m][n];
      asm volatile("" ::: "memory");
    }
  }
};
template <bool FINAL>
struct EpiResidNorm192 {
  static constexpr bool PERM = false, AFTER_DRAIN = false;
  float* x; const float* g; float* part; unsigned* cnt; const float* nw; const float* modl; int sh_off, sc_off; bf16_t* hout;
  template <bool UNI>
  __device__ __forceinline__ void run(f32x4 (&acc)[2][2][3][2], const pg8::Unit& u, int wr, int wc, int fr, int fq) const {
    const int col0 = u.pn * 256 + wc * 32 + 4 * fq;
    const int tile0 = u.pm * 192, cond0 = (tile0 < T_CTX) ? 0 : 1 + ((tile0 - T_CTX) >> 12);
    f32x4 wsu[2][2];
    if (UNI) {
#pragma unroll
      for (int bj = 0; bj < 2; ++bj)
#pragma unroll
        for (int n = 0; n < 2; ++n) { const int c = col0 + bj * 128 + n * 16;
          const f32x4 w = *(const f32x4*)(nw + c);
          if (FINAL) wsu[bj][n] = w;
          else { const f32x4 sc = *(const f32x4*)(modl + cond0 * 6144 + sc_off + c); wsu[bj][n] = w * (1.f + sc); } }
    }
#pragma unroll
    for (int ai = 0; ai < 2; ++ai) {
      const int row0 = tile0 + ai * 96 + wr * 48;
      float* xb = x + (unsigned)(row0 + fr) * DM + col0;
#pragma unroll
      for (int m = 0; m < 3; ++m) {
        const int rf = row0 + m * 16, cond = UNI ? cond0 : ((rf < T_CTX) ? 0 : 1 + ((rf - T_CTX) >> 12));
        f32x4 xv[2][2];
#pragma unroll
        for (int bj = 0; bj < 2; ++bj)
#pragma unroll
          for (int n = 0; n < 2; ++n) xv[bj][n] = *(const f32x4*)(xb + (unsigned)m * 16 * DM + bj * 128 + n * 16);
        float ss = 0.f;
#pragma unroll
        for (int bj = 0; bj < 2; ++bj)
#pragma unroll
          for (int n = 0; n < 2; ++n) {
            const f32x4 gv = *(const f32x4*)(g + cond * 6144 + col0 + bj * 128 + n * 16);
            const f32x4 xn = xv[bj][n] + gv * acc[ai][bj][m][n];
            acc[ai][bj][m][n] = xn;
            if (!FINAL) *(f32x4*)(xb + (unsigned)m * 16 * DM + bj * 128 + n * 16) = xn;
            ss += xn[0] * xn[0] + xn[1] * xn[1] + xn[2] * xn[2] + xn[3] * xn[3];
          }
        ss += __shfl_xor(ss, 16); ss += __shfl_xor(ss, 32);
        if (fq == 0) { float* d = part + (unsigned)(rf + fr) * 16 + u.pn * 4 + wc; asm volatile("global_store_dword %0, %1, off sc1" :: "v"(d), "v"(ss) : "memory"); }
      }
    }
    asm volatile("s_waitcnt vmcnt(0)" ::: "memory");
    __syncthreads();
    if (wr == 0 && wc == 0) {
      unsigned* cw = cnt + u.pm * 64;
      if (fq * 16 + fr == 0) __hip_atomic_fetch_add(cw, 1u, __ATOMIC_RELAXED, __HIP_MEMORY_SCOPE_AGENT);
      unsigned spins = 0;
      while ((unsigned)__builtin_amdgcn_readfirstlane(__hip_atomic_load(cw, __ATOMIC_RELAXED, __HIP_MEMORY_SCOPE_AGENT)) < 4u) {
        __builtin_amdgcn_s_sleep(1);
        if (++spins > (1u << 22)) break;
      }
    }
    __syncthreads();
#pragma unroll
    for (int ai = 0; ai < 2; ++ai) {
      const int row0 = tile0 + ai * 96 + wr * 48;
      f32x4 p4[3];
      {
        const float* q0 = part + (unsigned)(row0 + fr) * 16 + 4 * fq; const float* q1 = q0 + 256; const float* q2 = q0 + 512;
        asm volatile("global_load_dwordx4 %0, %3, off sc1\n\tglobal_load_dwordx4 %1, %4, off sc1\n\tglobal_load_dwordx4 %2, %5, off sc1\n\ts_waitcnt vmcnt(0)"
                     : "=&v"(p4[0]), "=&v"(p4[1]), "=&v"(p4[2]) : "v"(q0), "v"(q1), "v"(q2) : "memory");
      }
#pragma unroll
      for (int m = 0; m < 3; ++m) {
        const int rf = row0 + m * 16, cond = UNI ? cond0 : ((rf < T_CTX) ? 0 : 1 + ((rf - T_CTX) >> 12));
        float tot = (p4[m][0] + p4[m][1]) + (p4[m][2] + p4[m][3]);
        tot += __shfl_xor(tot, 16); tot += __shfl_xor(tot, 32);
        const float rstd = rsqrtf(tot * (1.f / DM) + EPS);
#pragma unroll
        for (int bj = 0; bj < 2; ++bj)
#pragma unroll
          for (int n = 0; n < 2; ++n) {
            const int c = col0 + bj * 128 + n * 16;
            const f32x4 xn = acc[ai][bj][m][n];
            f32x4 ws, sh;
            if (UNI) { ws = wsu[bj][n]; if (!FINAL) sh = *(const f32x4*)(modl + cond0 * 6144 + sh_off + c); }
            else { const f32x4 w = *(const f32x4*)(nw + c);
              if (FINAL) ws = w; else { ws = w * (1.f + *(const f32x4*)(modl + cond * 6144 + sc_off + c)); sh = *(const f32x4*)(modl + cond * 6144 + sh_off + c); } }
            if (FINAL) {
              *(f32x4*)(x + (unsigned)(rf + fr) * DM + c) = xn * rstd * ws;
            } else {
              u32x2 o; o[0] = pack2(xn[0] * rstd * ws[0] + sh[0], xn[1] * rstd * ws[1] + sh[1]);
              o[1] = pack2(xn[2] * rstd * ws[2] + sh[2], xn[3] * rstd * ws[3] + sh[3]);
              *(u32x2*)(hout + (unsigned)(rf + fr) * DM + c) = o;
            }
          }
      }
    }
  }
  __device__ __forceinline__ void operator()(f32x4 (&acc)[2][2][3][2], const pg8::Unit& u, int wr, int wc, int fr, int fq) const {
    const int t0 = u.pm * 192, t1 = t0 + 191;
    const int c0 = (t0 < T_CTX) ? 0 : 1 + ((t0 - T_CTX) >> 12), c1 = (t1 < T_CTX) ? 0 : 1 + ((t1 - T_CTX) >> 12);
    if (c0 == c1) run<true>(acc, u, wr, wc, fr, fq); else run<false>(acc, u, wr, wc, fr, fq);
  }
};
template <bool FINAL>
__device__ __forceinline__ void gemm_phase_residnorm192(lds_u8* lds, const bf16_t* A, const bf16_t* Bt, int K, float* x, const float* g, float* part, unsigned* cnt,
                                                        const float* nw, const float* modl, int sh_off, int sc_off, bf16_t* hout, int wq) {
  pg8::Gemm gm{A, Bt, T_TOK, 1024, K};
  pg8::StaticOrder S; S.init(T_TOK, 1024, (int)gridDim.x, (int)blockIdx.x, 192);
  EpiResidNorm192<FINAL> E{x, g, part, cnt, nw, modl, sh_off, sc_off, hout};
  pg8::gemm_phase<EpiResidNorm192<FINAL>, pg8::StaticOrder, true, true, 192, true>(lds, gm, S, E, tidw(wq));
  __syncthreads();
}
__device__ __forceinline__ void gemm_phase_resid192(lds_u8* lds, const bf16_t* A, const bf16_t* Bt, int M, int Npad, int K, float* x, const float* g, int wq) {
  pg8::Gemm gm{A, Bt, M, Npad, K};
  pg8::StaticOrder S; S.init(M, Npad, (int)gridDim.x, (int)blockIdx.x, 192);
  EpiResidP192 E{x, g};
  pg8::gemm_phase<EpiResidP192, pg8::StaticOrder, false, true, 192>(lds, gm, S, E, tidw(wq));
  __syncthreads();
}
__device__ __forceinline__ void gemm_phase_resid(lds_u8* lds, const bf16_t* A, const bf16_t* Bt, int M, int Npad, int K, float* x, const float* g, int wq) {
  pg8::Gemm gm{A, Bt, M, Npad, K};
  pg8::StaticOrder S; S.init(M, Npad, (int)gridDim.x, (int)blockIdx.x);
  EpiResidP E{x, g};
  pg8::gemm_phase<EpiResidP, pg8::StaticOrder, false, true>(lds, gm, S, E, tidw(wq));
  __syncthreads();
}
template <class F> struct EpiAdapt8 {
  static constexpr bool PERM = true, AFTER_DRAIN = false;
  F f;
  __device__ __forceinline__ void operator()(const f32x4 (&acc)[2][2][4][2], const pg8::Unit& u, int wr, int wc, int fr, int fq) const {
#pragma unroll
    for (int ai = 0; ai < 2; ++ai)
#pragma unroll
      for (int m = 0; m < 4; ++m) {
        const int row = u.pm * 256 + ai * 128 + wr * 64 + m * 16 + fr;
#pragma unroll
        for (int bj = 0; bj < 2; ++bj) f.st8(row, u.pn * 256 + bj * 128 + wc * 32 + fq * 8, acc[ai][bj][m][0], acc[ai][bj][m][1]);
      }
  }
};
template <class F>
__device__ __forceinline__ void gemm_phase8(lds_u8* lds, const bf16_t* A, const bf16_t* Bt, int M, int Npad, int K, const F& f, int wq) {
  pg8::Gemm g{A, Bt, M, Npad, K};
  pg8::StaticOrder S; S.init(M, Npad, (int)gridDim.x, (int)blockIdx.x);
  EpiAdapt8<F> E{f};
  pg8::gemm_phase<EpiAdapt8<F>, pg8::StaticOrder, false, true>(lds, g, S, E, tidw(wq));
  __syncthreads();
}
__device__ __forceinline__ void st_bf8(bf16_t* d, f32x4 a, f32x4 b) { u32x4 o = {cvt2(a[0], a[1]), cvt2(a[2], a[3]), cvt2(b[0], b[1]), cvt2(b[2], b[3])}; *(u32x4*)d = o; }
__device__ __forceinline__ void st_bf4(bf16_t* d, f32x4 v) { u32x2 o; o[0] = pack2(v[0], v[1]); o[1] = pack2(v[2], v[3]); *(u32x2*)d = o; }

struct EpiSsmIn { bf16_t *Pz, *Pxbc; float* small;
  __device__ __forceinline__ void operator()(int m, int n, f32x4 v) const {
    if (n < 2048) st_bf4(Pz + (size_t)m * 2048 + n, v);
    else if (n < 6144) st_bf4(Pxbc + (size_t)m * 4096 + (n - 2048), v);
    else if (n < 6208) *(f32x4*)(small + (size_t)m * 64 + (n - 6144)) = v;
  }
  __device__ __forceinline__ void st8(int m, int n, f32x4 a, f32x4 b) const {
    if (n < 2048) st_bf8(Pz + (size_t)m * 2048 + n, a, b);
    else if (n < 6144) st_bf8(Pxbc + (size_t)m * 4096 + (n - 2048), a, b);
    else if (n < 6208) { float* d = small + (size_t)m * 64 + (n - 6144); *(f32x4*)d = a; *(f32x4*)(d + 4) = b; }
  } };
struct EpiGlaIn { bf16_t *A, *Pz; float* G; const float* gb;
  __device__ __forceinline__ void st8(int m, int n, f32x4 a, f32x4 b) const {
    if (n < 512) st_bf8(A + (size_t)m * 2048 + n, a * 0.08838834764831845f, b * 0.08838834764831845f);
    else if (n < 2048) st_bf8(A + (size_t)m * 2048 + n, a, b);
    else if (n < 3072) st_bf8(Pz + (size_t)m * 1024 + (n - 2048), a, b);
    else {
      const int c = n - 3072;
      const f32x4 b0 = *(const f32x4*)(gb + c), b1 = *(const f32x4*)(gb + c + 4);
      f32x4 o0, o1;
#pragma unroll
      for (int q = 0; q < 4; ++q) { o0[q] = -softplus_fast(-(a[q] + b0[q])) * (1.f / 16.f); o1[q] = -softplus_fast(-(b[q] + b1[q])) * (1.f / 16.f); }
      float* d = G + (size_t)m * 1024 + c; *(f32x4*)d = o0; *(f32x4*)(d + 4) = o1;
    }
  } };
struct EpiGdnIn { bf16_t *Pz, *Pxbc; float* small;
  __device__ __forceinline__ void operator()(int m, int n, f32x4 v) const {
    if (n < 4096) st_bf4(Pxbc + (size_t)m * 4096 + n, v);
    else if (n < 6144) st_bf4(Pz + (size_t)m * 2048 + (n - 4096), v);
    else if (n < 6176) *(f32x4*)(small + (size_t)m * 64 + (n - 6144)) = v;
  }
  __device__ __forceinline__ void st8(int m, int n, f32x4 a, f32x4 b) const {
    if (n < 4096) st_bf8(Pxbc + (size_t)m * 4096 + n, a, b);
    else if (n < 6144) st_bf8(Pz + (size_t)m * 2048 + (n - 4096), a, b);
    else if (n < 6176) { float* d = small + (size_t)m * 64 + (n - 6144); *(f32x4*)d = a; *(f32x4*)(d + 4) = b; }
  } };
struct EpiFfnIn { bf16_t *Pa, *Pv;
  __device__ __forceinline__ void operator()(int m, int n, f32x4 v) const {
    if (n < DFF) st_bf4(Pa + (size_t)m * DFF + n, v); else st_bf4(Pv + (size_t)m * DFF + (n - DFF), v);
  }
  __device__ __forceinline__ void st8(int m, int n, f32x4 a, f32x4 b) const {
    if (n < DFF) st_bf8(Pa + (size_t)m * DFF + n, a, b); else st_bf8(Pv + (size_t)m * DFF + (n - DFF), a, b);
  } };
struct EpiResid { float* x; const float* g;
  __device__ __forceinline__ void operator()(int m, int n, f32x4 v) const {
    const int cond = (m < T_CTX) ? 0 : 1 + ((m - T_CTX) >> 12);
    const f32x4 gv = *(const f32x4*)(g + cond * 6144 + n);
    f32x4* d = (f32x4*)(x + (size_t)m * DM + n);
    f32x4 o = *d; o += gv * v; *d = o;
  } };

__device__ __forceinline__ void ph_ssm_pre(const P& p, int j) {
  const int tid = tidw(p.wq);
  const int gtid = blockIdx.x * NT + tid, gsz = gridDim.x * NT;
  const float* cw = p.ssm_conv_w + (size_t)j * 3 * 4096; const float* cb = p.ssm_conv_b + (size_t)j * 4096;
  const int per = (T_TOK + (int)gridDim.x - 1) / (int)gridDim.x;
  const int tbeg = (int)blockIdx.x * per, tend = (tbeg + per < T_TOK) ? tbeg + per : T_TOK;
  {
    const int c = tid * 8;
    float w[3][8], bias[8];
#pragma unroll
    for (int k = 0; k < 3; ++k) { const f32x4 w0 = *(const f32x4*)(cw + k * 4096 + c), w1 = *(const f32x4*)(cw + k * 4096 + c + 4);
      w[k][0] = w0[0]; w[k][1] = w0[1]; w[k][2] = w0[2]; w[k][3] = w0[3]; w[k][4] = w1[0]; w[k][5] = w1[1]; w[k][6] = w1[2]; w[k][7] = w1[3]; }
    { const f32x4 b0 = *(const f32x4*)(cb + c), b1 = *(const f32x4*)(cb + c + 4);
      bias[0] = b0[0]; bias[1] = b0[1]; bias[2] = b0[2]; bias[3] = b0[3]; bias[4] = b1[0]; bias[5] = b1[1]; bias[6] = b1[2]; bias[7] = b1[3]; }
    const u32x4 z4 = {0u, 0u, 0u, 0u};
    for (int t = tbeg; t < tend; t += 4) {
      int t0, L, cond; tok_info(t, t0, L, cond);
      const int pos = t - t0;
      const bf16_t* srcp = p.Pxbc + (size_t)t * 4096 + c;
      u32x4 X[6];
#pragma unroll
      for (int jx = 0; jx < 6; ++jx) X[jx] = (pos + jx - 1 >= 0 && pos + jx - 1 < L) ? *(const u32x4*)(srcp + (jx - 1) * 4096) : z4;
#pragma unroll
      for (int k = 0; k < 4; ++k) {
        u32x4 o;
#pragma unroll
        for (int q = 0; q < 4; ++q) {
          const float v0 = bias[2 * q] + w[0][2 * q] * bflo(X[k][q]) + w[1][2 * q] * bflo(X[k + 1][q]) + w[2][2 * q] * bflo(X[k + 2][q]);
          const float v1 = bias[2 * q + 1] + w[0][2 * q + 1] * bfhi(X[k][q]) + w[1][2 * q + 1] * bfhi(X[k + 1][q]) + w[2][2 * q + 1] * bfhi(X[k + 2][q]);
          o[q] = pack2(silu_f(v0), silu_f(v1));
        }
        *(u32x4*)(p.A + (size_t)(t + k) * 4096 + c) = o;
      }
    }
  }
  for (int it = gtid; it < T_TOK * 64; it += gsz) {
    const int t = it >> 6, dh = it & 63;
    const float raw = p.small[(size_t)t * 64 + dh];
    const float dt = softplus_f(raw + p.ssm_dt_bias[j * 64 + dh]);
    const float la = -__expf(p.ssm_a_log[j * 64 + dh]) * dt;
    p.small2[(size_t)t * 128 + dh] = dt; p.small2[(size_t)t * 128 + 64 + dh] = la;
  }
}

__device__ __forceinline__ void ph_ssm_tiles(const P& p, int j, unsigned char* shm) {
  const int tid = tidw(p.wq), wave = tid >> 6, lane = tid & 63;
  bf16_t* Bs = (bf16_t*)shm;
  bf16_t* Xs = Bs + 64 * 136;
  bf16_t* Cs = Xs + 64 * 264;
  const float* cw = p.ssm_conv_w + (size_t)j * 3 * 4096; const float* cb = p.ssm_conv_b + (size_t)j * 4096;
  const int cgi = tid & 63, to = tid >> 6;
  const u32x4 z4 = {0u, 0u, 0u, 0u};
#define SSM_LOADX(itm_) do { const int g_ = (itm_) & 7, tk0_ = ((itm_) >> 3) * 64; \
      const int chg_ = (cgi < 32) ? (g_ * 256 + cgi * 8) : ((cgi < 48) ? (2048 + g_ * 128 + (cgi - 32) * 8) : (3072 + g_ * 128 + (cgi - 48) * 8)); \
      int t0_, L_, cond_; tok_info(tk0_, t0_, L_, cond_); const int posb_ = tk0_ - t0_ + 8 * to - 1; \
      const bf16_t* srcp_ = p.Pxbc + (size_t)(tk0_ + 8 * to - 1) * 4096 + chg_; \
      _Pragma("unroll") for (int r = 0; r < 10; ++r) X[r] = (posb_ + r >= 0 && posb_ + r < L_) ? *(const u32x4*)(srcp_ + (size_t)r * 4096) : z4; } while (0)
  u32x4 X[10];
  if ((int)blockIdx.x < 192 * 8) SSM_LOADX((int)blockIdx.x);
  float w[3][8], bias[8]; int gcur = -1;
  for (int item = blockIdx.x; item < 192 * 8; item += gridDim.x) {
    const int c = item >> 3, g = item & 7, tok0 = c * 64;
    const int sr_ = wave & 3, sdir_ = wave >> 2, shead_ = g * 4 + sr_, stk_ = sdir_ ? 63 - lane : lane;
    const float raw_pre = p.small[(size_t)(tok0 + stk_) * 64 + sdir_ * 32 + shead_];
    {
      const int chg = (cgi < 32) ? (g * 256 + cgi * 8) : ((cgi < 48) ? (2048 + g * 128 + (cgi - 32) * 8) : (3072 + g * 128 + (cgi - 48) * 8));
      bf16_t* ld = (cgi < 32) ? (Xs + cgi * 8) : ((cgi < 48) ? (Bs + (cgi - 32) * 8) : (Cs + (cgi - 48) * 8));
      const int lstride = (cgi < 32) ? 264 : 136;
      if (g != gcur) {
        gcur = g;
#pragma unroll
        for (int k = 0; k < 3; ++k) { const f32x4 w0 = *(const f32x4*)(cw + k * 4096 + chg), w1 = *(const f32x4*)(cw + k * 4096 + chg + 4);
          w[k][0] = w0[0]; w[k][1] = w0[1]; w[k][2] = w0[2]; w[k][3] = w0[3]; w[k][4] = w1[0]; w[k][5] = w1[1]; w[k][6] = w1[2]; w[k][7] = w1[3]; }
        { const f32x4 b0 = *(const f32x4*)(cb + chg), b1 = *(const f32x4*)(cb + chg + 4);
          bias[0] = b0[0]; bias[1] = b0[1]; bias[2] = b0[2]; bias[3] = b0[3]; bias[4] = b1[0]; bias[5] = b1[1]; bias[6] = b1[2]; bias[7] = b1[3]; }
      }
      u32x4 oo[8];
#pragma unroll
      for (int k = 0; k < 8; ++k) {
#pragma unroll
        for (int q = 0; q < 4; ++q) {
          const float v0 = bias[2 * q] + w[0][2 * q] * bflo(X[k][q]) + w[1][2 * q] * bflo(X[k + 1][q]) + w[2][2 * q] * bflo(X[k + 2][q]);
          const float v1 = bias[2 * q + 1] + w[0][2 * q + 1] * bfhi(X[k][q]) + w[1][2 * q + 1] * bfhi(X[k + 1][q]) + w[2][2 * q + 1] * bfhi(X[k + 2][q]);
          oo[k][q] = pack2(silu_f(v0), silu_f(v1));
        }
      }
      { const int nxt = item + (int)gridDim.x; if (nxt < 192 * 8) SSM_LOADX(nxt); }
#pragma unroll
      for (int k = 0; k < 8; ++k) {
        if (cgi >= 48) *(u32x4*)(p.A + (size_t)(tok0 + 8 * to + k) * 4096 + chg) = oo[k];
        *(u32x4*)(ld + (8 * to + k) * lstride) = oo[k];
      }
    }
    __syncthreads();
    bf16_t* BTt = p.BT + (size_t)item * 8192;
    for (int q = tid; q < 1024; q += NT) { const int n = q >> 3, cc = q & 7;
      unsigned short v[8];
#pragma unroll
      for (int qq = 0; qq < 8; ++qq) v[qq] = Bs[kperm(cc * 8 + qq) * 136 + n];
      u32x4 o = {(unsigned)v[0] | ((unsigned)v[1] << 16), (unsigned)v[2] | ((unsigned)v[3] << 16), (unsigned)v[4] | ((unsigned)v[5] << 16), (unsigned)v[6] | ((unsigned)v[7] << 16)};
      *(u32x4*)(BTt + n * 64 + cc * 8) = o; }
    bf16_t* XTt = p.XT + (size_t)(c * 32 + g * 4) * 4096;
    for (int q = tid; q < 2048; q += NT) { const int ch = q >> 3, cc = q & 7;
      unsigned short v[8];
#pragma unroll
      for (int qq = 0; qq < 8; ++qq) v[qq] = Xs[kperm(cc * 8 + qq) * 264 + ch];
      u32x4 o = {(unsigned)v[0] | ((unsigned)v[1] << 16), (unsigned)v[2] | ((unsigned)v[3] << 16), (unsigned)v[4] | ((unsigned)v[5] << 16), (unsigned)v[6] | ((unsigned)v[7] << 16)};
      *(u32x4*)(XTt + ch * 64 + cc * 8) = o; }
    if (wave < 4) {
      const int ti = wave >> 1, tj = wave & 1, col = lane & 31, h = lane >> 5;
      f32x16 acc;
#pragma unroll
      for (int r = 0; r < 16; ++r) acc[r] = 0.f;
      const bf16_t* cp = Cs + (32 * ti + col) * 136 + 8 * h;
      const bf16_t* bp = Bs + (32 * tj + col) * 136 + 8 * h;
#pragma unroll
      for (int s = 0; s < 8; ++s) { const bf16x8 a = *(const bf16x8*)(cp + 16 * s), b = *(const bf16x8*)(bp + 16 * s); acc = MFMA32(a, b, acc); }
      bf16_t* Gt = p.Gm + (size_t)item * 4096;
#pragma unroll
      for (int r = 0; r < 16; ++r) { const int i = 32 * ti + (r & 3) + 8 * (r >> 2) + 4 * h; Gt[i * 64 + kperm(32 * tj + col)] = f2bf(acc[r]); }
    }
    {
      const int r = wave & 3, dir = wave >> 2, head = g * 4 + r, tk = dir ? 63 - lane : lane;
      const float dt = softplus_f(raw_pre + p.ssm_dt_bias[j * 64 + dir * 32 + head]);
      const float la = -__expf(p.ssm_a_log[j * 64 + dir * 32 + head]) * dt;
      const float cs = wave_scan_incl(la);
      const float tot = __builtin_bit_cast(float, __builtin_amdgcn_readlane(__builtin_bit_cast(int, cs), 63));
      float* vec = p.VEC + ((size_t)(c * 32 + head) * 2 + dir) * 192;
      vec[tk] = cs; vec[64 + tk] = __logf(dt) - cs; vec[128 + tk] = dt * __expf(tot - cs);
    }
    __syncthreads();
  }
}

__device__ __forceinline__ void put4(f32x16& v, int k, u32x4 x) { v[4 * k] = __uint_as_float(x[0]); v[4 * k + 1] = __uint_as_float(x[1]); v[4 * k + 2] = __uint_as_float(x[2]); v[4 * k + 3] = __uint_as_float(x[3]); }
__device__ __forceinline__ u32x4 get4(const f32x16& v, int k) { u32x4 x = {__float_as_uint(v[4 * k]), __float_as_uint(v[4 * k + 1]), __float_as_uint(v[4 * k + 2]), __float_as_uint(v[4 * k + 3])}; return x; }
__device__ __forceinline__ u32x4 scale8(u32x4 x, float f0, float f1, float f2, float f3, float f4, float f5, float f6, float f7) {
  u32x4 o = {cvt2(bflo(x[0]) * f0, bfhi(x[0]) * f1), cvt2(bflo(x[1]) * f2, bfhi(x[1]) * f3), cvt2(bflo(x[2]) * f4, bfhi(x[2]) * f5), cvt2(bflo(x[3]) * f6, bfhi(x[3]) * f7)};
  return o;
}
__device__ __forceinline__ int grp_pos_bytes(int G) { const int w = G & 3; return ((G & ~3) | (((w & 1) << 1) | (w >> 1))) * 8; }
#define SSM_OFF_Q 0
#define SSM_OFF_BT 17408
#define SSM_OFF_M 35840
#define SSM_OFF_W 45056
#define SSM_BUF 45568
#define SSM_OFF_SB (2 * SSM_BUF)
__device__ __forceinline__ void ph_ssm_chain(const P& p, int j, lds_u8* lds) {
  const int tid = tidw(p.wq), wave = __builtin_amdgcn_readfirstlane(tid >> 6), lane = tid & 63, col = lane & 31, h = lane >> 5;
  float* out_state = p.out + (size_t)T_TOK * DM;
  const int nlat = 128, nitem = 1152, G = (int)gridDim.x;
  const int stride = ((int)blockIdx.x < nlat) ? nitem : (G - nlat);
  for (int item = (int)blockIdx.x; item < nitem; item += stride) {
    int seq, dir, head;
    if (item < 128) { const int x = item & 7, k = item >> 3, cmb = x * 4 + (k >> 2); seq = 16 + (cmb >> 4); dir = (cmb >> 3) & 1; head = (cmb & 7) * 4 + (k & 3); }
    else { const int i2 = item - 128, x = i2 & 7, kk = i2 >> 3, cmb = (kk >> 2) * 8 + x; seq = cmb >> 4; dir = (cmb >> 3) & 1; head = (cmb & 7) * 4 + (kk & 3); }
    int chunk0, nch; if (seq < 16) { chunk0 = seq * 4; nch = 4; } else { chunk0 = 64 + (seq - 16) * 64; nch = 64; }
    const int g = head >> 2;
    const float dskip = dir ? 0.f : p.ssm_d[j * 32 + head];
#define SSM_MPIECE(gq_, cs_i_, aj_, ii_, c8_) do { float m_[8]; \
      const int jb_ = 16 * ((c8_) >> 1) + 4 * ((c8_) & 1); \
      _Pragma("unroll") for (int e = 0; e < 8; ++e) { const int jj = jb_ + (e & 3) + 8 * (e >> 2); \
        const float gv = (e & 1) ? bfhi((gq_)[e >> 1]) : bflo((gq_)[e >> 1]); \
        const float val = gv * __expf((cs_i_) + (aj_)[e]); const bool keep = dir ? (jj >= (ii_)) : (jj <= (ii_)); m_[e] = (keep ? val : 0.f) + ((jj == (ii_)) ? dskip : 0.f); } \
      const u32x4 mo_ = {cvt2(m_[0], m_[1]), cvt2(m_[2], m_[3]), cvt2(m_[4], m_[5]), cvt2(m_[6], m_[7])}; \
      *(LAS u32x4*)(buf + SSM_OFF_M + (ii_) * 144 + (c8_) * 16) = mo_; } while (0)
    if (wave >= 4) {
      const int ltid = tid - 256, lrow = ltid >> 4, lc16 = ltid & 15, lc8 = ltid & 7, grow = ltid >> 3;
      const unsigned lo_c = (unsigned)(((ltid >> 4) * 4096 + (ltid & 15) * 8) * 2), lo_t = (unsigned)(ltid * 16);
      u32x4 RCc[2][4], RB[2][4], RG[2], RG2[2]; float RS[2][16];
#define SSM_LLOAD(set, stepn) do { const int c_ = chunk0 + (dir ? nch - 1 - (stepn) : (stepn)); \
        const char* Cb_ = (const char*)(p.A + (size_t)c_ * 64 * 4096 + 3072 + g * 128); const char* BTt_ = (const char*)(p.BT + (size_t)(c_ * 8 + g) * 8192); \
        const char* Gt_ = (const char*)(p.Gm + (size_t)(c_ * 8 + g) * 4096); const float* v0_ = p.VEC + ((size_t)(c_ * 32 + head) * 2 + dir) * 192; \
        _Pragma("unroll") for (int i = 0; i < 4; ++i) { RCc[set][i] = *(const u32x4*)(Cb_ + i * 131072 + lo_c); RB[set][i] = *(const u32x4*)(BTt_ + i * 4096 + lo_t); RS[set][i] = v0_[lrow + 16 * i]; } \
        RG[set] = *(const u32x4*)(Gt_ + lo_t); RG2[set] = *(const u32x4*)(Gt_ + 4096 + lo_t); RS[set][4] = v0_[grow]; RS[set][7] = v0_[32 + grow]; RS[set][5] = v0_[dir ? 0 : 63]; RS[set][6] = v0_[128 + (ltid & 63)]; \
        { const int ao_ = 64 + 16 * (lc8 >> 1) + 4 * (lc8 & 1); const f32x4 a0_ = *(const f32x4*)(v0_ + ao_), a1_ = *(const f32x4*)(v0_ + ao_ + 8); \
          _Pragma("unroll") for (int e = 0; e < 4; ++e) { RS[set][8 + e] = a0_[e]; RS[set][12 + e] = a1_[e]; } } } while (0)
#define SSM_LWRITE(set, bufi) do { lds_u8* buf = lds + (bufi) * SSM_BUF; \
        const int p0 = grp_pos_bytes(2 * lc16), p1 = grp_pos_bytes(2 * lc16 + 1); \
        _Pragma("unroll") for (int i = 0; i < 4; ++i) { const int row = lrow + 16 * i; const float e0 = __expf(RS[set][i]); \
          const u32x4 q0 = scale8(RCc[set][i], e0, e0, e0, e0, e0, e0, e0, e0); \
          *(LAS u32x2*)(buf + SSM_OFF_Q + row * 272 + p0) = (u32x2){q0[0], q0[1]}; \
          *(LAS u32x2*)(buf + SSM_OFF_Q + row * 272 + p1) = (u32x2){q0[2], q0[3]}; \
          const int q = ltid + 256 * i; *(LAS u32x4*)(buf + SSM_OFF_BT + (q >> 3) * 144 + (q & 7) * 16) = RB[set][i]; } \
        SSM_MPIECE(RG[set], RS[set][4], (&RS[set][8]), grow, lc8); SSM_MPIECE(RG2[set], RS[set][7], (&RS[set][8]), 32 + grow, lc8); \
        if (ltid < 64) { LAS float* wv = (LAS float*)(buf + SSM_OFF_W); wv[ltid] = RS[set][6]; if (ltid == 0) wv[64] = __expf(RS[set][5]); } } while (0)
      SSM_LLOAD(0, 0);
      if (nch > 1) SSM_LLOAD(1, 1);
      for (int it = 0; it <= nch; it += 2) {
        if (it < nch) SSM_LWRITE(0, 0);
        if (it + 2 < nch) SSM_LLOAD(0, it + 2);
        CH_BARRIER();
        if (it + 1 <= nch) {
          if (it + 1 < nch) SSM_LWRITE(1, 1);
          if (it + 3 < nch) SSM_LLOAD(1, it + 3);
          CH_BARRIER();
        }
      }
    } else {
      const int ph = wave & 1, ecol = ph * 32 + col;
      const bool is_state = wave < 2;
      LAS unsigned char* sbw = (LAS unsigned char*)lds + SSM_OFF_SB + ph * 8192 + lane * 16;
      bf16x8 xf[2][4];
#define SSM_LOADXF(set, stepn) do { const int cx_ = chunk0 + (dir ? nch - 1 - (stepn) : (stepn)); \
        const bf16_t* XTt_ = p.XT + (size_t)(cx_ * 32 + head) * 4096 + ecol * 64 + 8 * h; \
        _Pragma("unroll") for (int s = 0; s < 4; ++s) xf[set][s] = *(const bf16x8*)(XTt_ + 16 * s); } while (0)
      if (is_state) {
        f32x16 S[4];
        if (seq >= 16) {
          const float* s = p.state_ssm + ((((size_t)(seq - 16) * 2 + j) * 2 + dir) * 32 + head) * 8192 + ecol;
#pragma unroll
          for (int db = 0; db < 4; ++db)
#pragma unroll
            for (int r = 0; r < 16; ++r) S[db][r] = s[(32 * db + (r & 3) + 8 * (r >> 2) + 4 * h) * 64];
        } else {
#pragma unroll
          for (int db = 0; db < 4; ++db)
#pragma unroll
            for (int r = 0; r < 16; ++r) S[db][r] = 0.f;
        }
#define SSM_PUBLISH(slot) do { _Pragma("unroll") for (int db = 0; db < 4; ++db) { \
          *(LAS bf16x8*)(sbw + (slot) * 16384 + (2 * db) * 1024) = pack_half(S[db], 0); *(LAS bf16x8*)(sbw + (slot) * 16384 + (2 * db + 1) * 1024) = pack_half(S[db], 1); } } while (0)
#define SSM_SSTEP(set, stepn) do { const int step = (stepn); \
          const lds_u8* buf = lds + (step & 1) * SSM_BUF; const LAS float* wv = (const LAS float*)(buf + SSM_OFF_W); \
          const float dec = wv[64]; bf16x8 xw[4]; \
          _Pragma("unroll") for (int s = 0; s < 4; ++s) { \
            const f32x4 wlo = *(const LAS f32x4*)(wv + 16 * s + 4 * h), whi = *(const LAS f32x4*)(wv + 16 * s + 8 + 4 * h); \
            const u32x4 xq = __builtin_bit_cast(u32x4, xf[set][s]); \
            xw[s] = mk8(cvt2(bflo(xq[0]) * wlo[0], bfhi(xq[0]) * wlo[1]), cvt2(bflo(xq[1]) * wlo[2], bfhi(xq[1]) * wlo[3]), \
                        cvt2(bflo(xq[2]) * whi[0], bfhi(xq[2]) * whi[1]), cvt2(bflo(xq[3]) * whi[2], bfhi(xq[3]) * whi[3])); } \
          if (step + 2 < nch) SSM_LOADXF(set, step + 2); \
          _Pragma("unroll") for (int db = 0; db < 4; ++db) _Pragma("unroll") for (int r = 0; r < 16; ++r) S[db][r] *= dec; \
          _Pragma("unroll") for (int sp = 0; sp < 2; ++sp) { bf16x8 kb[4][2]; \
            _Pragma("unroll") for (int db = 0; db < 4; ++db) _Pragma("unroll") for (int s2 = 0; s2 < 2; ++s2) \
              kb[db][s2] = *(const LAS bf16x8*)(buf + SSM_OFF_BT + (32 * db + col) * 144 + 32 * (2 * sp + s2) + 16 * h); \
            _Pragma("unroll") for (int s2 = 0; s2 < 2; ++s2) _Pragma("unroll") for (int db = 0; db < 4; ++db) S[db] = MFMA32(kb[db][s2], xw[2 * sp + s2], S[db]); } \
          if (step + 1 < nch) SSM_PUBLISH((step + 1) & 1); } while (0)
        SSM_LOADXF(0, 0);
        if (nch > 1) SSM_LOADXF(1, 1);
        SSM_PUBLISH(0);
        for (int it = 0; it <= nch; it += 2) {
          if (it >= 1) SSM_SSTEP(1, it - 1);
          CH_BARRIER();
          if (it + 1 <= nch) { SSM_SSTEP(0, it); CH_BARRIER(); }
        }
        if (seq < 16) {
          float* d = out_state + ((((size_t)seq * 2 + j) * 2 + dir) * 32 + head) * 8192 + ecol;
#pragma unroll
          for (int db = 0; db < 4; ++db)
#pragma unroll
            for (int r = 0; r < 16; ++r) d[(32 * db + (r & 3) + 8 * (r >> 2) + 4 * h) * 64] = S[db][r];
        }
      } else {
#define SSM_OSTEP(set, stepn) do { const int step = (stepn); \
          const int c = chunk0 + (dir ? nch - 1 - step : step), tok0 = c * 64; \
          const lds_u8* buf = lds + (step & 1) * SSM_BUF; const lds_u8* Qb = buf + SSM_OFF_Q; const lds_u8* Mb = buf + SSM_OFF_M; \
          bf16x8 Sb[8]; \
          _Pragma("unroll") for (int f = 0; f < 8; ++f) Sb[f] = *(const LAS bf16x8*)(sbw + (step & 1) * 16384 + f * 1024); \
          bf16_t* Yb = p.Pxbc + ((size_t)dir * T_TOK + tok0) * 2048 + head * 64 + ecol + 4 * h * 2048; \
          f32x16 Oa[2]; \
          _Pragma("unroll") for (int t = 0; t < 2; ++t) _Pragma("unroll") for (int r = 0; r < 16; ++r) Oa[t][r] = 0.f; \
          _Pragma("unroll") for (int sg = 0; sg < 2; ++sg) { bf16x8 qa[2][4]; \
            _Pragma("unroll") for (int t = 0; t < 2; ++t) _Pragma("unroll") for (int s2 = 0; s2 < 4; ++s2) qa[t][s2] = *(const LAS bf16x8*)(Qb + (32 * t + col) * 272 + 32 * (4 * sg + s2) + 16 * h); \
            _Pragma("unroll") for (int s2 = 0; s2 < 4; ++s2) { Oa[0] = MFMA32(qa[0][s2], Sb[4 * sg + s2], Oa[0]); Oa[1] = MFMA32(qa[1][s2], Sb[4 * sg + s2], Oa[1]); } } \
          { bf16x8 ma[2][4]; \
            _Pragma("unroll") for (int t = 0; t < 2; ++t) _Pragma("unroll") for (int s = 0; s < 4; ++s) ma[t][s] = *(const LAS bf16x8*)(Mb + (32 * t + col) * 144 + 32 * s + 16 * h); \
            _Pragma("unroll") for (int s = 0; s < 4; ++s) { Oa[0] = MFMA32(ma[0][s], xf[set][s], Oa[0]); Oa[1] = MFMA32(ma[1][s], xf[set][s], Oa[1]); } } \
          if (step + 2 < nch) SSM_LOADXF(set, step + 2); \
          _Pragma("unroll") for (int t = 0; t < 2; ++t) _Pragma("unroll") for (int r = 0; r < 16; r += 2) { \
            const unsigned pk = cvt2(Oa[t][r], Oa[t][r + 1]); \
            Yb[(size_t)(32 * t + (r & 3) + 8 * (r >> 2)) * 2048] = (bf16_t)(pk & 0xffffu); \
            Yb[(size_t)(32 * t + ((r + 1) & 3) + 8 * ((r + 1) >> 2)) * 2048] = (bf16_t)(pk >> 16); } } while (0)
        SSM_LOADXF(0, 0);
        if (nch > 1) SSM_LOADXF(1, 1);
        for (int it = 0; it <= nch; it += 2) {
          if (it >= 1) SSM_OSTEP(1, it - 1);
          CH_BARRIER();
          if (it + 1 <= nch) { SSM_OSTEP(0, it); CH_BARRIER(); }
        }
      }
    }
  }
}

__device__ __forceinline__ void ph_ssm_post(const P& p, int j) {
  const int wave = tidw(p.wq) >> 6, lane = tidw(p.wq) & 63;
  const int gw = blockIdx.x * 8 + wave, nwv = gridDim.x * 8;
  const bf16_t* Y = p.Pxbc;
  const float* nw = p.ssm_norm_w + (size_t)j * 2048; const float* dsk = p.ssm_d + j * 32;
  for (int it4 = gw; it4 < T_TOK * 2; it4 += nwv) {
    const int t = it4 >> 1, g0 = (it4 & 1) * 4;
    u32x2 yf[4], yb[4], z[4];
#pragma unroll
    for (int k = 0; k < 4; ++k) {
      const int c = (g0 + k) * 256 + lane * 4;
      yf[k] = *(const u32x2*)(Y + (size_t)t * 2048 + c);
      yb[k] = *(const u32x2*)(Y + ((size_t)T_TOK + t) * 2048 + c);
      z[k] = *(const u32x2*)(p.Pz + (size_t)t * 2048 + c);
    }
#pragma unroll
    for (int k = 0; k < 4; ++k) {
      const int c = (g0 + k) * 256 + lane * 4;
      float v[4];
      v[0] = (bflo(yf[k][0]) + bflo(yb[k][0])) * silu_f(bflo(z[k][0]));
      v[1] = (bfhi(yf[k][0]) + bfhi(yb[k][0])) * silu_f(bfhi(z[k][0]));
      v[2] = (bflo(yf[k][1]) + bflo(yb[k][1])) * silu_f(bflo(z[k][1]));
      v[3] = (bfhi(yf[k][1]) + bfhi(yb[k][1])) * silu_f(bfhi(z[k][1]));
      const float ss = wave_sum(v[0] * v[0] + v[1] * v[1] + v[2] * v[2] + v[3] * v[3]);
      const float rstd = rsqrtf(ss * (1.f / 256.f) + EPS);
      const f32x4 w = *(const f32x4*)(nw + c);
      u32x2 o; o[0] = pack2(v[0] * rstd * w[0], v[1] * rstd * w[1]); o[1] = pack2(v[2] * rstd * w[2], v[3] * rstd * w[3]);
      *(u32x2*)(p.H + (size_t)t * 2048 + c) = o;
    }
  }
}

__device__ __forceinline__ void ph_gla_pre(const P& p) {
  const int tid = tidw(p.wq);
  float* G = (float*)p.Pxbc;
  const int per = (T_TOK + (int)gridDim.x - 1) / (int)gridDim.x;
  const int tbeg = (int)blockIdx.x * per, tend = (tbeg + per < T_TOK) ? tbeg + per : T_TOK;
#pragma unroll 1
  for (int half = 0; half < 2; ++half) {
    const int idx = half * NT + tid, e = idx >> 9, kk = idx & 511;
    float w2[16];
#pragma unroll
    for (int r = 0; r < 16; ++r) w2[r] = p.gla_gate_w2[(size_t)e * 16 * 512 + r * 512 + kk];
    const float gb = p.gla_gate_b[e * 512 + kk];
    for (int t = tbeg; t < tend; t += 4) {
      f32x4 lr[4][4];
#pragma unroll
      for (int k = 0; k < 4; ++k)
#pragma unroll
        for (int q = 0; q < 4; ++q) lr[k][q] = *(const f32x4*)(p.small + (size_t)(t + k) * 64 + e * 16 + q * 4);
#pragma unroll
      for (int k = 0; k < 4; ++k) {
        float s = gb;
#pragma unroll
        for (int q = 0; q < 4; ++q) s += lr[k][q][0] * w2[4 * q] + lr[k][q][1] * w2[4 * q + 1] + lr[k][q][2] * w2[4 * q + 2] + lr[k][q][3] * w2[4 * q + 3];
        G[(size_t)(t + k) * 1024 + idx] = -softplus_f(-s) * (1.f / 16.f);
      }
    }
  }
}


template <int DIR>
__device__ __forceinline__ void gla_scan1(const bf16_t* Qr, const bf16_t* Kr, bf16_t* Qs, bf16_t* Ks, bf16_t* qpt, const float (&lgv)[32], float cs, int half, int d) {
  const int ib = DIR ? 63 - 32 * half : 32 * half;
  const bf16_t* qr = Qr + ib * 136 + d; const bf16_t* kr = Kr + ib * 136 + d;
  bf16_t* qs = Qs + (DIR * 64 + ib) * 136 + d; bf16_t* ks = Ks + (DIR * 64 + ib) * 136 + d; bf16_t* qg = qpt + ib * 128;
#pragma unroll
  for (int k = 0; k < 32; ++k) { const int o = DIR ? -k : k;
    cs += lgv[k];
    const float e = __expf(cs);
    const unsigned pk = cvt2(bf2f(qr[o * 136]) * e, bf2f(kr[o * 136]) * __builtin_amdgcn_rcpf(e));
    const bf16_t qb = (bf16_t)(pk & 0xffffu);
    qs[o * 136] = qb; qg[o * 128] = qb; ks[o * 136] = (bf16_t)(pk >> 16); }
}
template <int DIR>
__device__ __forceinline__ void gla_scan2(const bf16_t* Kr, bf16_t* Ks, const float (&lgv)[32], float cs, float cs_tot, int half, int d) {
  const int ib = DIR ? 63 - 32 * half : 32 * half;
  const bf16_t* kr = Kr + ib * 136 + d; bf16_t* ks = Ks + (DIR * 64 + ib) * 136 + d;
#pragma unroll
  for (int k = 0; k < 32; ++k) { const int o = DIR ? -k : k;
    cs += lgv[k];
    ks[o * 136] = f2bf(bf2f(kr[o * 136]) * __expf(cs_tot - cs)); }
}
template <int DIR>
__device__ __forceinline__ void gla_load_lg(const float* lgp  , float (&lga)[64]) {
#pragma unroll
  for (int s = 0; s < 64; ++s) lga[s] = lgp[(DIR ? -s : s) * 1024];
}
__device__ __forceinline__ void ph_gla_tiles(const P& p, unsigned char* shm) {
  const int tid = tidw(p.wq), wave = tid >> 6, lane = tid & 63;
  bf16_t* Qs = (bf16_t*)shm;
  bf16_t* Ks = Qs + 2 * 64 * 136;
  bf16_t* Vs = Ks + 2 * 64 * 136;
  bf16_t* Qr = Vs + 64 * 264;
  bf16_t* Kr = Qr + 64 * 136;
  const float* LG = (const float*)p.Pxbc;
  bf16_t* QP = p.H; bf16_t* KWT = p.H + (size_t)1536 * 8192; bf16_t* AI = p.H + (size_t)2 * 1536 * 8192;
  const int dir = __builtin_amdgcn_readfirstlane((tid >> 7) & 1), half = __builtin_amdgcn_readfirstlane(tid >> 8);
  for (int item = blockIdx.x; item < 192 * 4; item += gridDim.x) {
    const int c = item >> 2, hd = item & 3, tok0 = c * 64;
    int d = tid & 127; asm volatile("" : "+v"(d));
    float lgv[32]; float cs_start = 0.f, cs_tot = 0.f;
    {
      float lga[64];
      { const float* lgp = LG + (size_t)(tok0 + (dir ? 63 : 0)) * 1024 + dir * 512 + hd * 128 + d;
        if (dir) gla_load_lg<1>(lgp, lga); else gla_load_lg<0>(lgp, lga); }
      for (int q = tid; q < 2048; q += NT) { const int row = q >> 5, c16 = q & 31;
        *(u32x4*)(Vs + row * 264 + c16 * 8) = *(const u32x4*)(p.A + (size_t)(tok0 + row) * 2048 + 1024 + hd * 256 + c16 * 8); }
      for (int q = tid; q < 1024; q += NT) { const int row = q >> 4, c16 = q & 15;
        *(u32x4*)(Qr + row * 136 + c16 * 8) = *(const u32x4*)(p.A + (size_t)(tok0 + row) * 2048 + hd * 128 + c16 * 8);
        *(u32x4*)(Kr + row * 136 + c16 * 8) = *(const u32x4*)(p.A + (size_t)(tok0 + row) * 2048 + 512 + hd * 128 + c16 * 8); }
      float acc = 0.f;
#pragma unroll
      for (int s = 0; s < 64; ++s) { if (s == 32) cs_start = half ? acc : 0.f; acc += lga[s]; }
      cs_tot = acc;
#pragma unroll
      for (int k = 0; k < 32; ++k) lgv[k] = half ? lga[32 + k] : lga[k];
    }
    __syncthreads();
    {
      bf16_t* qpt = QP + (size_t)(item * 2 + dir) * 8192 + kperm(d);
      if (dir) gla_scan1<1>(Qr, Kr, Qs, Ks, qpt, lgv, cs_start, half, d); else gla_scan1<0>(Qr, Kr, Qs, Ks, qpt, lgv, cs_start, half, d);
      if (half == 0) p.VEC[(size_t)(item * 2 + dir) * 128 + d] = __expf(cs_tot);
    }
    __syncthreads();
    {
      const int dirw = wave >> 2, ti = (wave >> 1) & 1, tj = wave & 1, col = lane & 31, h = lane >> 5;
      f32x16 acc;
#pragma unroll
      for (int r = 0; r < 16; ++r) acc[r] = 0.f;
      const bf16_t* ap = Qs + (dirw * 64 + 32 * ti + col) * 136 + 8 * h;
      const bf16_t* bp = Ks + (dirw * 64 + 32 * tj + col) * 136 + 8 * h;
#pragma unroll
      for (int s = 0; s < 8; ++s) acc = MFMA32(*(const bf16x8*)(ap + 16 * s), *(const bf16x8*)(bp + 16 * s), acc);
      bf16_t* At = AI + (size_t)(item * 2 + dirw) * 4096;
      const int jj = 32 * tj + col;
#pragma unroll
      for (int r = 0; r < 16; ++r) { const int i = 32 * ti + (r & 3) + 8 * (r >> 2) + 4 * h;
        const bool keep = dirw ? (jj >= i) : (jj <= i);
        At[i * 64 + kperm(jj)] = keep ? f2bf(acc[r]) : (bf16_t)0; }
    }
    {
      bf16_t* VTt = p.BT + (size_t)item * 16384;
      for (int q = tid; q < 2048; q += NT) { const int e = q >> 3, cc = q & 7;
        unsigned short v[8];
#pragma unroll
        for (int qq = 0; qq < 8; ++qq) v[qq] = Vs[kperm(cc * 8 + qq) * 264 + e];
        u32x4 o = {(unsigned)v[0] | ((unsigned)v[1] << 16), (unsigned)v[2] | ((unsigned)v[3] << 16), (unsigned)v[4] | ((unsigned)v[5] << 16), (unsigned)v[6] | ((unsigned)v[7] << 16)};
        *(u32x4*)(VTt + e * 64 + cc * 8) = o; }
    }
    __syncthreads();
    if (dir) gla_scan2<1>(Kr, Ks, lgv, cs_start, cs_tot, half, d); else gla_scan2<0>(Kr, Ks, lgv, cs_start, cs_tot, half, d);
    __syncthreads();
    for (int q = tid; q < 2048; q += NT) { const int dirq = q >> 10, dd = (q >> 3) & 127, cc = q & 7;
      unsigned short v[8];
#pragma unroll
      for (int qq = 0; qq < 8; ++qq) v[qq] = Ks[(dirq * 64 + kperm(cc * 8 + qq)) * 136 + dd];
      u32x4 o = {(unsigned)v[0] | ((unsigned)v[1] << 16), (unsigned)v[2] | ((unsigned)v[3] << 16), (unsigned)v[4] | ((unsigned)v[5] << 16), (unsigned)v[6] | ((unsigned)v[7] << 16)};
      *(u32x4*)(KWT + (size_t)(item * 2 + dirq) * 8192 + dd * 64 + cc * 8) = o; }
    __syncthreads();
  }
}

#define GLA_OFF_Q 0
#define GLA_OFF_K 17408
#define GLA_OFF_A 35840
#define GLA_OFF_D 45056
#define GLA_BUF 45568
#define GLA_OFF_SB (2 * GLA_BUF)
__device__ __forceinline__ void ph_gla_chain(const P& p, lds_u8* lds) {
  const int tid = tidw(p.wq), wave = __builtin_amdgcn_readfirstlane(tid >> 6), lane = tid & 63, col = lane & 31, h = lane >> 5;
  float* out_state = p.out + (size_t)T_TOK * DM + 16777216;
  const bf16_t* QP = p.H; const bf16_t* KWT = p.H + (size_t)1536 * 8192; const bf16_t* AI = p.H + (size_t)2 * 1536 * 8192;
  const int nlat = 64, nitem = 576, G = (int)gridDim.x;
  const int stride = ((int)blockIdx.x < nlat) ? nitem : (G - nlat);
  for (int item = (int)blockIdx.x; item < nitem; item += stride) {
    int seq, dir, hd, quarter;
    if (item < 64) { const int x = item & 7, k = item >> 3, cmb = (k >> 2) * 8 + x; quarter = k & 3; seq = 16 + (cmb >> 3); dir = (cmb >> 2) & 1; hd = cmb & 3; }
    else { const int i2 = item - 64, x = i2 & 7, kk = i2 >> 3, cmb = (kk >> 2) * 8 + x; quarter = kk & 3; seq = cmb >> 3; dir = (cmb >> 2) & 1; hd = cmb & 3; }
    int chunk0, nch; if (seq < 16) { chunk0 = seq * 4; nch = 4; } else { chunk0 = 64 + (seq - 16) * 64; nch = 64; }
    if (wave >= 4) {
      const int ltid = tid - 256;
      const unsigned lo_t = (unsigned)(ltid * 16);
      u32x4 RQ[2][4], RK[2][4], RA[2][2], RD[2];
#define GLA_LLOAD(set, stepn) do { const int c_ = chunk0 + (dir ? nch - 1 - (stepn) : (stepn)); const size_t tix_ = (size_t)((c_ * 4 + hd) * 2 + dir); \
        const char* Qt_ = (const char*)(QP + tix_ * 8192); const char* Kt_ = (const char*)(KWT + tix_ * 8192); const char* At_ = (const char*)(AI + tix_ * 4096); \
        _Pragma("unroll") for (int i = 0; i < 4; ++i) { RQ[set][i] = *(const u32x4*)(Qt_ + i * 4096 + lo_t); RK[set][i] = *(const u32x4*)(Kt_ + i * 4096 + lo_t); } \
        _Pragma("unroll") for (int i = 0; i < 2; ++i) RA[set][i] = *(const u32x4*)(At_ + i * 4096 + lo_t); \
        if (ltid < 32) RD[set] = *(const u32x4*)(p.VEC + tix_ * 128 + ltid * 4); } while (0)
#define GLA_LWRITE(set, bufi) do { lds_u8* buf = lds + (bufi) * GLA_BUF; \
        _Pragma("unroll") for (int i = 0; i < 4; ++i) { const int q = ltid + 256 * i; \
          *(LAS u32x4*)(buf + GLA_OFF_Q + (q >> 4) * 272 + (q & 15) * 16) = RQ[set][i]; \
          *(LAS u32x4*)(buf + GLA_OFF_K + (q >> 3) * 144 + (q & 7) * 16) = RK[set][i]; } \
        _Pragma("unroll") for (int i = 0; i < 2; ++i) { const int q = ltid + 256 * i; *(LAS u32x4*)(buf + GLA_OFF_A + (q >> 3) * 144 + (q & 7) * 16) = RA[set][i]; } \
        if (ltid < 32) *(LAS u32x4*)(buf + GLA_OFF_D + ltid * 16) = RD[set]; } while (0)
      GLA_LLOAD(0, 0);
      if (nch > 1) GLA_LLOAD(1, 1);
      for (int it = 0; it <= nch; it += 2) {
        if (it < nch) GLA_LWRITE(0, 0);
        if (it + 2 < nch) GLA_LLOAD(0, it + 2);
        CH_BARRIER();
        if (it + 1 <= nch) {
          if (it + 1 < nch) GLA_LWRITE(1, 1);
          if (it + 3 < nch) GLA_LLOAD(1, it + 3);
          CH_BARRIER();
        }
      }
    } else {
      const int ph = wave & 1, ecol = (quarter * 2 + ph) * 32 + col;
      LAS unsigned char* sbw = (LAS unsigned char*)lds + GLA_OFF_SB + ph * 8192 + lane * 16;
      bf16x8 vf[2][4];
#define GLA_LOADVF(set, stepn) do { const int cx_ = chunk0 + (dir ? nch - 1 - (stepn) : (stepn)); \
        const bf16_t* Vt_ = p.BT + (size_t)(cx_ * 4 + hd) * 16384 + ecol * 64 + 8 * h; \
        _Pragma("unroll") for (int s = 0; s < 4; ++s) vf[set][s] = *(const bf16x8*)(Vt_ + 16 * s); } while (0)
      if (wave < 2) {
        f32x16 S[4];
        if (seq >= 16) {
          const float* s = p.state_gla + (((size_t)(seq - 16) * 2 + dir) * 4 + hd) * 32768 + ecol;
#pragma unroll
          for (int db = 0; db < 4; ++db)
#pragma unroll
            for (int r = 0; r < 16; ++r) S[db][r] = s[(32 * db + (r & 3) + 8 * (r >> 2) + 4 * h) * 256];
        } else {
#pragma unroll
          for (int db = 0; db < 4; ++db)
#pragma unroll
            for (int r = 0; r < 16; ++r) S[db][r] = 0.f;
        }
#define GLA_PUBLISH(slot) do { _Pragma("unroll") for (int db = 0; db < 4; ++db) { \
          *(LAS bf16x8*)(sbw + (slot) * 16384 + (2 * db) * 1024) = pack_half(S[db], 0); *(LAS bf16x8*)(sbw + (slot) * 16384 + (2 * db + 1) * 1024) = pack_half(S[db], 1); } } while (0)
#define GLA_SSTEP(set, stepn) do { const int step = (stepn); \
          const lds_u8* buf = lds + (step & 1) * GLA_BUF; const LAS float* dect = (const LAS float*)(buf + GLA_OFF_D); \
          _Pragma("unroll") for (int db = 0; db < 4; ++db) _Pragma("unroll") for (int q = 0; q < 4; ++q) { const f32x4 d4 = *(const LAS f32x4*)(dect + 32 * db + 8 * q + 4 * h); \
            _Pragma("unroll") for (int rr = 0; rr < 4; ++rr) S[db][4 * q + rr] *= d4[rr]; } \
          _Pragma("unroll") for (int sp = 0; sp < 2; ++sp) { bf16x8 kb[4][2]; \
            _Pragma("unroll") for (int db = 0; db < 4; ++db) _Pragma("unroll") for (int s2 = 0; s2 < 2; ++s2) \
              kb[db][s2] = *(const LAS bf16x8*)(buf + GLA_OFF_K + (32 * db + col) * 144 + 32 * (2 * sp + s2) + 16 * h); \
            _Pragma("unroll") for (int s2 = 0; s2 < 2; ++s2) _Pragma("unroll") for (int db = 0; db < 4; ++db) S[db] = MFMA32(kb[db][s2], vf[set][2 * sp + s2], S[db]); } \
          if (step + 2 < nch) GLA_LOADVF(set, step + 2); \
          if (step + 1 < nch) GLA_PUBLISH((step + 1) & 1); } while (0)
        GLA_LOADVF(0, 0);
        if (nch > 1) GLA_LOADVF(1, 1);
        GLA_PUBLISH(0);
        for (int it = 0; it <= nch; it += 2) {
          if (it >= 1) GLA_SSTEP(1, it - 1);
          CH_BARRIER();
          if (it + 1 <= nch) { GLA_SSTEP(0, it); CH_BARRIER(); }
        }
        if (seq < 16) {
          float* d_ = out_state + (((size_t)seq * 2 + dir) * 4 + hd) * 32768 + ecol;
#pragma unroll
          for (int db = 0; db < 4; ++db)
#pragma unroll
            for (int r = 0; r < 16; ++r) d_[(32 * db + (r & 3) + 8 * (r >> 2) + 4 * h) * 256] = S[db][r];
        }
      } else {
#define GLA_OSTEP(set, stepn) do { const int step = (stepn); \
          const int c = chunk0 + (dir ? nch - 1 - step : step), tok0 = c * 64; \
          const lds_u8* buf = lds + (step & 1) * GLA_BUF; \
          bf16x8 Sb[8]; \
          _Pragma("unroll") for (int f = 0; f < 8; ++f) Sb[f] = *(const LAS bf16x8*)(sbw + (step & 1) * 16384 + f * 1024); \
          bf16_t* Ob = p.Pxbc + (size_t)T_TOK * 2048 + ((size_t)dir * T_TOK + tok0) * 1024 + hd * 256 + ecol + 4 * h * 1024; \
          f32x16 Oa[2]; \
          _Pragma("unroll") for (int t = 0; t < 2; ++t) _Pragma("unroll") for (int r = 0; r < 16; ++r) Oa[t][r] = 0.f; \
          _Pragma("unroll") for (int sg = 0; sg < 2; ++sg) { bf16x8 qa[2][4]; \
            _Pragma("unroll") for (int t = 0; t < 2; ++t) _Pragma("unroll") for (int s2 = 0; s2 < 4; ++s2) qa[t][s2] = *(const LAS bf16x8*)(buf + GLA_OFF_Q + (32 * t + col) * 272 + 32 * (4 * sg + s2) + 16 * h); \
            _Pragma("unroll") for (int s2 = 0; s2 < 4; ++s2) { Oa[0] = MFMA32(qa[0][s2], Sb[4 * sg + s2], Oa[0]); Oa[1] = MFMA32(qa[1][s2], Sb[4 * sg + s2], Oa[1]); } } \
          { bf16x8 ma[2][4]; \
            _Pragma("unroll") for (int t = 0; t < 2; ++t) _Pragma("unroll") for (int s = 0; s < 4; ++s) ma[t][s] = *(const LAS bf16x8*)(buf + GLA_OFF_A + (32 * t + col) * 144 + 32 * s + 16 * h); \
            _Pragma("unroll") for (int s = 0; s < 4; ++s) { Oa[0] = MFMA32(ma[0][s], vf[set][s], Oa[0]); Oa[1] = MFMA32(ma[1][s], vf[set][s], Oa[1]); } } \
          if (step + 2 < nch) GLA_LOADVF(set, step + 2); \
          _Pragma("unroll") for (int t = 0; t < 2; ++t) _Pragma("unroll") for (int r = 0; r < 16; r += 2) { \
            const unsigned pk = cvt2(Oa[t][r], Oa[t][r + 1]); \
            Ob[(size_t)(32 * t + (r & 3) + 8 * (r >> 2)) * 1024] = (bf16_t)(pk & 0xffffu); \
            Ob[(size_t)(32 * t + ((r + 1) & 3) + 8 * ((r + 1) >> 2)) * 1024] = (bf16_t)(pk >> 16); } } while (0)
        GLA_LOADVF(0, 0);
        if (nch > 1) GLA_LOADVF(1, 1);
        for (int it = 0; it <= nch; it += 2) {
          if (it >= 1) GLA_OSTEP(1, it - 1);
          CH_BARRIER();
          if (it + 1 <= nch) { GLA_OSTEP(0, it); CH_BARRIER(); }
        }
      }
    }
  }
}

__device__ __forceinline__ void ph_headnorm_post(const P& p, const bf16_t* __restrict__ O, int nheads, const float* __restrict__ nw, const bf16_t* __restrict__ gate) {
  const int wave = tidw(p.wq) >> 6, lane = tidw(p.wq) & 63;
  const int gw = blockIdx.x * 8 + wave, nwv = gridDim.x * 8;
  const int C = nheads * 256, npt = nheads >> 2;
  const f32x4 w = *(const f32x4*)(nw + lane * 4);
  for (int it4 = gw; it4 < T_TOK * npt; it4 += nwv) {
    const int t = it4 / npt, h0 = (it4 % npt) * 4;
    u32x2 of[4], ob[4], z[4];
#pragma unroll
    for (int k = 0; k < 4; ++k) {
      const int c = (h0 + k) * 256 + lane * 4;
      of[k] = *(const u32x2*)(O + (size_t)t * C + c);
      ob[k] = *(const u32x2*)(O + ((size_t)T_TOK + t) * C + c);
      z[k] = *(const u32x2*)(gate + (size_t)t * C + c);
    }
#pragma unroll
    for (int k = 0; k < 4; ++k) {
      const int c = (h0 + k) * 256 + lane * 4;
      float v[4];
      v[0] = bflo(of[k][0]) + bflo(ob[k][0]); v[1] = bfhi(of[k][0]) + bfhi(ob[k][0]); v[2] = bflo(of[k][1]) + bflo(ob[k][1]); v[3] = bfhi(of[k][1]) + bfhi(ob[k][1]);
      const float ss = wave_sum(v[0] * v[0] + v[1] * v[1] + v[2] * v[2] + v[3] * v[3]);
      const float rstd = rsqrtf(ss * (1.f / 256.f) + EPS);
      u32x2 o;
      o[0] = pack2(v[0] * rstd * w[0] * silu_f(bflo(z[k][0])), v[1] * rstd * w[1] * silu_f(bfhi(z[k][0])));
      o[1] = pack2(v[2] * rstd * w[2] * silu_f(bflo(z[k][1])), v[3] * rstd * w[3] * silu_f(bfhi(z[k][1])));
      *(u32x2*)(p.H + (size_t)t * C + c) = o;
    }
  }
}

__device__ __forceinline__ void ph_gdn_pre(const P& p) {
  const int tid = tidw(p.wq);
  const float* cw = p.gdn_conv_w;
  const int per = (T_TOK + (int)gridDim.x - 1) / (int)gridDim.x;
  const int tbeg = (int)blockIdx.x * per, tend = (tbeg + per < T_TOK) ? tbeg + per : T_TOK;
  {
    const int c = tid * 8;
    float w[3][8];
#pragma unroll
    for (int k = 0; k < 3; ++k) { const f32x4 w0 = *(const f32x4*)(cw + k * 4096 + c), w1 = *(const f32x4*)(cw + k * 4096 + c + 4);
      w[k][0] = w0[0]; w[k][1] = w0[1]; w[k][2] = w0[2]; w[k][3] = w0[3]; w[k][4] = w1[0]; w[k][5] = w1[1]; w[k][6] = w1[2]; w[k][7] = w1[3]; }
    const u32x4 z4 = {0u, 0u, 0u, 0u};
    for (int t = tbeg; t < tend; t += 4) {
      int t0, L, cond; tok_info(t, t0, L, cond);
      const int pos = t - t0;
      const bf16_t* srcp = p.Pxbc + (size_t)t * 4096 + c;
      u32x4 X[6];
#pragma unroll
      for (int jx = 0; jx < 6; ++jx) X[jx] = (pos + jx - 1 >= 0 && pos + jx - 1 < L) ? *(const u32x4*)(srcp + (jx - 1) * 4096) : z4;
#pragma unroll
      for (int k = 0; k < 4; ++k) {
        float v[8];
#pragma unroll
        for (int q = 0; q < 4; ++q) {
          v[2 * q] = silu_f(w[0][2 * q] * bflo(X[k][q]) + w[1][2 * q] * bflo(X[k + 1][q]) + w[2][2 * q] * bflo(X[k + 2][q]));
          v[2 * q + 1] = silu_f(w[0][2 * q + 1] * bfhi(X[k][q]) + w[1][2 * q + 1] * bfhi(X[k + 1][q]) + w[2][2 * q + 1] * bfhi(X[k + 2][q]));
        }
        if (c < 2048) {
          float ss = 0.f;
#pragma unroll
          for (int q = 0; q < 8; ++q) ss += v[q] * v[q];
          ss += __shfl_xor(ss, 1); ss += __shfl_xor(ss, 2); ss += __shfl_xor(ss, 4); ss += __shfl_xor(ss, 8);
          float sc = rsqrtf(ss + 1e-6f);
          if (c < 1024) sc *= 0.08838834764831845f;
#pragma unroll
          for (int q = 0; q < 8; ++q) v[q] *= sc;
        }
        u32x4 o;
#pragma unroll
        for (int q = 0; q < 4; ++q) o[q] = pack2(v[2 * q], v[2 * q + 1]);
        *(u32x4*)(p.A + (size_t)(t + k) * 4096 + c) = o;
      }
    }
  }
  const int gtid = blockIdx.x * NT + tid, gsz = gridDim.x * NT;
  for (int it = gtid; it < T_TOK * 16; it += gsz) {
    const int t = it >> 4, dh = it & 15;
    const float a_raw = p.small[(size_t)t * 64 + dh], b_raw = p.small[(size_t)t * 64 + 16 + dh];
    const float logg = -__expf(p.gdn_a_log[dh]) * softplus_f(a_raw + p.gdn_dt_bias[dh]);
    p.small2[(size_t)t * 128 + dh] = logg;
    p.small2[(size_t)t * 128 + 16 + dh] = sigmoid_f(b_raw);
  }
}

template <int DIR>
__device__ __forceinline__ void gdn_solve(const float* Ms, const float* csb, bf16_t* Tt0, int wave, int lane) {
  const int part = lane >> 4, cidx = (wave & 3) * 16 + (lane & 15);
  const float* mb = Ms + DIR * 64 * 65 + (DIR ? -part : part);
  float Tr[16];
#pragma unroll
  for (int k = 0; k < 16; ++k) Tr[k] = 0.f;
#pragma unroll
  for (int s = 0; s < 64; ++s) {
    const int i = DIR ? 63 - s : s;
    float a0 = 0.f, a1 = 0.f, a2 = 0.f, a3 = 0.f;
#pragma unroll
    for (int k = 0; 4 * k < s; ++k) {
      const float mv = mb[i * 65 + (DIR ? 63 - 4 * k : 4 * k)];
      if ((k & 3) == 0) a0 -= mv * Tr[k]; else if ((k & 3) == 1) a1 -= mv * Tr[k]; else if ((k & 3) == 2) a2 -= mv * Tr[k]; else a3 -= mv * Tr[k];
    }
    float acc = (a0 + a1) + (a2 + a3);
    acc += __shfl_xor(acc, 16); acc += __shfl_xor(acc, 32);
    const float tv = ((cidx == i) ? 1.f : 0.f) + acc;
    Tr[s >> 2] = ((s & 3) == part) ? tv : Tr[s >> 2];
    if ((s & 3) == 3) asm volatile("" ::: "memory");
  }
  const float bl = csb[128 + DIR * 64 + cidx];
  bf16_t* Tt = Tt0 + kperm(cidx) + (DIR ? -part : part) * 64;
#pragma unroll
  for (int k = 0; k < 16; ++k) Tt[(DIR ? 63 - 4 * k : 4 * k) * 64] = f2bf(Tr[k] * bl);
}

#define GDN_MS 68
template <int DIR>
__device__ __forceinline__ void gdn_solve_col(const float* Ms, const float* csb, bf16_t* Tt0, int lane) {
  typedef float f32x2 __attribute__((ext_vector_type(2)));
  const float* mb = Ms + DIR * 64 * GDN_MS;
  f32x2 X[32];
#pragma unroll
  for (int k = 0; k < 32; ++k) X[k] = (f32x2){0.f, 0.f};
  f32x4 A[8], B[8], An[8];
#pragma unroll
  for (int s = 0; s < 64; ++s) {
    const int i = DIR ? 63 - s : s;
    const int ng = (s + 3) >> 2, nA = ng < 8 ? ng : 8, ngn = (s + 4) >> 2, nAn = (s + 1 < 64) ? (ngn < 8 ? ngn : 8) : 0;
#pragma unroll
    for (int k = 8; k < 16; ++k) if (k < ng) B[k - 8] = *(const f32x4*)(mb + i * GDN_MS + (DIR ? 60 - 4 * k : 4 * k));
    asm volatile("" ::: "memory");
    f32x2 a01 = {0.f, 0.f}, a23 = {0.f, 0.f};
#pragma unroll
    for (int k = 0; k < 8; ++k) if (k < nA) {
      const f32x2 mlo = DIR ? (f32x2){A[k][3], A[k][2]} : (f32x2){A[k][0], A[k][1]}, mhi = DIR ? (f32x2){A[k][1], A[k][0]} : (f32x2){A[k][2], A[k][3]};
      a01 -= mlo * X[2 * k]; a23 -= mhi * X[2 * k + 1];
    }
    {
      const int in = DIR ? 62 - s : s + 1;
#pragma unroll
      for (int k = 0; k < 8; ++k) if (k < nAn) An[k] = *(const f32x4*)(mb + in * GDN_MS + (DIR ? 60 - 4 * k : 4 * k));
    }
    asm volatile("" ::: "memory");
#pragma unroll
    for (int k = 8; k < 16; ++k) if (k < ng) {
      const f32x2 mlo = DIR ? (f32x2){B[k - 8][3], B[k - 8][2]} : (f32x2){B[k - 8][0], B[k - 8][1]}, mhi = DIR ? (f32x2){B[k - 8][1], B[k - 8][0]} : (f32x2){B[k - 8][2], B[k - 8][3]};
      a01 -= mlo * X[2 * k]; a23 -= mhi * X[2 * k + 1];
    }
    const f32x2 a = a01 + a23;
    X[s >> 1][s & 1] = ((lane == s) ? 1.f : 0.f) + (a[0] + a[1]);
#pragma unroll
    for (int k = 0; k < 8; ++k) if (k < nAn) A[k] = An[k];
  }
  const int cidx = DIR ? 63 - lane : lane;
  const float bl = csb[128 + DIR * 64 + cidx];
  bf16_t* Tt = Tt0 + kperm(cidx);
#pragma unroll
  for (int s = 0; s < 64; ++s) Tt[(DIR ? 63 - s : s) * 64] = f2bf(X[s >> 1][s & 1] * bl);
}

__device__ __forceinline__ void ph_gdn_tiles(const P& p, unsigned char* shm) {
  const int tid = tidw(p.wq), wave = tid >> 6, lane = tid & 63;
  float* KK = (float*)shm;
  float* QK = KK + 64 * GDN_MS;
  float* MsB = QK + 64 * GDN_MS;
  float* csb = MsB + 4 * 64 * GDN_MS;
  bf16_t* Kt = (bf16_t*)(csb + 1024);
  bf16_t* Qt = Kt + 64 * 136;
  bf16_t* TP = p.H; bf16_t* AI = p.H + (size_t)3072 * 4096;
  const float* cw = p.gdn_conv_w;
  const int cgi = tid & 63, to = tid >> 6;
  const int G = (int)gridDim.x;
#define GDN_SCAN(itm_, csbp_, dsel_) do { const int dir = (dsel_), tk = dir ? 63 - lane : lane; const size_t t = (size_t)((itm_) >> 3) * 64 + tk; const int dh = dir * 8 + ((itm_) & 7); \
      const float a_raw = p.small[t * 64 + dh], b_raw = p.small[t * 64 + 16 + dh]; \
      const float cs = wave_scan_incl(-__expf(p.gdn_a_log[dh]) * softplus_f(a_raw + p.gdn_dt_bias[dh])); \
      const float bt = sigmoid_f(b_raw); \
      (csbp_)[dir * 64 + tk] = cs; (csbp_)[128 + dir * 64 + tk] = bt; \
      p.VEC[(size_t)((itm_) * 2 + dir) * 64 + tk] = cs; } while (0)
  auto ai_gather = [&](int item, const float* csbc, int t2, int nthr) {
    for (int q = t2; q < 1024; q += nthr) {
      const int dir = q >> 9, i = (q >> 3) & 63, m = q & 7;
      const float ci = csbc[dir * 64 + i];
      float v[8];
#pragma unroll
      for (int e = 0; e < 8; ++e) {
        const int jx = kperm(8 * m + e);
        const bool incl = dir ? (jx >= i) : (jx <= i);
        v[e] = incl ? QK[i * GDN_MS + jx] * __expf(ci - csbc[dir * 64 + jx]) : 0.f;
      }
      const u32x4 o = {cvt2(v[0], v[1]), cvt2(v[2], v[3]), cvt2(v[4], v[5]), cvt2(v[6], v[7])};
      *(u32x4*)(AI + (size_t)(item * 2 + dir) * 4096 + i * 64 + 8 * m) = o;
    }
    for (int q = t2; q < 1024; q += nthr) { const int d = q >> 3, cc = q & 7;
      unsigned short v[8];
#pragma unroll
      for (int qq = 0; qq < 8; ++qq) v[qq] = Kt[kperm(cc * 8 + qq) * 136 + d];
      u32x4 o = {(unsigned)v[0] | ((unsigned)v[1] << 16), (unsigned)v[2] | ((unsigned)v[3] << 16), (unsigned)v[4] | ((unsigned)v[5] << 16), (unsigned)v[6] | ((unsigned)v[7] << 16)};
      *(u32x4*)(p.BT + (size_t)item * 8192 + d * 64 + cc * 8) = o; }
  };
  auto prefetch_rows = [&](int nxt, int l2) {
    const int tokn = (nxt >> 3) * 64, hdn = nxt & 7;
    const bf16_t* pa[5];
#pragma unroll
    for (int jj = 0; jj < 5; ++jj) {
      int idx = l2 + 128 * jj; idx = idx < 528 ? idx : 527;
      const int row = idx >> 3, seg = idx & 7;
      int tr = tokn - 1 + row; tr = tr < 0 ? 0 : (tr > T_TOK - 1 ? T_TOK - 1 : tr);
      const int eo = (seg < 2) ? (hdn * 128 + seg * 64) : ((seg < 4) ? (1024 + hdn * 128 + (seg - 2) * 64) : (2048 + hdn * 256 + (seg - 4) * 64));
      pa[jj] = p.Pxbc + (size_t)tr * 4096 + eo;
    }
    unsigned d0, d1, d2, d3, d4;
    asm volatile("global_load_dword %0, %5, off\n\tglobal_load_dword %1, %6, off\n\tglobal_load_dword %2, %7, off\n\tglobal_load_dword %3, %8, off\n\tglobal_load_dword %4, %9, off\n\ts_waitcnt vmcnt(0)"
                 : "=&v"(d0), "=&v"(d1), "=&v"(d2), "=&v"(d3), "=&v"(d4) : "v"(pa[0]), "v"(pa[1]), "v"(pa[2]), "v"(pa[3]), "v"(pa[4]) : "memory");
  };
  if (wave >= 6) {
    if ((int)blockIdx.x < 192 * 8) GDN_SCAN((int)blockIdx.x, csb, wave - 6);
    if ((int)blockIdx.x + G < 192 * 8) GDN_SCAN((int)blockIdx.x + G, csb + 256, wave - 6);
  }
  int itn = 0;
  for (int item0 = blockIdx.x; item0 < 192 * 8; item0 += 2 * G, ++itn) {
    float* csbp = csb + (itn & 1) * 512; float* csbn = csb + ((itn + 1) & 1) * 512;
    const bool has_b = item0 + G < 192 * 8;
#pragma nounroll
    for (int e = 0; e < 2; ++e) {
      if (e == 1 && !has_b) break;
      const int item = item0 + e * G;
      const int c = item >> 3, hd = item & 7, tok0 = c * 64;
      float* Ms = MsB + e * 2 * 64 * GDN_MS; const float* csbc = csbp + e * 256;
      {
        const int chg = (cgi < 16) ? (hd * 128 + cgi * 8) : ((cgi < 32) ? (1024 + hd * 128 + (cgi - 16) * 8) : (2048 + hd * 256 + (cgi - 32) * 8));
        float w[3][8];
#pragma unroll
        for (int k = 0; k < 3; ++k) { const f32x4 w0 = *(const f32x4*)(cw + k * 4096 + chg), w1 = *(const f32x4*)(cw + k * 4096 + chg + 4);
          w[k][0] = w0[0]; w[k][1] = w0[1]; w[k][2] = w0[2]; w[k][3] = w0[3]; w[k][4] = w1[0]; w[k][5] = w1[1]; w[k][6] = w1[2]; w[k][7] = w1[3]; }
        int t0, L, cond; tok_info(tok0, t0, L, cond);
        const int posb = tok0 - t0 + 8 * to - 1;
        const bf16_t* srcp = p.Pxbc + (size_t)(tok0 + 8 * to - 1) * 4096 + chg;
        const u32x4 z4 = {0u, 0u, 0u, 0u};
        u32x4 X[10];
#pragma unroll
        for (int r = 0; r < 10; ++r) X[r] = (posb + r >= 0 && posb + r < L) ? *(const u32x4*)(srcp + (size_t)r * 4096) : z4;
#pragma unroll
        for (int k = 0; k < 8; ++k) {
          float v[8];
#pragma unroll
          for (int q = 0; q < 4; ++q) {
            v[2 * q] = silu_f(w[0][2 * q] * bflo(X[k][q]) + w[1][2 * q] * bflo(X[k + 1][q]) + w[2][2 * q] * bflo(X[k + 2][q]));
            v[2 * q + 1] = silu_f(w[0][2 * q + 1] * bfhi(X[k][q]) + w[1][2 * q + 1] * bfhi(X[k + 1][q]) + w[2][2 * q + 1] * bfhi(X[k + 2][q]));
          }
          if (cgi < 32) {
            float ss = 0.f;
#pragma unroll
            for (int q = 0; q < 8; ++q) ss += v[q] * v[q];
            ss = row16_allsum(ss);
            float sc = rsqrtf(ss + 1e-6f);
            if (cgi < 16) sc *= 0.08838834764831845f;
#pragma unroll
            for (int q = 0; q < 8; ++q) v[q] *= sc;
          }
          u32x4 o;
#pragma unroll
          for (int q = 0; q < 4; ++q) o[q] = pack2(v[2 * q], v[2 * q + 1]);
          *(u32x4*)(p.A + (size_t)(tok0 + 8 * to + k) * 4096 + chg) = o;
          if (cgi < 16) *(u32x4*)(Qt + (8 * to + k) * 136 + cgi * 8) = o;
          else if (cgi < 32) *(u32x4*)(Kt + (8 * to + k) * 136 + (cgi - 16) * 8) = o;
        }
      }
      __syncthreads();
      {
        const int which = wave >> 2, ti = (wave >> 1) & 1, tj = wave & 1, col = lane & 31, h = lane >> 5;
        f32x16 acc;
#pragma unroll
        for (int r = 0; r < 16; ++r) acc[r] = 0.f;
        const bf16_t* ap = (which ? Qt : Kt) + (32 * ti + col) * 136 + 8 * h;
        const bf16_t* bp = Kt + (32 * tj + col) * 136 + 8 * h;
#pragma unroll
        for (int s = 0; s < 8; ++s) acc = MFMA32(*(const bf16x8*)(ap + 16 * s), *(const bf16x8*)(bp + 16 * s), acc);
        float* dst = which ? QK : KK;
#pragma unroll
        for (int r = 0; r < 16; ++r) dst[(32 * ti + (r & 3) + 8 * (r >> 2) + 4 * h) * GDN_MS + 32 * tj + col] = acc[r];
      }
      __syncthreads();
      for (int idx = tid; idx < 2 * 4096; idx += NT) {
        const int dir = idx >> 12, i = (idx >> 6) & 63, jx = idx & 63;
        const float ci = csbc[dir * 64 + i], cj = csbc[dir * 64 + jx];
        const bool before = dir ? (jx > i) : (jx < i);
        Ms[(dir * 64 + i) * GDN_MS + jx] = before ? csbc[128 + dir * 64 + i] * KK[i * GDN_MS + jx] * __expf(ci - cj) : 0.f;
      }
      __syncthreads();
      if (e == 0 && has_b) {
        ai_gather(item, csbc, tid, NT);
        __syncthreads();
      }
    }
    const int last = has_b ? 1 : 0;
    if (wave < 4) {
      const int e = wave >> 1;
      if (e <= last) {
        const float* Ms = MsB + e * 2 * 64 * GDN_MS; const float* csbc = csbp + e * 256; const int item = item0 + e * G;
        if (wave & 1) gdn_solve_col<1>(Ms, csbc, TP + (size_t)(item * 2 + 1) * 4096, lane);
        else gdn_solve_col<0>(Ms, csbc, TP + (size_t)(item * 2) * 4096, lane);
      }
    } else if (wave < 6) {
      ai_gather(item0 + last * G, csbp + last * 256, tid - 256, 128);
    } else {
      const int n0 = item0 + 2 * G, n1 = n0 + G;
      if (n0 < 192 * 8) { GDN_SCAN(n0, csbn, wave - 6); prefetch_rows(n0, tid - 384); }
      if (n1 < 192 * 8) { GDN_SCAN(n1, csbn + 256, wave - 6); prefetch_rows(n1, tid - 384); }
    }
    __syncthreads();
  }
}

#define GDN_OFF_K 0
#define GDN_OFF_Q 17408
#define GDN_OFF_KT 34816
#define GDN_OFF_T 53248
#define GDN_OFF_A 62464
#define GDN_OFF_CS 71680
#define GDN_BUF 71936
__device__ __forceinline__ void ph_gdn_chain(const P& p, lds_u8* lds) {
  const int tid = tidw(p.wq), wave = __builtin_amdgcn_readfirstlane(tid >> 6), lane = tid & 63, col = lane & 31, h = lane >> 5;
  const bool consumer = wave < 4;
  const int ltid = tid - 256;
  float* out_state = p.out + (size_t)T_TOK * DM + 16777216 + 4194304;
  const bf16_t* TP = p.H; const bf16_t* AI = p.H + (size_t)3072 * 4096;
  const int nlat = 64, nitem = 576, G = (int)gridDim.x;
  const int stride = ((int)blockIdx.x < nlat) ? nitem : (G - nlat);
  for (int item = (int)blockIdx.x; item < nitem; item += stride) {
    int seq, dir, hd, half;
    if (item < 64) { const int x = item & 7, k = item >> 3, cmb = (k >> 1) * 8 + x; half = k & 1; seq = 16 + (cmb >> 4); dir = (cmb >> 3) & 1; hd = cmb & 7; }
    else { const int i2 = item - 64, x = i2 & 7, kk = i2 >> 3, cmb = (kk >> 1) * 8 + x; half = kk & 1; seq = cmb >> 4; dir = (cmb >> 3) & 1; hd = cmb & 7; }
    int chunk0, nch; if (seq < 16) { chunk0 = seq * 4; nch = 4; } else { chunk0 = 64 + (seq - 16) * 64; nch = 64; }
    if (!consumer) {
      const int lrow = ltid >> 4, lc16 = ltid & 15, lc8 = ltid & 7;
      u32x4 RK[2][4], RQ[2][4], RKT[2][4], RT[2][2], RA[2][2]; float RC[2][13];
      const unsigned lo_kq = (unsigned)(((ltid >> 4) * 4096 + (ltid & 15) * 8) * 2), lo_t = (unsigned)(ltid * 16), lo_c = (unsigned)(lrow * 4), lo_c8 = (unsigned)((16 * (lc8 >> 1) + 4 * (lc8 & 1)) * 4);
#define GDN_LLOAD(set, stepn) do { const int c_ = chunk0 + (dir ? nch - 1 - (stepn) : (stepn)); const size_t tix_ = (size_t)((c_ * 8 + hd) * 2 + dir); \
        const char* qb_ = (const char*)(p.A + (size_t)c_ * 64 * 4096 + hd * 128); const char* kb_ = qb_ + 2048; \
        const char* KTt_ = (const char*)(p.BT + (size_t)(c_ * 8 + hd) * 8192); const char* Tt_ = (const char*)(TP + tix_ * 4096); const char* At_ = (const char*)(AI + tix_ * 4096); \
        const char* cs_ = (const char*)(p.VEC + tix_ * 64); \
        _Pragma("unroll") for (int i = 0; i < 4; ++i) { \
          RK[set][i] = *(const u32x4*)(kb_ + i * 131072 + lo_kq); RQ[set][i] = *(const u32x4*)(qb_ + i * 131072 + lo_kq); \
          RKT[set][i] = *(const u32x4*)(KTt_ + i * 4096 + lo_t); RC[set][1 + i] = *(const float*)(cs_ + i * 64 + lo_c); } \
        _Pragma("unroll") for (int i = 0; i < 2; ++i) { RT[set][i] = *(const u32x4*)(Tt_ + i * 4096 + lo_t); RA[set][i] = *(const u32x4*)(At_ + i * 4096 + lo_t); } \
        RC[set][0] = *(const float*)(cs_ + (dir ? 0 : 252)); \
        { const f32x4 a_ = *(const f32x4*)(cs_ + lo_c8), b_ = *(const f32x4*)(cs_ + 32 + lo_c8); \
          RC[set][5] = a_[0]; RC[set][6] = a_[1]; RC[set][7] = a_[2]; RC[set][8] = a_[3]; RC[set][9] = b_[0]; RC[set][10] = b_[1]; RC[set][11] = b_[2]; RC[set][12] = b_[3]; } } while (0)
#define GDN_LWRITE(set, bufi) do { lds_u8* buf = lds + (bufi) * GDN_BUF; \
        const float cs_tot = RC[set][0]; float ks[8]; \
        _Pragma("unroll") for (int e = 0; e < 8; ++e) ks[e] = __expf(cs_tot - RC[set][5 + e]); \
        const int p0 = grp_pos_bytes(2 * lc16), p1 = grp_pos_bytes(2 * lc16 + 1); \
        _Pragma("unroll") for (int i = 0; i < 4; ++i) { \
          const float ec = __expf(RC[set][1 + i]); const int row = lrow + 16 * i; \
          const u32x4 kk = scale8(RK[set][i], -ec, -ec, -ec, -ec, -ec, -ec, -ec, -ec); \
          const u32x4 qq = scale8(RQ[set][i], ec, ec, ec, ec, ec, ec, ec, ec); \
          *(LAS u32x2*)(buf + GDN_OFF_K + row * 272 + p0) = (u32x2){kk[0], kk[1]}; \
          *(LAS u32x2*)(buf + GDN_OFF_K + row * 272 + p1) = (u32x2){kk[2], kk[3]}; \
          *(LAS u32x2*)(buf + GDN_OFF_Q + row * 272 + p0) = (u32x2){qq[0], qq[1]}; \
          *(LAS u32x2*)(buf + GDN_OFF_Q + row * 272 + p1) = (u32x2){qq[2], qq[3]}; \
          const int q = ltid + 256 * i; \
          *(LAS u32x4*)(buf + GDN_OFF_KT + (q >> 3) * 144 + (q & 7) * 16) = scale8(RKT[set][i], ks[0], ks[1], ks[2], ks[3], ks[4], ks[5], ks[6], ks[7]); } \
        _Pragma("unroll") for (int i = 0; i < 2; ++i) { const int q = ltid + 256 * i; \
          *(LAS u32x4*)(buf + GDN_OFF_T + (q >> 3) * 144 + (q & 7) * 16) = RT[set][i]; \
          *(LAS u32x4*)(buf + GDN_OFF_A + (q >> 3) * 144 + (q & 7) * 16) = RA[set][i]; } \
        if (ltid == 0) *(LAS float*)(buf + GDN_OFF_CS) = __expf(cs_tot); } while (0)
      GDN_LLOAD(0, 0);
      if (nch > 1) GDN_LLOAD(1, 1);
      for (int it = 0; it <= nch; it += 2) {
        if (it < nch) GDN_LWRITE(0, 0);
        if (it + 2 < nch) GDN_LLOAD(0, it + 2);
        CH_BARRIER();
        if (it + 1 <= nch) {
          if (it + 1 < nch) GDN_LWRITE(1, 1);
          if (it + 3 < nch) GDN_LLOAD(1, it + 3);
          CH_BARRIER();
        }
      }
    } else {
      const int ecol = (half * 4 + (wave & 3)) * 32 + col;
      f32x16 S[4];
      f32x16 XX[2];
      if (seq >= 16) {
        const float* s = p.state_gdn + (((size_t)(seq - 16) * 2 + dir) * 8 + hd) * 32768 + ecol;
#pragma unroll
        for (int db = 0; db < 4; ++db)
#pragma unroll
          for (int r = 0; r < 16; ++r) S[db][r] = s[(32 * db + (r & 3) + 8 * (r >> 2) + 4 * h) * 256];
      } else {
#pragma unroll
        for (int db = 0; db < 4; ++db)
#pragma unroll
          for (int r = 0; r < 16; ++r) S[db][r] = 0.f;
      }
      bf16x8 vr[2][2];
      const int vcol0 = 2048 + hd * 256 + (half * 4 + (wave & 3)) * 32 + 8 * h;
      {
        const int c0 = chunk0 + (dir ? nch - 1 : 0);
#pragma unroll
        for (int t = 0; t < 2; ++t)
#pragma unroll
          for (int s = 0; s < 2; ++s) vr[t][s] = *(const bf16x8*)(p.A + (size_t)(c0 * 64 + 32 * t + col) * 4096 + vcol0 + 16 * s);
      }
      for (int it = 0; it <= nch; ++it) {
        if (it >= 1) {
          const int step = it - 1;
        const int c = chunk0 + (dir ? nch - 1 - step : step), tok0 = c * 64;
        const lds_u8* buf = lds + (step & 1) * GDN_BUF;
        bf16_t* Ob = p.Pxbc + ((size_t)dir * T_TOK + tok0) * 2048 + hd * 256 + 4 * h * 2048 + ecol;
        bf16x8 Sb[8];
#pragma unroll
        for (int db = 0; db < 4; ++db) { Sb[2 * db] = pack_half(S[db], 0); Sb[2 * db + 1] = pack_half(S[db], 1); }
        f32x16 Q1[2];
#pragma unroll
        for (int t = 0; t < 2; ++t)
#pragma unroll
          for (int r = 0; r < 16; ++r) { Q1[t][r] = 0.f; XX[t][r] = 0.f; }
#pragma unroll
        for (int sg = 0; sg < 4; ++sg) {
          bf16x8 ka[2][2], qa[2][2];
#pragma unroll
          for (int t = 0; t < 2; ++t)
#pragma unroll
            for (int s2 = 0; s2 < 2; ++s2) {
              ka[t][s2] = *(const LAS bf16x8*)(buf + GDN_OFF_K + (32 * t + col) * 272 + 32 * (2 * sg + s2) + 16 * h);
              qa[t][s2] = *(const LAS bf16x8*)(buf + GDN_OFF_Q + (32 * t + col) * 272 + 32 * (2 * sg + s2) + 16 * h);
            }
#pragma unroll
          for (int s2 = 0; s2 < 2; ++s2) {
            XX[0] = MFMA32(ka[0][s2], Sb[2 * sg + s2], XX[0]);
            XX[1] = MFMA32(ka[1][s2], Sb[2 * sg + s2], XX[1]);
            Q1[0] = MFMA32(qa[0][s2], Sb[2 * sg + s2], Q1[0]);
            Q1[1] = MFMA32(qa[1][s2], Sb[2 * sg + s2], Q1[1]);
          }
        }
        { int cx = col - 8 * h; asm volatile("" : "+v"(cx));
#pragma unroll
          for (int s = 0; s < 2; ++s) { u32x4 u;
#pragma unroll
            for (int q = 0; q < 4; ++q) { const int k0 = 16 * s + 2 * q; u[q] = ((cx == k0) ? 0x3F80u : 0u) | ((cx == k0 + 1) ? 0x3F800000u : 0u); }
            const bf16x8 Id = __builtin_bit_cast(bf16x8, u);
            XX[0] = MFMA32(vr[0][s], Id, XX[0]); XX[1] = MFMA32(vr[1][s], Id, XX[1]); } }
        bf16x8 Xb[4];
#pragma unroll
        for (int t = 0; t < 2; ++t) { Xb[2 * t] = pack_half(XX[t], 0); Xb[2 * t + 1] = pack_half(XX[t], 1); }
        f32x16 Vn[2];
        {
          bf16x8 ta[2][4];
#pragma unroll
          for (int t = 0; t < 2; ++t) {
#pragma unroll
            for (int r = 0; r < 16; ++r) Vn[t][r] = 0.f;
#pragma unroll
            for (int s = 0; s < 4; ++s) ta[t][s] = *(const LAS bf16x8*)(buf + GDN_OFF_T + (32 * t + col) * 144 + 32 * s + 16 * h);
          }
#pragma unroll
          for (int s = 0; s < 4; ++s) { Vn[0] = MFMA32(ta[0][s], Xb[s], Vn[0]); Vn[1] = MFMA32(ta[1][s], Xb[s], Vn[1]); }
        }
        bf16x8 Vnb[4];
#pragma unroll
        for (int t = 0; t < 2; ++t) { Vnb[2 * t] = pack_half(Vn[t], 0); Vnb[2 * t + 1] = pack_half(Vn[t], 1); }
        {
          bf16x8 aa[2][4];
#pragma unroll
          for (int t = 0; t < 2; ++t)
#pragma unroll
            for (int s = 0; s < 4; ++s) aa[t][s] = *(const LAS bf16x8*)(buf + GDN_OFF_A + (32 * t + col) * 144 + 32 * s + 16 * h);
#pragma unroll
          for (int s = 0; s < 4; ++s) { Q1[0] = MFMA32(aa[0][s], Vnb[s], Q1[0]); Q1[1] = MFMA32(aa[1][s], Vnb[s], Q1[1]); }
        }
#pragma unroll
        for (int t = 0; t < 2; ++t) {
#pragma unroll
          for (int r = 0; r < 16; r += 2) {
            const unsigned pk = cvt2(Q1[t][r], Q1[t][r + 1]);
            Ob[(size_t)(32 * t + (r & 3) + 8 * (r >> 2)) * 2048] = (bf16_t)(pk & 0xffffu);
            Ob[(size_t)(32 * t + ((r + 1) & 3) + 8 * ((r + 1) >> 2)) * 2048] = (bf16_t)(pk >> 16);
          }
        }
        if (step + 1 < nch) {
          const int cn = chunk0 + (dir ? nch - 2 - step : step + 1);
#pragma unroll
          for (int t = 0; t < 2; ++t)
#pragma unroll
            for (int s = 0; s < 2; ++s) vr[t][s] = *(const bf16x8*)(p.A + (size_t)(cn * 64 + 32 * t + col) * 4096 + vcol0 + 16 * s);
        }
        const float dec = *(const __attribute__((address_space(3))) float*)(buf + GDN_OFF_CS);
#pragma unroll
        for (int db = 0; db < 4; ++db)
#pragma unroll
          for (int r = 0; r < 16; ++r) S[db][r] *= dec;
#pragma unroll
        for (int sp = 0; sp < 2; ++sp) {
          bf16x8 kb[4][2];
#pragma unroll
          for (int db = 0; db < 4; ++db)
#pragma unroll
            for (int s2 = 0; s2 < 2; ++s2) kb[db][s2] = *(const LAS bf16x8*)(buf + GDN_OFF_KT + (32 * db + col) * 144 + 32 * (2 * sp + s2) + 16 * h);
#pragma unroll
          for (int s2 = 0; s2 < 2; ++s2)
#pragma unroll
            for (int db = 0; db < 4; ++db) S[db] = MFMA32(kb[db][s2], Vnb[2 * sp + s2], S[db]);
        }
        }
        CH_BARRIER();
      }
      if (seq < 16) {
        float* d_ = out_state + (((size_t)seq * 2 + dir) * 8 + hd) * 32768 + ecol;
#pragma unroll
        for (int db = 0; db < 4; ++db)
#pragma unroll
          for (int r = 0; r < 16; ++r) d_[(32 * db + (r & 3) + 8 * (r >> 2) + 4 * h) * 256] = S[db][r];
      }
    }
  }
}

__device__ __forceinline__ void ph_ffn_glu(const P& p, int layer, unsigned char* shm) {
  const int tid = tidw(p.wq);
  const bf16_t* Pa = p.Pz; const bf16_t* Pv = p.Pz + (size_t)T_TOK * DFF;
  const float* cw = p.ffn_conv_w + (size_t)layer * 9 * DFF; const float* cb = p.ffn_conv_b + (size_t)layer * DFF;
  float* wl = (float*)shm;
  for (int i = tid; i < 9 * DFF / 4; i += NT) *(f32x4*)(wl + i * 4) = *(const f32x4*)(cw + i * 4);
  for (int i = tid; i < DFF / 4; i += NT) *(f32x4*)(wl + 9 * DFF + i * 4) = *(const f32x4*)(cb + i * 4);
  __syncthreads();
  const int ngrp = T_TOK / 4, per = (ngrp + (int)gridDim.x - 1) / (int)gridDim.x;
  const int gbeg = (int)blockIdx.x * per, gend = (gbeg + per < ngrp) ? gbeg + per : ngrp;
  const int nitems = (gend - gbeg) * (DFF / 8);
  const u32x4 z4 = {0u, 0u, 0u, 0u};
  for (int it = tid; it < nitems; it += NT) {
    const int gi = gbeg + it / (DFF / 8), c = (it % (DFF / 8)) * 8;
    const int t = gi * 4;
    const bool lat = t >= T_CTX;
    const int pos = lat ? ((t - T_CTX) & 4095) : (t & 255);
    const int W = lat ? 64 : 256;
    const int col = lat ? (pos & 63) : pos, row = lat ? (pos >> 6) : 0;
    u32x4 A[3][6], vv[4];
#pragma unroll
    for (int iy = 0; iy < 3; ++iy) {
      const bool rok = lat ? (row + iy - 1 >= 0 && row + iy - 1 < 64) : (iy == 1);
#pragma unroll
      for (int jx = 0; jx < 6; ++jx) {
        const int cc = col + jx - 1;
        A[iy][jx] = (rok && cc >= 0 && cc < W) ? *(const u32x4*)(Pa + (size_t)(t + (iy - 1) * 64 + jx - 1) * DFF + c) : z4;
      }
    }
#pragma unroll
    for (int k = 0; k < 4; ++k) vv[k] = *(const u32x4*)(Pv + (size_t)(t + k) * DFF + c);
    float acc[4][8];
    { const f32x4 b0 = *(const f32x4*)(wl + 9 * DFF + c), b1 = *(const f32x4*)(wl + 9 * DFF + c + 4);
#pragma unroll
      for (int k = 0; k < 4; ++k) { acc[k][0] = b0[0]; acc[k][1] = b0[1]; acc[k][2] = b0[2]; acc[k][3] = b0[3]; acc[k][4] = b1[0]; acc[k][5] = b1[1]; acc[k][6] = b1[2]; acc[k][7] = b1[3]; } }
#pragma unroll
    for (int iy = 0; iy < 3; ++iy)
#pragma unroll
      for (int jx = 0; jx < 3; ++jx) {
        const f32x4 w0 = *(const f32x4*)(wl + (iy * 3 + jx) * DFF + c), w1 = *(const f32x4*)(wl + (iy * 3 + jx) * DFF + c + 4);
#pragma unroll
        for (int k = 0; k < 4; ++k) {
          const u32x4 a = A[iy][k + jx];
          acc[k][0] += w0[0] * bflo(a[0]); acc[k][1] += w0[1] * bfhi(a[0]); acc[k][2] += w0[2] * bflo(a[1]); acc[k][3] += w0[3] * bfhi(a[1]);
          acc[k][4] += w1[0] * bflo(a[2]); acc[k][5] += w1[1] * bfhi(a[2]); acc[k][6] += w1[2] * bflo(a[3]); acc[k][7] += w1[3] * bfhi(a[3]);
        }
      }
#pragma unroll
    for (int k = 0; k < 4; ++k) {
      u32x4 o;
#pragma unroll
      for (int q = 0; q < 4; ++q) o[q] = pack2(silu_f(acc[k][2 * q]) * bflo(vv[k][q]), silu_f(acc[k][2 * q + 1]) * bfhi(vv[k][q]));
      *(u32x4*)(p.H + (size_t)(t + k) * DFF + c) = o;
    }
  }
  __syncthreads();
}

__device__ __forceinline__ void ph_final_norm(const P& p) {
  const int wave = tidw(p.wq) >> 6, lane = tidw(p.wq) & 63;
  const int gw = blockIdx.x * 8 + wave, nwv = gridDim.x * 8;
  for (int tb = gw; tb < T_TOK; tb += 3 * nwv) {
    f32x4 v[3][4]; float ss[3];
#pragma unroll
    for (int j = 0; j < 3; ++j) {
      const int t = tb + j * nwv; ss[j] = 0.f;
      if (t < T_TOK) {
        const float* xr = p.out + (size_t)t * DM;
#pragma unroll
        for (int i = 0; i < 4; ++i) v[j][i] = *(const f32x4*)(xr + i * 256 + lane * 4);
      }
    }
#pragma unroll
    for (int j = 0; j < 3; ++j) {
      const int t = tb + j * nwv;
      if (t < T_TOK) {
#pragma unroll
        for (int i = 0; i < 4; ++i) ss[j] += v[j][i][0] * v[j][i][0] + v[j][i][1] * v[j][i][1] + v[j][i][2] * v[j][i][2] + v[j][i][3] * v[j][i][3];
        const float rstd = rsqrtf(wave_sum(ss[j]) * (1.f / DM) + EPS);
        float* xr = p.out + (size_t)t * DM;
#pragma unroll
        for (int i = 0; i < 4; ++i) {
          const f32x4 w = *(const f32x4*)(p.final_norm_w + i * 256 + lane * 4);
          f32x4 o = v[j][i] * rstd * w;
          *(f32x4*)(xr + i * 256 + lane * 4) = o;
        }
      }
    }
  }
}

#define XB_TMO      128
#define XB_XCNT(j)  (256  + 64 * (j))
#define XB_XSUB(j)  (1280 + 64 * (j))
#define XB_XGEN(j)  (2304 + 64 * (j))
#define XB_TOP      3328
#define XB_TOPGEN   3392
#define XCD_BAR_WORDS 3456
#define XB_SPIN_CAP (1u << 18)


__device__ __forceinline__ unsigned xb_ld(unsigned* p)              { return __hip_atomic_load(p, __ATOMIC_RELAXED, __HIP_MEMORY_SCOPE_AGENT); }
__device__ __forceinline__ unsigned xb_add(unsigned* p, unsigned v) { return __hip_atomic_fetch_add(p, v, __ATOMIC_RELAXED, __HIP_MEMORY_SCOPE_AGENT); }
__device__ __forceinline__ unsigned xb_xcc_id() { return (unsigned)__builtin_amdgcn_s_getreg((3 << 11) | 20) & 0xFu; }
#define XB_SPIN(cond, bar) do { unsigned _sp = 0; while (cond) { __builtin_amdgcn_s_sleep(1); \
    if ((++_sp & 255u) == 0u) { if (xb_ld(&(bar)[XB_TMO])) break; if (_sp > XB_SPIN_CAP) { atomicAdd(&(bar)[XB_TMO], 1u); break; } } } } while (0)

struct XcdBarrier {
    unsigned* bar; unsigned x;
    volatile LAS unsigned* st;
};

__device__ __forceinline__ XcdBarrier xcd_barrier_post(unsigned* bar, volatile LAS unsigned* st) {
    XcdBarrier b; b.bar = bar; b.x = xb_xcc_id(); b.st = st;
    if (threadIdx.x == 0) (void)xb_add(&bar[XB_XCNT(b.x)], 1u);
    return b;
}
__device__ __forceinline__ void xcd_barrier_complete(unsigned* bar, unsigned x, unsigned& nloc, unsigned& nx) {
    const unsigned G = gridDim.x * gridDim.y * gridDim.z;
    unsigned sum, cnt, mine, sp = 0u;
    for (;;) {
        sum = 0u; cnt = 0u; mine = 0u;
#pragma unroll
        for (unsigned j = 0; j < 16; ++j) { const unsigned c = xb_ld(&bar[XB_XCNT(j)]); sum += c; cnt += (c > 0u) ? 1u : 0u; mine = (j == x) ? c : mine; }
        if (sum == G) break;
        __builtin_amdgcn_s_sleep(1);
        if ((++sp & 255u) == 0u) { if (xb_ld(&bar[XB_TMO])) break; if (sp > XB_SPIN_CAP) { atomicAdd(&bar[XB_TMO], 1u); break; } }
    }
    nloc = mine > 0u ? mine : 1u; nx = cnt > 0u ? cnt : 1u;
}

__device__ __forceinline__ void xcd_barrier(const XcdBarrier& b) {
    asm volatile("s_waitcnt vmcnt(0)" ::: "memory");
    __syncthreads();
    if (threadIdx.x == 0) {
        unsigned* bar = b.bar;
        __builtin_amdgcn_s_waitcnt(0);
        unsigned nloc = b.st[0], nx = b.st[1];
        if (nloc == 0u) { xcd_barrier_complete(bar, b.x, nloc, nx); b.st[0] = nloc; b.st[1] = nx; }
        const unsigned old = xb_add(&bar[XB_XSUB(b.x)], 1u);
        const unsigned gen = old / nloc;
        if (old + 1u == (gen + 1u) * nloc) {
            __builtin_amdgcn_fence(__ATOMIC_RELEASE, "agent");
            asm volatile("s_waitcnt vmcnt(0)" ::: "memory");
            const unsigned og = xb_add(&bar[XB_TOP], 1u);
            const unsigned tg = og / nx;
            if (og + 1u == (tg + 1u) * nx) xb_add(&bar[XB_TOPGEN], 1u);
            else XB_SPIN(xb_ld(&bar[XB_TOPGEN]) == tg, bar);
            __builtin_amdgcn_fence(__ATOMIC_ACQUIRE, "agent");
            xb_add(&bar[XB_XGEN(b.x)], 1u);
            asm volatile("s_waitcnt vmcnt(0)" ::: "memory");
        } else {
            XB_SPIN(xb_ld(&bar[XB_XGEN(b.x)]) == gen, bar);
            __builtin_amdgcn_fence(__ATOMIC_ACQUIRE, "agent");
            asm volatile("s_waitcnt vmcnt(0)" ::: "memory");
        }
    }
    __syncthreads();
}

typedef const __attribute__((address_space(4))) P* kargp_t;
__device__ __forceinline__ kargp_t getP() {
  kargp_t k = (kargp_t)__builtin_amdgcn_kernarg_segment_ptr();
  asm volatile("" : "+s"(k));
  return k;
}
#if defined(__HIP_DEVICE_COMPILE__)
#define LP() P p = *getP(); p.wq = widx_k
#else
#define LP() P p = p_arg; p.wq = widx_k
#endif

#define GSYNC() do { LP(); XcdBarrier b_; b_.bar = p.bar; b_.x = xb_xcc_id(); b_.st = (volatile LAS unsigned*)(lds + LDS_BYTES - 16); xcd_barrier(b_); } while (0)
__global__ void __launch_bounds__(NT) fwd_megakernel(P p_arg) {
  const int widx_k = __builtin_amdgcn_readfirstlane((int)(threadIdx.x >> 6));
  extern __shared__ __attribute__((aligned(16))) unsigned char shm[];
  float* tile = (float*)shm;
  lds_u8* lds = (lds_u8*)shm;

  volatile LAS unsigned* xst = (volatile LAS unsigned*)(lds + LDS_BYTES - 16);
  if (threadIdx.x == 0) { xst[0] = 0u; xst[1] = 0u; xst[2] = 0u; xst[3] = 0u; }
  __syncthreads();
  { LP(); (void)xcd_barrier_post(p.bar, xst); }
  { LP(); ph_ada_direct(p, 0, 1, shm, (int)blockIdx.x, (int)gridDim.x); }
  { LP(); ph_convert(p, 0, 1, tile, (int)blockIdx.x, (int)gridDim.x); }
  GSYNC();

  {
    constexpr int layer = 0; constexpr int kind = layer % 3, j = layer / 3;
    if constexpr (layer == 0) { { LP(); ph_norm_mod<true>(p, p.norm_mix_w + layer * DM, p.mod + (size_t)layer * 3 * 6144, 0, 1024, p.H); }
      GSYNC(); }
    if constexpr (kind == 0) {
      { LP(); gemm_phase8(lds, layer == 0 ? p.H : p.A, p.Win, T_TOK, 6400, DM, EpiSsmIn{p.Pz, p.Pxbc, p.small}, p.wq); }
      if constexpr (layer == 0) { LP(); const int g_ = (int)gridDim.x, b0_ = (g_ >= 192) ? 176 : 0; if ((int)blockIdx.x >= b0_) { ph_convert(p, 0, 2, tile, (int)blockIdx.x - b0_, g_ - b0_); ph_ada_direct(p, 1, 2, shm, (int)blockIdx.x - b0_, g_ - b0_); } }
      GSYNC();
      { LP(); ph_ssm_tiles(p, j, shm); }
      GSYNC();
      { LP(); ph_ssm_chain(p, j, lds); }
      { LP(); if ((int)blockIdx.x >= 128) ph_convert(p, layer, 8, tile, (int)blockIdx.x - 128, (int)gridDim.x - 128); }
      GSYNC();
      { LP(); ph_ssm_post(p, j); }
      GSYNC();
      { LP(); gemm_phase_residnorm192<false>(lds, p.H, p.Wout, 2048, p.out, p.mod + (size_t)layer * 3 * 6144 + 2048, p.adap, p.bar + XCD_BAR_WORDS + (layer * 2) * 4096,
                                             p.norm_ffn_w + layer * DM, p.mod + (size_t)layer * 3 * 6144, 3072, 4096, p.A, p.wq); }
    } else if constexpr (kind == 1) {
      { LP(); gemm_phase8(lds, p.Pxbc + (size_t)T_TOK * 2048, p.Win, T_TOK, 4096, DM, EpiGlaIn{p.A, p.Pz, (float*)p.Pxbc, p.gla_gate_b}, p.wq); }
      GSYNC();
      { LP(); ph_gla_tiles(p, shm); }
      GSYNC();
      { LP(); ph_gla_chain(p, lds); }
      { LP(); if ((int)blockIdx.x >= 64) ph_convert(p, layer, 8, tile, (int)blockIdx.x - 64, (int)gridDim.x - 64); }
      GSYNC();
      { LP(); ph_headnorm_post(p, p.Pxbc + (size_t)T_TOK * 2048, 4, p.gla_norm_w, p.Pz); }
      GSYNC();
      { LP(); gemm_phase_residnorm192<false>(lds, p.H, p.Wout, 1024, p.out, p.mod + (size_t)layer * 3 * 6144 + 2048, p.adap, p.bar + XCD_BAR_WORDS + (layer * 2) * 4096,
                                             p.norm_ffn_w + layer * DM, p.mod + (size_t)layer * 3 * 6144, 3072, 4096, p.A, p.wq); }
    } else {
      { LP(); gemm_phase8(lds, p.A, p.Win, T_TOK, 6400, DM, EpiGdnIn{p.Pz, p.Pxbc, p.small}, p.wq); }
      GSYNC();
      { LP(); ph_gdn_tiles(p, shm); }
      GSYNC();
      { LP(); ph_gdn_chain(p, lds); }
      { LP(); if ((int)blockIdx.x >= 64) ph_convert(p, layer, 8, tile, (int)blockIdx.x - 64, (int)gridDim.x - 64); }
      GSYNC();
      { LP(); ph_headnorm_post(p, p.Pxbc, 8, p.gdn_norm_w, p.Pz); }
      GSYNC();
      { LP(); gemm_phase_residnorm192<false>(lds, p.H, p.Wout, 2048, p.out, p.mod + (size_t)layer * 3 * 6144 + 2048, p.adap, p.bar + XCD_BAR_WORDS + (layer * 2) * 4096,
                                             p.norm_ffn_w + layer * DM, p.mod + (size_t)layer * 3 * 6144, 3072, 4096, p.A, p.wq); }
    }
    GSYNC();
    { LP(); gemm_phase8(lds, p.A, p.Wfi, T_TOK, 5632, DM, EpiFfnIn{p.Pz, p.Pz + (size_t)T_TOK * DFF}, p.wq); }
    { LP(); const int g_ = (int)gridDim.x, b0_ = (g_ >= 64) ? 32 : 0;
      if ((int)blockIdx.x >= b0_) { ph_convert(p, layer, 16, tile, (int)blockIdx.x - b0_, g_ - b0_); if (layer < 3) ph_convert(p, layer + 1, 3, tile, (int)blockIdx.x - b0_, g_ - b0_);
                                    if (layer < 2) ph_ada_direct(p, layer + 2, layer + 3, shm, (int)blockIdx.x - b0_, g_ - b0_); } }
    GSYNC();
    { LP(); ph_ffn_glu(p, layer, shm); }
    GSYNC();
    if constexpr (layer < 3) { LP(); gemm_phase_residnorm192<false>(lds, p.H, p.Wfo, DFF, p.out, p.mod + (size_t)layer * 3 * 6144 + 5120, p.adap, p.bar + XCD_BAR_WORDS + (layer * 2 + 1) * 4096,
                                             p.norm_mix_w + (layer + 1) * DM, p.mod + (size_t)(layer + 1) * 3 * 6144, 0, 1024, ((layer + 1) % 3 == 1) ? p.Pxbc + (size_t)T_TOK * 2048 : p.A, p.wq); }
    else { LP(); gemm_phase_residnorm192<true>(lds, p.H, p.Wfo, DFF, p.out, p.mod + (size_t)layer * 3 * 6144 + 5120, p.adap, p.bar + XCD_BAR_WORDS + (layer * 2 + 1) * 4096,
                                             p.final_norm_w, nullptr, 0, 0, nullptr, p.wq); }
    GSYNC();
    }
  {
    constexpr int layer = 1; constexpr int kind = layer % 3, j = layer / 3;
    if constexpr (layer == 0) { { LP(); ph_norm_mod<true>(p, p.norm_mix_w + layer * DM, p.mod + (size_t)layer * 3 * 6144, 0, 1024, p.H); }
      GSYNC(); }
    if constexpr (kind == 0) {
      { LP(); gemm_phase8(lds, layer == 0 ? p.H : p.A, p.Win, T_TOK, 6400, DM, EpiSsmIn{p.Pz, p.Pxbc, p.small}, p.wq); }
      if constexpr (layer == 0) { LP(); const int g_ = (int)gridDim.x, b0_ = (g_ >= 192) ? 176 : 0; if ((int)blockIdx.x >= b0_) { ph_convert(p, 0, 2, tile, (int)blockIdx.x - b0_, g_ - b0_); ph_ada_direct(p, 1, 2, shm, (int)blockIdx.x - b0_, g_ - b0_); } }
      GSYNC();
      { LP(); ph_ssm_tiles(p, j, shm); }
      GSYNC();
      { LP(); ph_ssm_chain(p, j, lds); }
      { LP(); if ((int)blockIdx.x >= 128) ph_convert(p, layer, 8, tile, (int)blockIdx.x - 128, (int)gridDim.x - 128); }
      GSYNC();
      { LP(); ph_ssm_post(p, j); }
      GSYNC();
      { LP(); gemm_phase_residnorm192<false>(lds, p.H, p.Wout, 2048, p.out, p.mod + (size_t)layer * 3 * 6144 + 2048, p.adap, p.bar + XCD_BAR_WORDS + (layer * 2) * 4096,
                                             p.norm_ffn_w + layer * DM, p.mod + (size_t)layer * 3 * 6144, 3072, 4096, p.A, p.wq); }
    } else if constexpr (kind == 1) {
      { LP(); gemm_phase8(lds, p.Pxbc + (size_t)T_TOK * 2048, p.Win, T_TOK, 4096, DM, EpiGlaIn{p.A, p.Pz, (float*)p.Pxbc, p.gla_gate_b}, p.wq); }
      GSYNC();
      { LP(); ph_gla_tiles(p, shm); }
      GSYNC();
      { LP(); ph_gla_chain(p, lds); }
      { LP(); if ((int)blockIdx.x >= 64) ph_convert(p, layer, 8, tile, (int)blockIdx.x - 64, (int)gridDim.x - 64); }
      GSYNC();
      { LP(); ph_headnorm_post(p, p.Pxbc + (size_t)T_TOK * 2048, 4, p.gla_norm_w, p.Pz); }
      GSYNC();
      { LP(); gemm_phase_residnorm192<false>(lds, p.H, p.Wout, 1024, p.out, p.mod + (size_t)layer * 3 * 6144 + 2048, p.adap, p.bar + XCD_BAR_WORDS + (layer * 2) * 4096,
                                             p.norm_ffn_w + layer * DM, p.mod + (size_t)layer * 3 * 6144, 3072, 4096, p.A, p.wq); }
    } else {
      { LP(); gemm_phase8(lds, p.A, p.Win, T_TOK, 6400, DM, EpiGdnIn{p.Pz, p.Pxbc, p.small}, p.wq); }
      GSYNC();
      { LP(); ph_gdn_tiles(p, shm); }
      GSYNC();
      { LP(); ph_gdn_chain(p, lds); }
      { LP(); if ((int)blockIdx.x >= 64) ph_convert(p, layer, 8, tile, (int)blockIdx.x - 64, (int)gridDim.x - 64); }
      GSYNC();
      { LP(); ph_headnorm_post(p, p.Pxbc, 8, p.gdn_norm_w, p.Pz); }
      GSYNC();
      { LP(); gemm_phase_residnorm192<false>(lds, p.H, p.Wout, 2048, p.out, p.mod + (size_t)layer * 3 * 6144 + 2048, p.adap, p.bar + XCD_BAR_WORDS + (layer * 2) * 4096,
                                             p.norm_ffn_w + layer * DM, p.mod + (size_t)layer * 3 * 6144, 3072, 4096, p.A, p.wq); }
    }
    GSYNC();
    { LP(); gemm_phase8(lds, p.A, p.Wfi, T_TOK, 5632, DM, EpiFfnIn{p.Pz, p.Pz + (size_t)T_TOK * DFF}, p.wq); }
    { LP(); const int g_ = (int)gridDim.x, b0_ = (g_ >= 64) ? 32 : 0;
      if ((int)blockIdx.x >= b0_) { ph_convert(p, layer, 16, tile, (int)blockIdx.x - b0_, g_ - b0_); if (layer < 3) ph_convert(p, layer + 1, 3, tile, (int)blockIdx.x - b0_, g_ - b0_);
                                    if (layer < 2) ph_ada_direct(p, layer + 2, layer + 3, shm, (int)blockIdx.x - b0_, g_ - b0_); } }
    GSYNC();
    { LP(); ph_ffn_glu(p, layer, shm); }
    GSYNC();
    if constexpr (layer < 3) { LP(); gemm_phase_residnorm192<false>(lds, p.H, p.Wfo, DFF, p.out, p.mod + (size_t)layer * 3 * 6144 + 5120, p.adap, p.bar + XCD_BAR_WORDS + (layer * 2 + 1) * 4096,
                                             p.norm_mix_w + (layer + 1) * DM, p.mod + (size_t)(layer + 1) * 3 * 6144, 0, 1024, ((layer + 1) % 3 == 1) ? p.Pxbc + (size_t)T_TOK * 2048 : p.A, p.wq); }
    else { LP(); gemm_phase_residnorm192<true>(lds, p.H, p.Wfo, DFF, p.out, p.mod + (size_t)layer * 3 * 6144 + 5120, p.adap, p.bar + XCD_BAR_WORDS + (layer * 2 + 1) * 4096,
                                             p.final_norm_w, nullptr, 0, 0, nullptr, p.wq); }
    GSYNC();
    }
  {
    constexpr int layer = 2; constexpr int kind = layer % 3, j = layer / 3;
    if constexpr (layer == 0) { { LP(); ph_norm_mod<true>(p, p.norm_mix_w + layer * DM, p.mod + (size_t)layer * 3 * 6144, 0, 1024, p.H); }
      GSYNC(); }
    if constexpr (kind == 0) {
      { LP(); gemm_phase8(lds, layer == 0 ? p.H : p.A, p.Win, T_TOK, 6400, DM, EpiSsmIn{p.Pz, p.Pxbc, p.small}, p.wq); }
      if constexpr (layer == 0) { LP(); const int g_ = (int)gridDim.x, b0_ = (g_ >= 192) ? 176 : 0; if ((int)blockIdx.x >= b0_) { ph_convert(p, 0, 2, tile, (int)blockIdx.x - b0_, g_ - b0_); ph_ada_direct(p, 1, 2, shm, (int)blockIdx.x - b0_, g_ - b0_); } }
      GSYNC();
      { LP(); ph_ssm_tiles(p, j, shm); }
      GSYNC();
      { LP(); ph_ssm_chain(p, j, lds); }
      { LP(); if ((int)blockIdx.x >= 128) ph_convert(p, layer, 8, tile, (int)blockIdx.x - 128, (int)gridDim.x - 128); }
      GSYNC();
      { LP(); ph_ssm_post(p, j); }
      GSYNC();
      { LP(); gemm_phase_residnorm192<false>(lds, p.H, p.Wout, 2048, p.out, p.mod + (size_t)layer * 3 * 6144 + 2048, p.adap, p.bar + XCD_BAR_WORDS + (layer * 2) * 4096,
                                             p.norm_ffn_w + layer * DM, p.mod + (size_t)layer * 3 * 6144, 3072, 4096, p.A, p.wq); }
    } else if constexpr (kind == 1) {
      { LP(); gemm_phase8(lds, p.Pxbc + (size_t)T_TOK * 2048, p.Win, T_TOK, 4096, DM, EpiGlaIn{p.A, p.Pz, (float*)p.Pxbc, p.gla_gate_b}, p.wq); }
      GSYNC();
      { LP(); ph_gla_tiles(p, shm); }
      GSYNC();
      { LP(); ph_gla_chain(p, lds); }
      { LP(); if ((int)blockIdx.x >= 64) ph_convert(p, layer, 8, tile, (int)blockIdx.x - 64, (int)gridDim.x - 64); }
      GSYNC();
      { LP(); ph_headnorm_post(p, p.Pxbc + (size_t)T_TOK * 2048, 4, p.gla_norm_w, p.Pz); }
      GSYNC();
      { LP(); gemm_phase_residnorm192<false>(lds, p.H, p.Wout, 1024, p.out, p.mod + (size_t)layer * 3 * 6144 + 2048, p.adap, p.bar + XCD_BAR_WORDS + (layer * 2) * 4096,
                                             p.norm_ffn_w + layer * DM, p.mod + (size_t)layer * 3 * 6144, 3072, 4096, p.A, p.wq); }
    } else {
      { LP(); gemm_phase8(lds, p.A, p.Win, T_TOK, 6400, DM, EpiGdnIn{p.Pz, p.Pxbc, p.small}, p.wq); }
      GSYNC();
      { LP(); ph_gdn_tiles(p, shm); }
      GSYNC();
      { LP(); ph_gdn_chain(p, lds); }
      { LP(); if ((int)blockIdx.x >= 64) ph_convert(p, layer, 8, tile, (int)blockIdx.x - 64, (int)gridDim.x - 64); }
      GSYNC();
      { LP(); ph_headnorm_post(p, p.Pxbc, 8, p.gdn_norm_w, p.Pz); }
      GSYNC();
      { LP(); gemm_phase_residnorm192<false>(lds, p.H, p.Wout, 2048, p.out, p.mod + (size_t)layer * 3 * 6144 + 2048, p.adap, p.bar + XCD_BAR_WORDS + (layer * 2) * 4096,
                                             p.norm_ffn_w + layer * DM, p.mod + (size_t)layer * 3 * 6144, 3072, 4096, p.A, p.wq); }
    }
    GSYNC();
    { LP(); gemm_phase8(lds, p.A, p.Wfi, T_TOK, 5632, DM, EpiFfnIn{p.Pz, p.Pz + (size_t)T_TOK * DFF}, p.wq); }
    { LP(); const int g_ = (int)gridDim.x, b0_ = (g_ >= 64) ? 32 : 0;
      if ((int)blockIdx.x >= b0_) { ph_convert(p, layer, 16, tile, (int)blockIdx.x - b0_, g_ - b0_); if (layer < 3) ph_convert(p, layer + 1, 3, tile, (int)blockIdx.x - b0_, g_ - b0_);
                                    if (layer < 2) ph_ada_direct(p, layer + 2, layer + 3, shm, (int)blockIdx.x - b0_, g_ - b0_); } }
    GSYNC();
    { LP(); ph_ffn_glu(p, layer, shm); }
    GSYNC();
    if constexpr (layer < 3) { LP(); gemm_phase_residnorm192<false>(lds, p.H, p.Wfo, DFF, p.out, p.mod + (size_t)layer * 3 * 6144 + 5120, p.adap, p.bar + XCD_BAR_WORDS + (layer * 2 + 1) * 4096,
                                             p.norm_mix_w + (layer + 1) * DM, p.mod + (size_t)(layer + 1) * 3 * 6144, 0, 1024, ((layer + 1) % 3 == 1) ? p.Pxbc + (size_t)T_TOK * 2048 : p.A, p.wq); }
    else { LP(); gemm_phase_residnorm192<true>(lds, p.H, p.Wfo, DFF, p.out, p.mod + (size_t)layer * 3 * 6144 + 5120, p.adap, p.bar + XCD_BAR_WORDS + (layer * 2 + 1) * 4096,
                                             p.final_norm_w, nullptr, 0, 0, nullptr, p.wq); }
    GSYNC();
    }
  {
    constexpr int layer = 3; constexpr int kind = layer % 3, j = layer / 3;
    if constexpr (layer == 0) { { LP(); ph_norm_mod<true>(p, p.norm_mix_w + layer * DM, p.mod + (size_t)layer * 3 * 6144, 0, 1024, p.H); }
      GSYNC(); }
    if constexpr (kind == 0) {
      { LP(); gemm_phase8(lds, layer == 0 ? p.H : p.A, p.Win, T_TOK, 6400, DM, EpiSsmIn{p.Pz, p.Pxbc, p.small}, p.wq); }
      if constexpr (layer == 0) { LP(); const int g_ = (int)gridDim.x, b0_ = (g_ >= 192) ? 176 : 0; if ((int)blockIdx.x >= b0_) { ph_convert(p, 0, 2, tile, (int)blockIdx.x - b0_, g_ - b0_); ph_ada_direct(p, 1, 2, shm, (int)blockIdx.x - b0_, g_ - b0_); } }
      GSYNC();
      { LP(); ph_ssm_tiles(p, j, shm); }
      GSYNC();
      { LP(); ph_ssm_chain(p, j, lds); }
      { LP(); if ((int)blockIdx.x >= 128) ph_convert(p, layer, 8, tile, (int)blockIdx.x - 128, (int)gridDim.x - 128); }
      GSYNC();
      { LP(); ph_ssm_post(p, j); }
      GSYNC();
      { LP(); gemm_phase_residnorm192<false>(lds, p.H, p.Wout, 2048, p.out, p.mod + (size_t)layer * 3 * 6144 + 2048, p.adap, p.bar + XCD_BAR_WORDS + (layer * 2) * 4096,
                                             p.norm_ffn_w + layer * DM, p.mod + (size_t)layer * 3 * 6144, 3072, 4096, p.A, p.wq); }
    } else if constexpr (kind == 1) {
      { LP(); gemm_phase8(lds, p.Pxbc + (size_t)T_TOK * 2048, p.Win, T_TOK, 4096, DM, EpiGlaIn{p.A, p.Pz, (float*)p.Pxbc, p.gla_gate_b}, p.wq); }
      GSYNC();
      { LP(); ph_gla_tiles(p, shm); }
      GSYNC();
      { LP(); ph_gla_chain(p, lds); }
      { LP(); if ((int)blockIdx.x >= 64) ph_convert(p, layer, 8, tile, (int)blockIdx.x - 64, (int)gridDim.x - 64); }
      GSYNC();
      { LP(); ph_headnorm_post(p, p.Pxbc + (size_t)T_TOK * 2048, 4, p.gla_norm_w, p.Pz); }
      GSYNC();
      { LP(); gemm_phase_residnorm192<false>(lds, p.H, p.Wout, 1024, p.out, p.mod + (size_t)layer * 3 * 6144 + 2048, p.adap, p.bar + XCD_BAR_WORDS + (layer * 2) * 4096,
                                             p.norm_ffn_w + layer * DM, p.mod + (size_t)layer * 3 * 6144, 3072, 4096, p.A, p.wq); }
    } else {
      { LP(); gemm_phase8(lds, p.A, p.Win, T_TOK, 6400, DM, EpiGdnIn{p.Pz, p.Pxbc, p.small}, p.wq); }
      GSYNC();
      { LP(); ph_gdn_tiles(p, shm); }
      GSYNC();
      { LP(); ph_gdn_chain(p, lds); }
      { LP(); if ((int)blockIdx.x >= 64) ph_convert(p, layer, 8, tile, (int)blockIdx.x - 64, (int)gridDim.x - 64); }
      GSYNC();
      { LP(); ph_headnorm_post(p, p.Pxbc, 8, p.gdn_norm_w, p.Pz); }
      GSYNC();
      { LP(); gemm_phase_residnorm192<false>(lds, p.H, p.Wout, 2048, p.out, p.mod + (size_t)layer * 3 * 6144 + 2048, p.adap, p.bar + XCD_BAR_WORDS + (layer * 2) * 4096,
                                             p.norm_ffn_w + layer * DM, p.mod + (size_t)layer * 3 * 6144, 3072, 4096, p.A, p.wq); }
    }
    GSYNC();
    { LP(); gemm_phase8(lds, p.A, p.Wfi, T_TOK, 5632, DM, EpiFfnIn{p.Pz, p.Pz + (size_t)T_TOK * DFF}, p.wq); }
    { LP(); const int g_ = (int)gridDim.x, b0_ = (g_ >= 64) ? 32 : 0;
      if ((int)blockIdx.x >= b0_) { ph_convert(p, layer, 16, tile, (int)blockIdx.x - b0_, g_ - b0_); if (layer < 3) ph_convert(p, layer + 1, 3, tile, (int)blockIdx.x - b0_, g_ - b0_);
                                    if (layer < 2) ph_ada_direct(p, layer + 2, layer + 3, shm, (int)blockIdx.x - b0_, g_ - b0_); } }
    GSYNC();
    { LP(); ph_ffn_glu(p, layer, shm); }
    GSYNC();
    if constexpr (layer < 3) { LP(); gemm_phase_residnorm192<false>(lds, p.H, p.Wfo, DFF, p.out, p.mod + (size_t)layer * 3 * 6144 + 5120, p.adap, p.bar + XCD_BAR_WORDS + (layer * 2 + 1) * 4096,
                                             p.norm_mix_w + (layer + 1) * DM, p.mod + (size_t)(layer + 1) * 3 * 6144, 0, 1024, ((layer + 1) % 3 == 1) ? p.Pxbc + (size_t)T_TOK * 2048 : p.A, p.wq); }
    else { LP(); gemm_phase_residnorm192<true>(lds, p.H, p.Wfo, DFF, p.out, p.mod + (size_t)layer * 3 * 6144 + 5120, p.adap, p.bar + XCD_BAR_WORDS + (layer * 2 + 1) * 4096,
                                             p.final_norm_w, nullptr, 0, 0, nullptr, p.wq); }
    GSYNC();
    }

}

extern "C" void kernel_launch(void* const* d_in, const int* in_sizes, int n_in, void* d_out, int out_size, void* d_ws, size_t ws_size, hipStream_t stream) {
  P p{};
  const float** pp = (const float**)&p;
  for (int i = 0; i < 36; ++i) pp[i] = (const float*)d_in[i];
  p.out = (float*)d_out;
  char* w = (char*)d_ws; size_t off = 0;
  auto take = [&](size_t bytes) { char* r = w + off; off += (bytes + 255) & ~(size_t)255; return r; };
  p.Win = (bf16_t*)take((size_t)6400 * 1024 * 2);
  p.Wout = (bf16_t*)take((size_t)1024 * 2048 * 2);
  p.Wfi = (bf16_t*)take((size_t)5632 * 1024 * 2);
  p.Wfo = (bf16_t*)take((size_t)1024 * 2816 * 2);
  p.H = (bf16_t*)take((size_t)T_TOK * 2816 * 2);
  p.Pz = (bf16_t*)take((size_t)T_TOK * 2048 * 2);
  p.Pxbc = (bf16_t*)take((size_t)T_TOK * 4096 * 2);
  p.A = (bf16_t*)take((size_t)T_TOK * 4096 * 2);
  p.small = (float*)take((size_t)T_TOK * 64 * 4);
  p.small2 = (float*)take((size_t)T_TOK * 128 * 4);
  p.adap = (float*)take((size_t)16 * 4 * 3 * 6144 * 4);
  p.mod = (float*)take((size_t)4 * 3 * 6144 * 4);
  p.XT = p.H; p.Gm = p.H + (size_t)192 * 32 * 4096;
  p.BT = (bf16_t*)take((size_t)192 * 8 * 8192 * 2);
  p.VEC = (float*)take((size_t)192 * 64 * 192 * 4);
  p.bar = (unsigned*)take((size_t)(XCD_BAR_WORDS + 8 * 4096) * 4);
  if (off > ws_size) { fprintf(stderr, "workspace too small: need %zu have %zu\n", off, ws_size); return; }
  static int grid_blocks = 0;
  if (!grid_blocks) {
    int dev = 0, cus = 0, per_cu = 0;
    (void)hipGetDevice(&dev);
    (void)hipDeviceGetAttribute(&cus, hipDeviceAttributeMultiprocessorCount, dev);
    if (hipFuncSetAttribute((const void*)fwd_megakernel, hipFuncAttributeMaxDynamicSharedMemorySize, LDS_BYTES) != hipSuccess) { fprintf(stderr, "hipFuncSetAttribute failed\n"); return; }
    (void)hipOccupancyMaxActiveBlocksPerMultiprocessor(&per_cu, fwd_megakernel, NT, LDS_BYTES);
    if (per_cu < 1) { fprintf(stderr, "occupancy query returned %d\n", per_cu); return; }
    grid_blocks = cus;
  }
  if (hipMemsetAsync(p.bar, 0, (size_t)(XCD_BAR_WORDS + 8 * 4096) * 4, stream) != hipSuccess) { fprintf(stderr, "memset failed\n"); return; }
  void* args[] = {&p};
  hipError_t e = hipLaunchCooperativeKernel((void*)fwd_megakernel, dim3(grid_blocks), dim3(NT), args, LDS_BYTES, stream);
  if (e != hipSuccess) fprintf(stderr, "cooperative launch failed: %s (grid %d)\n", hipGetErrorString(e), grid_blocks);
}
```

```cpp
#include <hip/hip_runtime.h>
#include <cstdio>

typedef unsigned short bf16_t;
typedef short bf16x8 __attribute__((ext_vector_type(8)));
typedef float f32x4 __attribute__((ext_vector_type(4)));
typedef unsigned u32x2 __attribute__((ext_vector_type(2)));
typedef unsigned u32x4 __attribute__((ext_vector_type(4)));

#define NT 512
#define CH_BARRIER() do { asm volatile("s_waitcnt lgkmcnt(0)" ::: "memory"); __builtin_amdgcn_s_barrier(); asm volatile("" ::: "memory"); } while (0)
#define LAS __attribute__((address_space(3)))
#define T_TOK 12288
#define T_CTX 4096
#define DM 1024
#define DFF 2816
#define EPS 1e-6f

struct P {
  const float *x_prompt, *x_sample, *state_ssm, *state_gla, *state_gdn, *c, *c_ctx;
  const float *norm_mix_w, *norm_ffn_w, *ada_w, *ada_b, *ffn_in_w, *ffn_conv_w, *ffn_conv_b, *ffn_out_w;
  const float *ssm_in_w, *ssm_conv_w, *ssm_conv_b, *ssm_dt_bias, *ssm_a_log, *ssm_d, *ssm_norm_w, *ssm_out_w;
  const float *gla_in_w, *gla_gate_w1, *gla_gate_w2, *gla_gate_b, *gla_norm_w, *gla_out_w;
  const float *gdn_in_w, *gdn_conv_w, *gdn_dt_bias, *gdn_a_log, *gdn_norm_w, *gdn_out_w, *final_norm_w;
  float* out;
  bf16_t *Win, *Wout, *Wfi, *Wfo;
  bf16_t *H;
  bf16_t *Pz, *Pxbc;
  bf16_t *A;
  float *small, *small2, *adap, *mod;
  bf16_t *XT, *Gm, *BT; float* VEC;
  unsigned* bar;
  int wq, pad_;
};

__device__ __forceinline__ bf16_t f2bf(float f) {
  unsigned u = __float_as_uint(f);
  u += 0x7fffu + ((u >> 16) & 1u);
  return (bf16_t)(u >> 16);
}
__device__ __forceinline__ float bf2f(bf16_t b) { return __uint_as_float(((unsigned)b) << 16); }
__device__ __forceinline__ float bflo(unsigned u) { return __uint_as_float(u << 16); }
__device__ __forceinline__ float bfhi(unsigned u) { return __uint_as_float(u & 0xffff0000u); }
__device__ __forceinline__ unsigned cvt2(float a, float b);
__device__ __forceinline__ unsigned pack2(float a, float b) { return cvt2(a, b); }

typedef float f32x2 __attribute__((ext_vector_type(2)));
typedef float f32x16 __attribute__((ext_vector_type(16)));
typedef __bf16 hwbf16x2 __attribute__((ext_vector_type(2)));
__device__ __forceinline__ unsigned cvt2(float a, float b) { f32x2 v = {a, b}; return __builtin_bit_cast(unsigned, __builtin_convertvector(v, hwbf16x2)); }
__device__ __forceinline__ bf16x8 mk8(unsigned a, unsigned b, unsigned c, unsigned d) { u32x4 u = {a, b, c, d}; return __builtin_bit_cast(bf16x8, u); }
#define MFMA32(a, b, c) __builtin_amdgcn_mfma_f32_32x32x16_bf16((a), (b), (c), 0, 0, 0)
__device__ __forceinline__ int kperm(int k) { const int g4 = (k >> 2) & 3; return (k & ~12) | ((((g4 & 1) << 1) | (g4 >> 1)) << 2); }
__device__ __forceinline__ bf16x8 pack_half(const f32x16& x, int half) {
  return half == 0 ? mk8(cvt2(x[0], x[1]), cvt2(x[2], x[3]), cvt2(x[4], x[5]), cvt2(x[6], x[7]))
                   : mk8(cvt2(x[8], x[9]), cvt2(x[10], x[11]), cvt2(x[12], x[13]), cvt2(x[14], x[15]));
}
__device__ __forceinline__ float silu_f(float x) { return x * __builtin_amdgcn_rcpf(1.f + __expf(-x)); }
__device__ __forceinline__ float softplus_f(float x) { return fmaxf(x, 0.f) + log1pf(__expf(-fabsf(x))); }
__device__ __forceinline__ float sigmoid_f(float x) { return __builtin_amdgcn_rcpf(1.f + __expf(-x)); }
__device__ __forceinline__ float softplus_fast(float x) { return fmaxf(x, 0.f) + __logf(1.f + __expf(-fabsf(x))); }
__device__ __forceinline__ float dpp_row_shr(float v, int n) {
  const int iv = __builtin_bit_cast(int, v); int r;
  switch (n) { case 1: r = __builtin_amdgcn_update_dpp(0, iv, 0x111, 0xf, 0xf, true); break; case 2: r = __builtin_amdgcn_update_dpp(0, iv, 0x112, 0xf, 0xf, true); break;
               case 4: r = __builtin_amdgcn_update_dpp(0, iv, 0x114, 0xf, 0xf, true); break; default: r = __builtin_amdgcn_update_dpp(0, iv, 0x118, 0xf, 0xf, true); break; }
  return __builtin_bit_cast(float, r);
}
__device__ __forceinline__ float wave_scan_incl(float v) {
  v += dpp_row_shr(v, 1); v += dpp_row_shr(v, 2); v += dpp_row_shr(v, 4); v += dpp_row_shr(v, 8);
  v += __builtin_bit_cast(float, __builtin_amdgcn_update_dpp(0, __builtin_bit_cast(int, v), 0x142, 0xa, 0xf, false));
  v += __builtin_bit_cast(float, __builtin_amdgcn_update_dpp(0, __builtin_bit_cast(int, v), 0x143, 0xc, 0xf, false));
  return v;
}
__device__ __forceinline__ float row16_allsum(float v) {
  v += __builtin_bit_cast(float, __builtin_amdgcn_update_dpp(0, __builtin_bit_cast(int, v), 0xB1, 0xf, 0xf, false));
  v += __builtin_bit_cast(float, __builtin_amdgcn_update_dpp(0, __builtin_bit_cast(int, v), 0x4E, 0xf, 0xf, false));
  v += __builtin_bit_cast(float, __builtin_amdgcn_update_dpp(0, __builtin_bit_cast(int, v), 0x141, 0xf, 0xf, false));
  v += __builtin_bit_cast(float, __builtin_amdgcn_update_dpp(0, __builtin_bit_cast(int, v), 0x140, 0xf, 0xf, false));
  return v;
}
__device__ __forceinline__ float xor16_sum(float x) {
  const auto r = __builtin_amdgcn_permlane16_swap(__builtin_bit_cast(unsigned, x), __builtin_bit_cast(unsigned, x), false, false);
  return __builtin_bit_cast(float, r[0]) + __builtin_bit_cast(float, r[1]);
}
__device__ __forceinline__ float xor32_sum(float x) {
  const auto r = __builtin_amdgcn_permlane32_swap(__builtin_bit_cast(unsigned, x), __builtin_bit_cast(unsigned, x), false, false);
  return __builtin_bit_cast(float, r[0]) + __builtin_bit_cast(float, r[1]);
}
__device__ __forceinline__ float wave_sum(float v) {
  v += dpp_row_shr(v, 1); v += dpp_row_shr(v, 2); v += dpp_row_shr(v, 4); v += dpp_row_shr(v, 8);
  v += __builtin_bit_cast(float, __builtin_amdgcn_update_dpp(0, __builtin_bit_cast(int, v), 0x142, 0xa, 0xf, false));
  v += __builtin_bit_cast(float, __builtin_amdgcn_update_dpp(0, __builtin_bit_cast(int, v), 0x143, 0xc, 0xf, false));
  return __builtin_bit_cast(float, __builtin_amdgcn_readlane(__builtin_bit_cast(int, v), 63));
}
__device__ __forceinline__ int tidw(int wq) { int l; asm volatile("v_mbcnt_lo_u32_b32 %0, -1, 0\n\tv_mbcnt_hi_u32_b32 %0, -1, %0" : "=v"(l)); return (wq << 6) | l; }
__device__ __forceinline__ void tok_info(int t, int& t0, int& L, int& cond) {
  if (t < T_CTX) { t0 = t & ~255; L = 256; cond = 0; }
  else { int b = (t - T_CTX) >> 12; t0 = T_CTX + (b << 12); L = 4096; cond = 1 + b; }
}

__device__ __forceinline__ void convert_wt(const float* __restrict__ W, int K, int N, bf16_t* __restrict__ Wt, int row0, int ncover, float* tile  , int wq, int bid, int nb) {
  const int tk = K / 64, tn = ncover / 64, ntile = tk * tn;
  const int tid = tidw(wq);
  const int r = tid >> 4, c4 = (tid & 15) * 4;
  for (int ti0 = bid * 4; ti0 < ntile; ti0 += nb * 4) {
    f32x4 v[4][2];
#pragma unroll
    for (int u = 0; u < 4; ++u) {
      const int ti = ti0 + u, kt = ti % tk, nt = ti / tk;
#pragma unroll
      for (int h = 0; h < 2; ++h) {
        const int k = kt * 64 + r + h * 32, n = nt * 64 + c4;
        v[u][h] = (f32x4){0.f, 0.f, 0.f, 0.f};
        if (ti < ntile && n < N) v[u][h] = *(const f32x4*)(W + (size_t)k * N + n);
      }
    }
#pragma unroll
    for (int u = 0; u < 4; ++u) {
      float* tl = tile + u * (64 * 65);
#pragma unroll
      for (int h = 0; h < 2; ++h) { float* d = tl + (r + h * 32) * 65 + c4; d[0] = v[u][h][0]; d[1] = v[u][h][1]; d[2] = v[u][h][2]; d[3] = v[u][h][3]; }
    }
    __syncthreads();
#pragma unroll
    for (int u = 0; u < 4; ++u) {
      const int ti = ti0 + u, kt = ti % tk, nt = ti / tk;
      if (ti < ntile) {
        const float* tl = tile + u * (64 * 65);
        const int n = tid >> 3, k8 = (tid & 7) * 8;
        u32x4 o;
        o[0] = pack2(tl[(k8 + 0) * 65 + n], tl[(k8 + 1) * 65 + n]);
        o[1] = pack2(tl[(k8 + 2) * 65 + n], tl[(k8 + 3) * 65 + n]);
        o[2] = pack2(tl[(k8 + 4) * 65 + n], tl[(k8 + 5) * 65 + n]);
        o[3] = pack2(tl[(k8 + 6) * 65 + n], tl[(k8 + 7) * 65 + n]);
        *(u32x4*)(Wt + (size_t)(row0 + nt * 64 + n) * K + kt * 64 + k8) = o;
      }
    }
    __syncthreads();
  }
}

__device__ __forceinline__ void ph_convert(const P& p, int layer, int which, float* tile, int bid, int nb) {
  const int kind = layer % 3, j = layer / 3;
  if (kind == 0) {
    if (which & 1) convert_wt(p.ssm_in_w + (size_t)j * 1024 * 6208, 1024, 6208, p.Win, 0, 6400, tile, p.wq, bid, nb);
    if (which & 2) convert_wt(p.ssm_out_w + (size_t)j * 2048 * 1024, 2048, 1024, p.Wout, 0, 1024, tile, p.wq, bid, nb);
  } else if (kind == 1) {
    if (which & 1) {
      convert_wt(p.gla_in_w, 1024, 3072, p.Win, 0, 3072, tile, p.wq, bid, nb);
      {
        const int tid_ = tidw(p.wq);
        for (int it = bid * NT + tid_; it < 1024 * 128; it += nb * NT) {
          const int n = it >> 7, k8 = (it & 127) * 8, e = n >> 9, kk = n & 511;
          float w2c[16];
#pragma unroll
          for (int r = 0; r < 16; ++r) w2c[r] = p.gla_gate_w2[(size_t)e * 16 * 512 + r * 512 + kk];
          float o[8];
#pragma unroll
          for (int q = 0; q < 8; ++q) {
            const float* w1 = p.gla_gate_w1 + ((size_t)e * 1024 + k8 + q) * 16;
            const f32x4 a0 = *(const f32x4*)(w1), a1 = *(const f32x4*)(w1 + 4), a2 = *(const f32x4*)(w1 + 8), a3 = *(const f32x4*)(w1 + 12);
            o[q] = (a0[0] * w2c[0] + a0[1] * w2c[1] + a0[2] * w2c[2] + a0[3] * w2c[3]) + (a1[0] * w2c[4] + a1[1] * w2c[5] + a1[2] * w2c[6] + a1[3] * w2c[7])
                 + (a2[0] * w2c[8] + a2[1] * w2c[9] + a2[2] * w2c[10] + a2[3] * w2c[11]) + (a3[0] * w2c[12] + a3[1] * w2c[13] + a3[2] * w2c[14] + a3[3] * w2c[15]);
          }
          u32x4 ov = {pack2(o[0], o[1]), pack2(o[2], o[3]), pack2(o[4], o[5]), pack2(o[6], o[7])};
          *(u32x4*)(p.Win + (size_t)(3072 + n) * 1024 + k8) = ov;
        }
      }
    }
    if (which & 2) convert_wt(p.gla_out_w, 1024, 1024, p.Wout, 0, 1024, tile, p.wq, bid, nb);
  } else {
    if (which & 1) convert_wt(p.gdn_in_w, 1024, 6176, p.Win, 0, 6400, tile, p.wq, bid, nb);
    if (which & 2) convert_wt(p.gdn_out_w, 2048, 1024, p.Wout, 0, 1024, tile, p.wq, bid, nb);
  }
  if (which & (4 | 8)) convert_wt(p.ffn_in_w + (size_t)layer * 1024 * 5632, 1024, 5632, p.Wfi, 0, 5632, tile, p.wq, bid, nb);
  if (which & (4 | 16)) convert_wt(p.ffn_out_w + (size_t)layer * 2816 * 1024, 2816, 1024, p.Wfo, 0, 1024, tile, p.wq, bid, nb);
}

__device__ __forceinline__ void ph_ada_partial(const P& p) {
  const int gtid = blockIdx.x * NT + tidw(p.wq), gsz = gridDim.x * NT;
  for (int it = gtid; it < 4 * 16 * 1536; it += gsz) {
    const int n4 = it % 1536, kp = (it / 1536) & 15, l = it / (1536 * 16);
    const float* w = p.ada_w + (size_t)l * 1024 * 6144 + (size_t)(kp * 64) * 6144 + n4 * 4;
    f32x4 a0 = {0.f, 0.f, 0.f, 0.f}, a1 = a0, a2 = a0;
#pragma unroll 8
    for (int k = 0; k < 64; ++k) {
      const int kk = kp * 64 + k;
      const float c0 = silu_f(p.c_ctx[kk]), c1 = silu_f(p.c[kk]), c2 = silu_f(p.c[1024 + kk]);
      const f32x4 wv = *(const f32x4*)(w + (size_t)k * 6144);
      a0 += c0 * wv; a1 += c1 * wv; a2 += c2 * wv;
    }
    float* d = p.adap + ((size_t)(kp * 4 + l) * 3) * 6144 + n4 * 4;
    *(f32x4*)(d) = a0; *(f32x4*)(d + 6144) = a1; *(f32x4*)(d + 2 * 6144) = a2;
  }
}
__device__ __forceinline__ void ph_ada_reduce(const P& p) {
  const int gtid = blockIdx.x * NT + tidw(p.wq), gsz = gridDim.x * NT;
  for (int it = gtid; it < 4 * 3 * 6144; it += gsz) {
    const int n = it % 6144, lc = it / 6144, l = lc / 3;
    float s = p.ada_b[l * 6144 + n];
#pragma unroll
    for (int kp = 0; kp < 16; ++kp) s += p.adap[(size_t)(kp * 12 + lc) * 6144 + n];
    p.mod[it] = s;
  }
}
__device__ __forceinline__ void ph_ada_direct(const P& p, int l_lo, int l_hi, unsigned char* shm, int bid, int nb) {
  const int tid = tidw(p.wq), part = tid >> 3, l8 = tid & 7;
  float* red = (float*)shm;
  const int nitem = (l_hi - l_lo) * 192;
  for (int item = bid; item < nitem; item += nb) {
    const int l = l_lo + item / 192, cg = item % 192;
    const float* w = p.ada_w + ((size_t)l * 1024 + part * 16) * 6144 + cg * 32 + l8 * 4;
    f32x4 wv[16];
#pragma unroll
    for (int k = 0; k < 16; ++k) wv[k] = *(const f32x4*)(w + (size_t)k * 6144);
    f32x4 a0 = {0.f, 0.f, 0.f, 0.f}, a1 = a0, a2 = a0;
#pragma unroll
    for (int k = 0; k < 16; ++k) {
      const int kk = part * 16 + k;
      const float c0 = silu_f(p.c_ctx[kk]), c1 = silu_f(p.c[kk]), c2 = silu_f(p.c[1024 + kk]);
      a0 += c0 * wv[k]; a1 += c1 * wv[k]; a2 += c2 * wv[k];
    }
    float* r = red + (part * 3) * 32 + l8 * 4;
    *(f32x4*)(r) = a0; *(f32x4*)(r + 32) = a1; *(f32x4*)(r + 64) = a2;
    __syncthreads();
    if (tid < 96) {
      const int cond = tid >> 5, n = tid & 31;
      float sacc = p.ada_b[l * 6144 + cg * 32 + n];
#pragma unroll 16
      for (int q = 0; q < 64; ++q) sacc += red[(q * 3 + cond) * 32 + n];
      p.mod[((size_t)l * 3 + cond) * 6144 + cg * 32 + n] = sacc;
    }
    __syncthreads();
  }
}
__device__ __forceinline__ void ph_copy_x(const P& p) {
  const int gtid = blockIdx.x * NT + tidw(p.wq), gsz = gridDim.x * NT;
  const int n1 = T_CTX * DM / 4, n2 = T_TOK * DM / 4;
  f32x4* o = (f32x4*)p.out;
  for (int i = gtid; i < n2; i += gsz) o[i] = (i < n1) ? ((const f32x4*)p.x_prompt)[i] : ((const f32x4*)p.x_sample)[i - n1];
}

template <bool FROM_INPUT>
__device__ __forceinline__ void ph_norm_mod(const P& p, const float* __restrict__ nw, const float* __restrict__ modl  , int sh_off, int sc_off, bf16_t* __restrict__ hout) {
  const int wave = tidw(p.wq) >> 6, lane = tidw(p.wq) & 63;
  const int gw = blockIdx.x * 8 + wave, nw_ = gridDim.x * 8;
  const float* x = p.out;
  for (int tb = gw; tb < T_TOK; tb += 3 * nw_) {
    f32x4 v[3][4]; float ss[3];
#pragma unroll
    for (int j = 0; j < 3; ++j) {
      const int t = tb + j * nw_; ss[j] = 0.f;
      if (t < T_TOK) {
        const float* xr = FROM_INPUT ? ((t < T_CTX) ? p.x_prompt + (size_t)t * DM : p.x_sample + (size_t)(t - T_CTX) * DM) : x + (size_t)t * DM;
#pragma unroll
        for (int i = 0; i < 4; ++i) v[j][i] = *(const f32x4*)(xr + i * 256 + lane * 4);
      }
    }
#pragma unroll
    for (int j = 0; j < 3; ++j) {
      const int t = tb + j * nw_;
      if (t < T_TOK) {
#pragma unroll
        for (int i = 0; i < 4; ++i) { ss[j] += v[j][i][0] * v[j][i][0] + v[j][i][1] * v[j][i][1] + v[j][i][2] * v[j][i][2] + v[j][i][3] * v[j][i][3];
          if (FROM_INPUT) *(f32x4*)(p.out + (size_t)t * DM + i * 256 + lane * 4) = v[j][i]; }
      }
    }
#pragma unroll
    for (int j = 0; j < 3; ++j) {
      const int t = tb + j * nw_;
      if (t < T_TOK) {
        int t0, L, cond; tok_info(t, t0, L, cond);
        const float rstd = rsqrtf(wave_sum(ss[j]) * (1.f / DM) + EPS);
        const float* mr = modl + cond * 6144;
#pragma unroll
        for (int i = 0; i < 4; ++i) {
          const int d = i * 256 + lane * 4;
          const f32x4 w = *(const f32x4*)(nw + d), sc = *(const f32x4*)(mr + sc_off + d), sh = *(const f32x4*)(mr + sh_off + d);
          float o0 = v[j][i][0] * rstd * w[0] * (1.f + sc[0]) + sh[0];
          float o1 = v[j][i][1] * rstd * w[1] * (1.f + sc[1]) + sh[1];
          float o2 = v[j][i][2] * rstd * w[2] * (1.f + sc[2]) + sh[2];
          float o3 = v[j][i][3] * rstd * w[3] * (1.f + sc[3]) + sh[3];
          u32x2 o; o[0] = pack2(o0, o1); o[1] = pack2(o2, o3);
          *(u32x2*)(hout + (size_t)t * DM + d) = o;
        }
      }
    }
  }
}

namespace pg8 {
#define PG8_LAS __attribute__((address_space(3)))
typedef unsigned short bf16_t;
typedef short bf16x8 __attribute__((ext_vector_type(8)));
typedef float f32x4 __attribute__((ext_vector_type(4)));
typedef unsigned u32x4 __attribute__((ext_vector_type(4)));
constexpr int BM = 256, BK = 64, HALF = 128, HTB = HALF * BK * 2  , STAGE_BYTES = 8 * HTB, NXCD = 8, WGM = 8;

__host__ __device__ __forceinline__ int lds_byte(int r, int c) { const int st = (r >> 4) * 2 + (c >> 5), rr = r & 15, cc = c & 31, ob = rr * 64 + cc * 2; return st * 1024 + (ob ^ (((ob >> 9) & 1) << 5)); }
__host__ __device__ __forceinline__ void stage_rc(int b, int& R, int& C) { const int st = b / 1024, sb = b % 1024, swz = sb ^ (((sb >> 9) & 1) << 5); R = (st >> 1) * 16 + swz / 64; C = (st & 1) * 32 + (swz % 64) / 2; }
__host__ __device__ __forceinline__ int perm32(int rho) { const int n = rho >> 4, i = rho & 15; return 8 * (i >> 2) + 4 * n + (i & 3); }

struct Unit { int pm, pn; };
struct Gemm { const bf16_t* A; const bf16_t* Bt; int M, N, K; };

struct StaticOrder {
    int nM, nN, nwg, G, c;
    __host__ __device__ void init(int M, int N, int G_, int c_, int bm = BM) { nM = M / bm; nN = N / BM; nwg = nM * nN; G = G_; c = c_; }
    __host__ __device__ bool next(int i, Unit& u) const {
        const long L = (long)i * G + c; if (L >= nwg) return false;
        int wgid = (int)L; { const int q = nwg / NXCD, r = nwg % NXCD, xcd = wgid % NXCD, off = wgid / NXCD; wgid = (xcd < r ? xcd * (q + 1) : r * (q + 1) + (xcd - r) * q) + off; }
        const int nig = WGM * nN, gid = wgid / nig, fm = gid * WGM, gsz = (nM - fm) < WGM ? (nM - fm) : WGM;
        u.pm = fm + ((wgid % nig) % gsz); u.pn = (wgid % nig) / gsz; return true;
    }
    __device__ __forceinline__ void a_ready(const Unit&) const {}
    __device__ __forceinline__ void done(const Unit&) const {}
};
template <class Epi, class Sched, bool ALIGN_EPI = false, bool SP2 = false, int BMR = 256, bool ONE_UNIT = false>
__device__ __forceinline__ void gemm_phase(PG8_LAS unsigned char* lds, const Gemm g, const Sched& S, const Epi& E, const int tid) {
    constexpr int HR = BMR / 2, MF = HR / 32;
    const int wid = __builtin_amdgcn_readfirstlane(tid >> 6), lane = tid & 63, wr = wid >> 2, wc = wid & 3, fr = lane & 15, fq = lane >> 4;
    const int K = g.K, nt = K / BK;
    unsigned voffA[2], voffB[2];
#pragma unroll
    for (int i = 0; i < 2; ++i) { int R, C; stage_rc(tid * 16 + i * 8192, R, C); const int Rb = Epi::PERM ? ((R & ~31) + perm32(R & 31)) : R;
        voffA[i] = (unsigned)(R * K + C) * 2u; voffB[i] = (unsigned)(Rb * K + C) * 2u; }
    const size_t kstep = (size_t)(BK * 2);
    const size_t hstep = (size_t)HALF * K * 2;
    const size_t tstep = 2 * hstep;
    const size_t hstepA = (size_t)HR * K * 2, tstepA = 2 * hstepA;
    const unsigned ldsw = (unsigned)wid * 1024u;
    const int aoff = lds_byte(wr * (HR / 2) + fr, fq * 8), boff = lds_byte(wc * 32 + fr, fq * 8);
#define PG8_SA(b, h) (((b) * 2 + (h)) * HTB)
#define PG8_SB(b, h) ((4 + (b) * 2 + (h)) * HTB)
#define PG8_STAGE(bufoff, gbase, voff) do { _Pragma("unroll") for (int _i = 0; _i < 2; ++_i) \
        __builtin_amdgcn_global_load_lds((const unsigned*)((const char*)(gbase) + (voff)[_i]), (PG8_LAS unsigned*)(lds + (bufoff) + ldsw + _i * 8192), 16, 0, 0); } while (0)
#define PG8_LDA(dst, b, h) do { _Pragma("unroll") for (int m = 0; m < MF; ++m) _Pragma("unroll") for (int k = 0; k < 2; ++k) dst[m][k] = *(const PG8_LAS bf16x8*)(lds + PG8_SA(b, h) + aoff + m * 2048 + k * 1024); } while (0)
#define PG8_LDB(dst, b, h) do { _Pragma("unroll") for (int n = 0; n < 2; ++n) _Pragma("unroll") for (int k = 0; k < 2; ++k) dst[n][k] = *(const PG8_LAS bf16x8*)(lds + PG8_SB(b, h) + boff + n * 2048 + k * 1024); } while (0)
#define PG8_MMA(ai, bj, At, Bt) do { __builtin_amdgcn_s_setprio(1); _Pragma("unroll") for (int m = 0; m < MF; ++m) _Pragma("unroll") for (int n = 0; n < 2; ++n) _Pragma("unroll") for (int k = 0; k < 2; ++k) \
        acc[ai][bj][m][n] = __builtin_amdgcn_mfma_f32_16x16x32_bf16(Bt[n][k], At[m][k], acc[ai][bj][m][n], 0, 0, 0); __builtin_amdgcn_s_setprio(0); } while (0)
#define PG8_WAIT_V(n) asm volatile("s_waitcnt vmcnt(" #n ")" ::: "memory")
#define PG8_WAIT_L(n) asm volatile("s_waitcnt lgkmcnt(" #n ")" ::: "memory")
#define PG8_BAR __builtin_amdgcn_s_barrier()
#define PG8_SCHED __builtin_amdgcn_sched_barrier(0)
    Unit cur, nxt; int ui = 0;
    if (!S.next(0, cur)) return;
    f32x4 acc[2][2][MF][2];
#pragma unroll
    for (int a = 0; a < 2; ++a)
#pragma unroll
        for (int b = 0; b < 2; ++b)
#pragma unroll
            for (int m = 0; m < MF; ++m)
#pragma unroll
                for (int n = 0; n < 2; ++n) acc[a][b][m][n] = (f32x4){0.f, 0.f, 0.f, 0.f};
    bf16x8 At[MF][2], B0[2][2], B1[2][2];
    const char* cA = (const char*)g.A + (size_t)cur.pm * tstepA; const char* cB = (const char*)g.Bt + (size_t)cur.pn * tstep;
    S.a_ready(cur);
    if constexpr (SP2) {
        PG8_STAGE(PG8_SB(0, 0), cB, voffB); PG8_STAGE(PG8_SB(0, 1), cB + hstep, voffB); PG8_STAGE(PG8_SA(0, 0), cA, voffA); PG8_STAGE(PG8_SA(0, 1), cA + hstepA, voffA);
        if (wr == 1) PG8_BAR;
        PG8_WAIT_V(2); PG8_BAR;
        PG8_STAGE(PG8_SB(1, 0), cB + kstep, voffB); PG8_STAGE(PG8_SA(1, 0), cA + kstep, voffA); PG8_STAGE(PG8_SB(1, 1), cB + hstep + kstep, voffB);
        PG8_WAIT_V(6); PG8_BAR;
    } else {
        PG8_STAGE(PG8_SB(0, 0), cB, voffB); PG8_STAGE(PG8_SA(0, 0), cA, voffA); PG8_STAGE(PG8_SB(0, 1), cB + hstep, voffB); PG8_STAGE(PG8_SA(0, 1), cA + hstepA, voffA);
        if (wr == 1) PG8_BAR;
        PG8_WAIT_V(4); PG8_BAR;
        PG8_STAGE(PG8_SB(1, 0), cB + kstep, voffB); PG8_STAGE(PG8_SA(1, 0), cA + kstep, voffA); PG8_STAGE(PG8_SB(1, 1), cB + hstep + kstep, voffB);
        PG8_WAIT_V(6); PG8_BAR;
    }
    for (;;) {
        const bool has_next = ONE_UNIT ? false : S.next(ui + 1, nxt);
        const char* nA = has_next ? (const char*)g.A + (size_t)nxt.pm * tstepA : cA; const char* nB = has_next ? (const char*)g.Bt + (size_t)nxt.pn * tstep : cB;
        for (int t = 0; t < nt; t += 2) {
            const bool last = (t == nt - 2);
            const char* a1 = cA + (size_t)(t + 1) * kstep;
            const char* a2 = last ? nA : cA + (size_t)(t + 2) * kstep; const char* b2 = last ? nB : cB + (size_t)(t + 2) * kstep;
            const char* a3 = a2 + kstep; const char* b3 = b2 + kstep;
            if (last && has_next) S.a_ready(nxt);
            if constexpr (SP2) {
            PG8_LDB(B0, 0, 0); PG8_LDB(B1, 0, 1); PG8_SCHED; PG8_LDA(At, 0, 0); PG8_STAGE(PG8_SA(1, 1), a1 + hstepA, voffA);
            PG8_WAIT_V(8); PG8_WAIT_L(0); PG8_BAR; PG8_MMA(0, 0, At, B0); PG8_MMA(0, 1, At, B1); PG8_BAR; PG8_SCHED;
            PG8_LDA(At, 0, 1); PG8_STAGE(PG8_SB(0, 0), b2, voffB); PG8_STAGE(PG8_SB(0, 1), b2 + hstep, voffB); PG8_STAGE(PG8_SA(0, 0), a2, voffA);
            PG8_WAIT_V(8); PG8_WAIT_L(0); PG8_BAR; PG8_MMA(1, 0, At, B0); PG8_MMA(1, 1, At, B1); PG8_BAR; PG8_SCHED;
            PG8_LDB(B0, 1, 0); PG8_LDB(B1, 1, 1); PG8_SCHED; PG8_LDA(At, 1, 0); PG8_STAGE(PG8_SA(0, 1), a2 + hstepA, voffA);
            PG8_WAIT_V(8); PG8_WAIT_L(0); PG8_BAR; PG8_MMA(0, 0, At, B0); PG8_MMA(0, 1, At, B1); PG8_BAR; PG8_SCHED;
            PG8_LDA(At, 1, 1); PG8_STAGE(PG8_SB(1, 0), b3, voffB); PG8_STAGE(PG8_SB(1, 1), b3 + hstep, voffB); PG8_STAGE(PG8_SA(1, 0), a3, voffA);
            PG8_WAIT_V(8); PG8_WAIT_L(0); PG8_BAR; PG8_MMA(1, 0, At, B0); PG8_MMA(1, 1, At, B1); PG8_BAR; PG8_SCHED;
            } else {
            PG8_LDB(B0, 0, 0); PG8_SCHED; PG8_LDA(At, 0, 0); PG8_STAGE(PG8_SA(1, 1), a1 + hstepA, voffA);
            PG8_WAIT_L(8); PG8_BAR; PG8_WAIT_L(0); PG8_MMA(0, 0, At, B0); PG8_BAR; PG8_SCHED;
            PG8_LDB(B1, 0, 1); PG8_STAGE(PG8_SB(0, 0), b2, voffB);
            PG8_BAR; PG8_WAIT_L(0); PG8_MMA(0, 1, At, B1); PG8_BAR;
            PG8_LDA(At, 0, 1); PG8_STAGE(PG8_SA(0, 0), a2, voffA);
            PG8_BAR; PG8_WAIT_L(0); PG8_MMA(1, 0, At, B0); PG8_BAR; PG8_SCHED;
            PG8_STAGE(PG8_SB(0, 1), b2 + hstep, voffB);
            PG8_WAIT_V(6); PG8_BAR; PG8_MMA(1, 1, At, B1); PG8_BAR;
            PG8_LDB(B0, 1, 0); PG8_SCHED; PG8_LDA(At, 1, 0); PG8_STAGE(PG8_SA(0, 1), a2 + hstepA, voffA);
            PG8_WAIT_L(8); PG8_BAR; PG8_WAIT_L(0); PG8_MMA(0, 0, At, B0); PG8_BAR; PG8_SCHED;
            PG8_LDB(B1, 1, 1); PG8_STAGE(PG8_SB(1, 0), b3, voffB);
            PG8_BAR; PG8_WAIT_L(0); PG8_MMA(0, 1, At, B1); PG8_BAR;
            PG8_LDA(At, 1, 1); PG8_STAGE(PG8_SA(1, 0), a3, voffA);
            PG8_BAR; PG8_WAIT_L(0); PG8_MMA(1, 0, At, B0); PG8_BAR; PG8_SCHED;
            PG8_STAGE(PG8_SB(1, 1), b3 + hstep, voffB);
            PG8_WAIT_V(6); PG8_BAR; PG8_MMA(1, 1, At, B1); PG8_BAR;
            }
        }
        if constexpr (ALIGN_EPI) { if (wr == 0) PG8_BAR; }
        if constexpr (!Epi::AFTER_DRAIN) { E(acc, cur, wr, wc, fr, fq); S.done(cur); }
        if (!has_next) break;
#pragma unroll
        for (int a = 0; a < 2; ++a)
#pragma unroll
            for (int b = 0; b < 2; ++b)
#pragma unroll
                for (int m = 0; m < MF; ++m)
#pragma unroll
                    for (int n = 0; n < 2; ++n) acc[a][b][m][n] = (f32x4){0.f, 0.f, 0.f, 0.f};
        cur = nxt; cA = nA; cB = nB; ++ui;
        if constexpr (ALIGN_EPI) { if (wr == 1) PG8_BAR; }
    }
    PG8_WAIT_V(0);
    if constexpr (!ALIGN_EPI) { if (wr == 0) PG8_BAR; }
    PG8_BAR;
    if constexpr (Epi::AFTER_DRAIN) { E.fused(acc, cur, wr, wc, fr, fq, lds, wid, lane); S.done(cur); }
#undef PG8_SA
#undef PG8_SB
#undef PG8_STAGE
#undef PG8_LDA
#undef PG8_LDB
#undef PG8_MMA
#undef PG8_WAIT_V
#undef PG8_WAIT_L
#undef PG8_BAR
#undef PG8_SCHED
}
}

#define LDS_BYTES 147456
typedef __attribute__((address_space(3))) unsigned char lds_u8;
template <class F> struct EpiAdapt {
  static constexpr bool PERM = false, AFTER_DRAIN = false;
  F f;
  __device__ __forceinline__ void operator()(const f32x4 (&acc)[2][2][4][2], const pg8::Unit& u, int wr, int wc, int fr, int fq) const {
#pragma unroll
    for (int ai = 0; ai < 2; ++ai)
#pragma unroll
      for (int m = 0; m < 4; ++m) {
        const int row = u.pm * 256 + ai * 128 + wr * 64 + m * 16 + fr;
#pragma unroll
        for (int bj = 0; bj < 2; ++bj)
#pragma unroll
          for (int n = 0; n < 2; ++n) f(row, u.pn * 256 + bj * 128 + wc * 32 + n * 16 + fq * 4, acc[ai][bj][m][n]);
        asm volatile("" ::: "memory");
      }
  }
};
template <class F>
__device__ __forceinline__ void gemm_phase(lds_u8* lds, const bf16_t* A, const bf16_t* Bt, int M, int Npad, int K, const F& f, int wq) {
  pg8::Gemm g{A, Bt, M, Npad, K};
  pg8::StaticOrder S; S.init(M, Npad, (int)gridDim.x, (int)blockIdx.x);
  EpiAdapt<F> E{f};
  pg8::gemm_phase<EpiAdapt<F>, pg8::StaticOrder, false, true>(lds, g, S, E, tidw(wq));
  __syncthreads();
}

struct EpiResidP {
  static constexpr bool PERM = false, AFTER_DRAIN = false;
  float* x; const float* g;
  __device__ __forceinline__ void operator()(const f32x4 (&acc)[2][2][4][2], const pg8::Unit& u, int wr, int wc, int fr, int fq) const {
    const int cond = (u.pm < 16) ? 0 : ((u.pm < 32) ? 1 : 2);
    const int col0 = u.pn * 256 + wc * 32 + 4 * fq;
    f32x4 gv[2][2];
#pragma unroll
    for (int bj = 0; bj < 2; ++bj)
#pragma unroll
      for (int n = 0; n < 2; ++n) gv[bj][n] = *(const f32x4*)(g + cond * 6144 + col0 + bj * 128 + n * 16);
#pragma unroll
    for (int ai = 0; ai < 2; ++ai) {
      float* xb = x + (size_t)(u.pm * 256 + ai * 128 + wr * 64 + fr) * DM + col0;
      f32x4 xv[4][2][2];
#pragma unroll
      for (int m = 0; m < 4; ++m)
#pragma unroll
        for (int bj = 0; bj < 2; ++bj)
#pragma unroll
          for (int n = 0; n < 2; ++n) xv[m][bj][n] = *(const f32x4*)(xb + (size_t)m * 16 * DM + bj * 128 + n * 16);
#pragma unroll
      for (int m = 0; m < 4; ++m)
#pragma unroll
        for (int bj = 0; bj < 2; ++bj)
#pragma unroll
          for (int n = 0; n < 2; ++n) *(f32x4*)(xb + (size_t)m * 16 * DM + bj * 128 + n * 16) = xv[m][bj][n] + gv[bj][n] * acc[ai][bj][m][n];
      asm volatile("" ::: "memory");
    }
  }
};
struct EpiResidP192 {
  static constexpr bool PERM = false, AFTER_DRAIN = false;
  float* x; const float* g;
  __device__ __forceinline__ void operator()(const f32x4 (&acc)[2][2][3][2], const pg8::Unit& u, int wr, int wc, int fr, int fq) const {
    const int col0 = u.pn * 256 + wc * 32 + 4 * fq;
#pragma unroll
    for (int ai = 0; ai < 2; ++ai) {
      const int row0 = u.pm * 192 + ai * 96 + wr * 48;
      float* xb = x + (size_t)(row0 + fr) * DM + col0;
      f32x4 xv[3][2][2], gv[3][2][2];
#pragma unroll
      for (int m = 0; m < 3; ++m) {
        const int rf = row0 + m * 16, cond = (rf < T_CTX) ? 0 : 1 + ((rf - T_CTX) >> 12);
#pragma unroll
        for (int bj = 0; bj < 2; ++bj)
#pragma unroll
          for (int n = 0; n < 2; ++n) { xv[m][bj][n] = *(const f32x4*)(xb + (size_t)m * 16 * DM + bj * 128 + n * 16); gv[m][bj][n] = *(const f32x4*)(g + cond * 6144 + col0 + bj * 128 + n * 16); }
      }
#pragma unroll
      for (int m = 0; m < 3; ++m)
#pragma unroll
        for (int bj = 0; bj < 2; ++bj)
#pragma unroll
          for (int n = 0; n < 2; ++n) *(f32x4*)(xb + (size_t)m * 16 * DM + bj * 128 + n * 16) = xv[m][bj][n] + gv[m][bj][n] * acc[ai][bj][m][n];
      asm volatile("" ::: "memory");
    }
  }
};
template <bool FINAL>
struct EpiResidNorm192 {
  static constexpr bool PERM = false, AFTER_DRAIN = false;
  float* x; const float* g; float* part; unsigned* cnt; const float* nw; const float* modl; int sh_off, sc_off; bf16_t* hout;
  template <bool UNI>
  __device__ __forceinline__ void run(f32x4 (&acc)[2][2][3][2], const pg8::Unit& u, int wr, int wc, int fr, int fq) const {
    const int col0 = u.pn * 256 + wc * 32 + 4 * fq;
    const int tile0 = u.pm * 192, cond0 = (tile0 < T_CTX) ? 0 : 1 + ((tile0 - T_CTX) >> 12);
    f32x4 wsu[2][2];
    if (UNI) {
#pragma unroll
      for (int bj = 0; bj < 2; ++bj)
#pragma unroll
        for (int n = 0; n < 2; ++n) { const int c = col0 + bj * 128 + n * 16;
          const f32x4 w = *(const f32x4*)(nw + c);
          if (FINAL) wsu[bj][n] = w;
          else { const f32x4 sc = *(const f32x4*)(modl + cond0 * 6144 + sc_off + c); wsu[bj][n] = w * (1.f + sc); } }
    }
#pragma unroll
    for (int ai = 0; ai < 2; ++ai) {
      const int row0 = tile0 + ai * 96 + wr * 48;
      float* xb = x + (unsigned)(row0 + fr) * DM + col0;
#pragma unroll
      for (int m = 0; m < 3; ++m) {
        const int rf = row0 + m * 16, cond = UNI ? cond0 : ((rf < T_CTX) ? 0 : 1 + ((rf - T_CTX) >> 12));
        f32x4 xv[2][2];
#pragma unroll
        for (int bj = 0; bj < 2; ++bj)
#pragma unroll
          for (int n = 0; n < 2; ++n) xv[bj][n] = *(const f32x4*)(xb + (unsigned)m * 16 * DM + bj * 128 + n * 16);
        float ss = 0.f;
#pragma unroll
        for (int bj = 0; bj < 2; ++bj)
#pragma unroll
          for (int n = 0; n < 2; ++n) {
            const f32x4 gv = *(const f32x4*)(g + cond * 6144 + col0 + bj * 128 + n * 16);
            const f32x4 xn = xv[bj][n] + gv * acc[ai][bj][m][n];
            acc[ai][bj][m][n] = xn;
            if (!FINAL) *(f32x4*)(xb + (unsigned)m * 16 * DM + bj * 128 + n * 16) = xn;
            ss += xn[0] * xn[0] + xn[1] * xn[1] + xn[2] * xn[2] + xn[3] * xn[3];
          }
        ss += __shfl_xor(ss, 16); ss += __shfl_xor(ss, 32);
        if (fq == 0) { float* d = part + (unsigned)(rf + fr) * 16 + u.pn * 4 + wc; asm volatile("global_store_dword %0, %1, off sc1" :: "v"(d), "v"(ss) : "memory"); }
      }
    }
    asm volatile("s_waitcnt vmcnt(0)" ::: "memory");
    __syncthreads();
    if (wr == 0 && wc == 0) {
      unsigned* cw = cnt + u.pm * 64;
      if (fq * 16 + fr == 0) __hip_atomic_fetch_add(cw, 1u, __ATOMIC_RELAXED, __HIP_MEMORY_SCOPE_AGENT);
      unsigned spins = 0;
      while ((unsigned)__builtin_amdgcn_readfirstlane(__hip_atomic_load(cw, __ATOMIC_RELAXED, __HIP_MEMORY_SCOPE_AGENT)) < 4u) {
        __builtin_amdgcn_s_sleep(1);
        if (++spins > (1u << 22)) break;
      }
      __builtin_amdgcn_fence(__ATOMIC_ACQUIRE, "agent");
      asm volatile("s_waitcnt vmcnt(0)" ::: "memory");
    }
    __syncthreads();
#pragma unroll
    for (int ai = 0; ai < 2; ++ai) {
      const int row0 = tile0 + ai * 96 + wr * 48;
      f32x4 p4[3];
#pragma unroll
      for (int m = 0; m < 3; ++m) p4[m] = *(const f32x4*)(part + (unsigned)(row0 + m * 16 + fr) * 16 + 4 * fq);
#pragma unroll
      for (int m = 0; m < 3; ++m) {
        const int rf = row0 + m * 16, cond = UNI ? cond0 : ((rf < T_CTX) ? 0 : 1 + ((rf - T_CTX) >> 12));
        float tot = (p4[m][0] + p4[m][1]) + (p4[m][2] + p4[m][3]);
        tot += __shfl_xor(tot, 16); tot += __shfl_xor(tot, 32);
        const float rstd = rsqrtf(tot * (1.f / DM) + EPS);
#pragma unroll
        for (int bj = 0; bj < 2; ++bj)
#pragma unroll
          for (int n = 0; n < 2; ++n) {
            const int c = col0 + bj * 128 + n * 16;
            const f32x4 xn = acc[ai][bj][m][n];
            f32x4 ws, sh;
            if (UNI) { ws = wsu[bj][n]; if (!FINAL) sh = *(const f32x4*)(modl + cond0 * 6144 + sh_off + c); }
            else { const f32x4 w = *(const f32x4*)(nw + c);
              if (FINAL) ws = w; else { ws = w * (1.f + *(const f32x4*)(modl + cond * 6144 + sc_off + c)); sh = *(const f32x4*)(modl + cond * 6144 + sh_off + c); } }
            if (FINAL) {
              *(f32x4*)(x + (unsigned)(rf + fr) * DM + c) = xn * rstd * ws;
            } else {
              u32x2 o; o[0] = pack2(xn[0] * rstd * ws[0] + sh[0], xn[1] * rstd * ws[1] + sh[1]);
              o[1] = pack2(xn[2] * rstd * ws[2] + sh[2], xn[3] * rstd * ws[3] + sh[3]);
              *(u32x2*)(hout + (unsigned)(rf + fr) * DM + c) = o;
            }
          }
      }
    }
  }
  __device__ __forceinline__ void operator()(f32x4 (&acc)[2][2][3][2], const pg8::Unit& u, int wr, int wc, int fr, int fq) const {
    const int t0 = u.pm * 192, t1 = t0 + 191;
    const int c0 = (t0 < T_CTX) ? 0 : 1 + ((t0 - T_CTX) >> 12), c1 = (t1 < T_CTX) ? 0 : 1 + ((t1 - T_CTX) >> 12);
    if (c0 == c1) run<true>(acc, u, wr, wc, fr, fq); else run<false>(acc, u, wr, wc, fr, fq);
  }
};
template <bool FINAL>
__device__ __forceinline__ void gemm_phase_residnorm192(lds_u8* lds, const bf16_t* A, const bf16_t* Bt, int K, float* x, const float* g, float* part, unsigned* cnt,
                                                        const float* nw, const float* modl, int sh_off, int sc_off, bf16_t* hout, int wq) {
  pg8::Gemm gm{A, Bt, T_TOK, 1024, K};
  pg8::StaticOrder S; S.init(T_TOK, 1024, (int)gridDim.x, (int)blockIdx.x, 192);
  EpiResidNorm192<FINAL> E{x, g, part, cnt, nw, modl, sh_off, sc_off, hout};
  pg8::gemm_phase<EpiResidNorm192<FINAL>, pg8::StaticOrder, true, true, 192, true>(lds, gm, S, E, tidw(wq));
  __syncthreads();
}
__device__ __forceinline__ void gemm_phase_resid192(lds_u8* lds, const bf16_t* A, const bf16_t* Bt, int M, int Npad, int K, float* x, const float* g, int wq) {
  pg8::Gemm gm{A, Bt, M, Npad, K};
  pg8::StaticOrder S; S.init(M, Npad, (int)gridDim.x, (int)blockIdx.x, 192);
  EpiResidP192 E{x, g};
  pg8::gemm_phase<EpiResidP192, pg8::StaticOrder, false, true, 192>(lds, gm, S, E, tidw(wq));
  __syncthreads();
}
__device__ __forceinline__ void gemm_phase_resid(lds_u8* lds, const bf16_t* A, const bf16_t* Bt, int M, int Npad, int K, float* x, const float* g, int wq) {
  pg8::Gemm gm{A, Bt, M, Npad, K};
  pg8::StaticOrder S; S.init(M, Npad, (int)gridDim.x, (int)blockIdx.x);
  EpiResidP E{x, g};
  pg8::gemm_phase<EpiResidP, pg8::StaticOrder, false, true>(lds, gm, S, E, tidw(wq));
  __syncthreads();
}
template <class F> struct EpiAdapt8 {
  static constexpr bool PERM = true, AFTER_DRAIN = false;
  F f;
  __device__ __forceinline__ void operator()(const f32x4 (&acc)[2][2][4][2], const pg8::Unit& u, int wr, int wc, int fr, int fq) const {
#pragma unroll
    for (int ai = 0; ai < 2; ++ai)
#pragma unroll
      for (int m = 0; m < 4; ++m) {
        const int row = u.pm * 256 + ai * 128 + wr * 64 + m * 16 + fr;
#pragma unroll
        for (int bj = 0; bj < 2; ++bj) f.st8(row, u.pn * 256 + bj * 128 + wc * 32 + fq * 8, acc[ai][bj][m][0], acc[ai][bj][m][1]);
      }
  }
};
template <class F>
__device__ __forceinline__ void gemm_phase8(lds_u8* lds, const bf16_t* A, const bf16_t* Bt, int M, int Npad, int K, const F& f, int wq) {
  pg8::Gemm g{A, Bt, M, Npad, K};
  pg8::StaticOrder S; S.init(M, Npad, (int)gridDim.x, (int)blockIdx.x);
  EpiAdapt8<F> E{f};
  pg8::gemm_phase<EpiAdapt8<F>, pg8::StaticOrder, false, true>(lds, g, S, E, tidw(wq));
  __syncthreads();
}
__device__ __forceinline__ void st_bf8(bf16_t* d, f32x4 a, f32x4 b) { u32x4 o = {cvt2(a[0], a[1]), cvt2(a[2], a[3]), cvt2(b[0], b[1]), cvt2(b[2], b[3])}; *(u32x4*)d = o; }
__device__ __forceinline__ void st_bf4(bf16_t* d, f32x4 v) { u32x2 o; o[0] = pack2(v[0], v[1]); o[1] = pack2(v[2], v[3]); *(u32x2*)d = o; }

struct EpiSsmIn { bf16_t *Pz, *Pxbc; float* small;
  __device__ __forceinline__ void operator()(int m, int n, f32x4 v) const {
    if (n < 2048) st_bf4(Pz + (size_t)m * 2048 + n, v);
    else if (n < 6144) st_bf4(Pxbc + (size_t)m * 4096 + (n - 2048), v);
    else if (n < 6208) *(f32x4*)(small + (size_t)m * 64 + (n - 6144)) = v;
  }
  __device__ __forceinline__ void st8(int m, int n, f32x4 a, f32x4 b) const {
    if (n < 2048) st_bf8(Pz + (size_t)m * 2048 + n, a, b);
    else if (n < 6144) st_bf8(Pxbc + (size_t)m * 4096 + (n - 2048), a, b);
    else if (n < 6208) { float* d = small + (size_t)m * 64 + (n - 6144); *(f32x4*)d = a; *(f32x4*)(d + 4) = b; }
  } };
struct EpiGlaIn { bf16_t *A, *Pz; float* G; const float* gb;
  __device__ __forceinline__ void st8(int m, int n, f32x4 a, f32x4 b) const {
    if (n < 512) st_bf8(A + (size_t)m * 2048 + n, a * 0.08838834764831845f, b * 0.08838834764831845f);
    else if (n < 2048) st_bf8(A + (size_t)m * 2048 + n, a, b);
    else if (n < 3072) st_bf8(Pz + (size_t)m * 1024 + (n - 2048), a, b);
    else {
      const int c = n - 3072;
      const f32x4 b0 = *(const f32x4*)(gb + c), b1 = *(const f32x4*)(gb + c + 4);
      f32x4 o0, o1;
#pragma unroll
      for (int q = 0; q < 4; ++q) { o0[q] = -softplus_fast(-(a[q] + b0[q])) * (1.f / 16.f); o1[q] = -softplus_fast(-(b[q] + b1[q])) * (1.f / 16.f); }
      float* d = G + (size_t)m * 1024 + c; *(f32x4*)d = o0; *(f32x4*)(d + 4) = o1;
    }
  } };
struct EpiGdnIn { bf16_t *Pz, *Pxbc; float* small;
  __device__ __forceinline__ void operator()(int m, int n, f32x4 v) const {
    if (n < 4096) st_bf4(Pxbc + (size_t)m * 4096 + n, v);
    else if (n < 6144) st_bf4(Pz + (size_t)m * 2048 + (n - 4096), v);
    else if (n < 6176) *(f32x4*)(small + (size_t)m * 64 + (n - 6144)) = v;
  }
  __device__ __forceinline__ void st8(int m, int n, f32x4 a, f32x4 b) const {
    if (n < 4096) st_bf8(Pxbc + (size_t)m * 4096 + n, a, b);
    else if (n < 6144) st_bf8(Pz + (size_t)m * 2048 + (n - 4096), a, b);
    else if (n < 6176) { float* d = small + (size_t)m * 64 + (n - 6144); *(f32x4*)d = a; *(f32x4*)(d + 4) = b; }
  } };
struct EpiFfnIn { bf16_t *Pa, *Pv;
  __device__ __forceinline__ void operator()(int m, int n, f32x4 v) const {
    if (n < DFF) st_bf4(Pa + (size_t)m * DFF + n, v); else st_bf4(Pv + (size_t)m * DFF + (n - DFF), v);
  }
  __device__ __forceinline__ void st8(int m, int n, f32x4 a, f32x4 b) const {
    if (n < DFF) st_bf8(Pa + (size_t)m * DFF + n, a, b); else st_bf8(Pv + (size_t)m * DFF + (n - DFF), a, b);
  } };
struct EpiResid { float* x; const float* g;
  __device__ __forceinline__ void operator()(int m, int n, f32x4 v) const {
    const int cond = (m < T_CTX) ? 0 : 1 + ((m - T_CTX) >> 12);
    const f32x4 gv = *(const f32x4*)(g + cond * 6144 + n);
    f32x4* d = (f32x4*)(x + (size_t)m * DM + n);
    f32x4 o = *d; o += gv * v; *d = o;
  } };

__device__ __forceinline__ void ph_ssm_pre(const P& p, int j) {
  const int tid = tidw(p.wq);
  const int gtid = blockIdx.x * NT + tid, gsz = gridDim.x * NT;
  const float* cw = p.ssm_conv_w + (size_t)j * 3 * 4096; const float* cb = p.ssm_conv_b + (size_t)j * 4096;
  const int per = (T_TOK + (int)gridDim.x - 1) / (int)gridDim.x;
  const int tbeg = (int)blockIdx.x * per, tend = (tbeg + per < T_TOK) ? tbeg + per : T_TOK;
  {
    const int c = tid * 8;
    float w[3][8], bias[8];
#pragma unroll
    for (int k = 0; k < 3; ++k) { const f32x4 w0 = *(const f32x4*)(cw + k * 4096 + c), w1 = *(const f32x4*)(cw + k * 4096 + c + 4);
      w[k][0] = w0[0]; w[k][1] = w0[1]; w[k][2] = w0[2]; w[k][3] = w0[3]; w[k][4] = w1[0]; w[k][5] = w1[1]; w[k][6] = w1[2]; w[k][7] = w1[3]; }
    { const f32x4 b0 = *(const f32x4*)(cb + c), b1 = *(const f32x4*)(cb + c + 4);
      bias[0] = b0[0]; bias[1] = b0[1]; bias[2] = b0[2]; bias[3] = b0[3]; bias[4] = b1[0]; bias[5] = b1[1]; bias[6] = b1[2]; bias[7] = b1[3]; }
    const u32x4 z4 = {0u, 0u, 0u, 0u};
    for (int t = tbeg; t < tend; t += 4) {
      int t0, L, cond; tok_info(t, t0, L, cond);
      const int pos = t - t0;
      const bf16_t* srcp = p.Pxbc + (size_t)t * 4096 + c;
      u32x4 X[6];
#pragma unroll
      for (int jx = 0; jx < 6; ++jx) X[jx] = (pos + jx - 1 >= 0 && pos + jx - 1 < L) ? *(const u32x4*)(srcp + (jx - 1) * 4096) : z4;
#pragma unroll
      for (int k = 0; k < 4; ++k) {
        u32x4 o;
#pragma unroll
        for (int q = 0; q < 4; ++q) {
          const float v0 = bias[2 * q] + w[0][2 * q] * bflo(X[k][q]) + w[1][2 * q] * bflo(X[k + 1][q]) + w[2][2 * q] * bflo(X[k + 2][q]);
          const float v1 = bias[2 * q + 1] + w[0][2 * q + 1] * bfhi(X[k][q]) + w[1][2 * q + 1] * bfhi(X[k + 1][q]) + w[2][2 * q + 1] * bfhi(X[k + 2][q]);
          o[q] = pack2(silu_f(v0), silu_f(v1));
        }
        *(u32x4*)(p.A + (size_t)(t + k) * 4096 + c) = o;
      }
    }
  }
  for (int it = gtid; it < T_TOK * 64; it += gsz) {
    const int t = it >> 6, dh = it & 63;
    const float raw = p.small[(size_t)t * 64 + dh];
    const float dt = softplus_f(raw + p.ssm_dt_bias[j * 64 + dh]);
    const float la = -__expf(p.ssm_a_log[j * 64 + dh]) * dt;
    p.small2[(size_t)t * 128 + dh] = dt; p.small2[(size_t)t * 128 + 64 + dh] = la;
  }
}

__device__ __forceinline__ void ph_ssm_tiles(const P& p, int j, unsigned char* shm) {
  const int tid = tidw(p.wq), wave = tid >> 6, lane = tid & 63;
  bf16_t* Bs = (bf16_t*)shm;
  bf16_t* Xs = Bs + 64 * 136;
  bf16_t* Cs = Xs + 64 * 264;
  const float* cw = p.ssm_conv_w + (size_t)j * 3 * 4096; const float* cb = p.ssm_conv_b + (size_t)j * 4096;
  const int cgi = tid & 63, to = tid >> 6;
  const u32x4 z4 = {0u, 0u, 0u, 0u};
#define SSM_LOADX(itm_) do { const int g_ = (itm_) & 7, tk0_ = ((itm_) >> 3) * 64; \
      const int chg_ = (cgi < 32) ? (g_ * 256 + cgi * 8) : ((cgi < 48) ? (2048 + g_ * 128 + (cgi - 32) * 8) : (3072 + g_ * 128 + (cgi - 48) * 8)); \
      int t0_, L_, cond_; tok_info(tk0_, t0_, L_, cond_); const int posb_ = tk0_ - t0_ + 8 * to - 1; \
      const bf16_t* srcp_ = p.Pxbc + (size_t)(tk0_ + 8 * to - 1) * 4096 + chg_; \
      _Pragma("unroll") for (int r = 0; r < 10; ++r) X[r] = (posb_ + r >= 0 && posb_ + r < L_) ? *(const u32x4*)(srcp_ + (size_t)r * 4096) : z4; } while (0)
  u32x4 X[10];
  if ((int)blockIdx.x < 192 * 8) SSM_LOADX((int)blockIdx.x);
  float w[3][8], bias[8]; int gcur = -1;
  for (int item = blockIdx.x; item < 192 * 8; item += gridDim.x) {
    const int c = item >> 3, g = item & 7, tok0 = c * 64;
    const int sr_ = wave & 3, sdir_ = wave >> 2, shead_ = g * 4 + sr_, stk_ = sdir_ ? 63 - lane : lane;
    const float raw_pre = p.small[(size_t)(tok0 + stk_) * 64 + sdir_ * 32 + shead_];
    {
      const int chg = (cgi < 32) ? (g * 256 + cgi * 8) : ((cgi < 48) ? (2048 + g * 128 + (cgi - 32) * 8) : (3072 + g * 128 + (cgi - 48) * 8));
      bf16_t* ld = (cgi < 32) ? (Xs + cgi * 8) : ((cgi < 48) ? (Bs + (cgi - 32) * 8) : (Cs + (cgi - 48) * 8));
      const int lstride = (cgi < 32) ? 264 : 136;
      if (g != gcur) {
        gcur = g;
#pragma unroll
        for (int k = 0; k < 3; ++k) { const f32x4 w0 = *(const f32x4*)(cw + k * 4096 + chg), w1 = *(const f32x4*)(cw + k * 4096 + chg + 4);
          w[k][0] = w0[0]; w[k][1] = w0[1]; w[k][2] = w0[2]; w[k][3] = w0[3]; w[k][4] = w1[0]; w[k][5] = w1[1]; w[k][6] = w1[2]; w[k][7] = w1[3]; }
        { const f32x4 b0 = *(const f32x4*)(cb + chg), b1 = *(const f32x4*)(cb + chg + 4);
          bias[0] = b0[0]; bias[1] = b0[1]; bias[2] = b0[2]; bias[3] = b0[3]; bias[4] = b1[0]; bias[5] = b1[1]; bias[6] = b1[2]; bias[7] = b1[3]; }
      }
      u32x4 oo[8];
#pragma unroll
      for (int k = 0; k < 8; ++k) {
#pragma unroll
        for (int q = 0; q < 4; ++q) {
          const float v0 = bias[2 * q] + w[0][2 * q] * bflo(X[k][q]) + w[1][2 * q] * bflo(X[k + 1][q]) + w[2][2 * q] * bflo(X[k + 2][q]);
          const float v1 = bias[2 * q + 1] + w[0][2 * q + 1] * bfhi(X[k][q]) + w[1][2 * q + 1] * bfhi(X[k + 1][q]) + w[2][2 * q + 1] * bfhi(X[k + 2][q]);
          oo[k][q] = pack2(silu_f(v0), silu_f(v1));
        }
      }
      { const int nxt = item + (int)gridDim.x; if (nxt < 192 * 8) SSM_LOADX(nxt); }
#pragma unroll
      for (int k = 0; k < 8; ++k) {
        if (cgi >= 48) *(u32x4*)(p.A + (size_t)(tok0 + 8 * to + k) * 4096 + chg) = oo[k];
        *(u32x4*)(ld + (8 * to + k) * lstride) = oo[k];
      }
    }
    __syncthreads();
    bf16_t* BTt = p.BT + (size_t)item * 8192;
    for (int q = tid; q < 1024; q += NT) { const int n = q >> 3, cc = q & 7;
      unsigned short v[8];
#pragma unroll
      for (int qq = 0; qq < 8; ++qq) v[qq] = Bs[kperm(cc * 8 + qq) * 136 + n];
      u32x4 o = {(unsigned)v[0] | ((unsigned)v[1] << 16), (unsigned)v[2] | ((unsigned)v[3] << 16), (unsigned)v[4] | ((unsigned)v[5] << 16), (unsigned)v[6] | ((unsigned)v[7] << 16)};
      *(u32x4*)(BTt + n * 64 + cc * 8) = o; }
    bf16_t* XTt = p.XT + (size_t)(c * 32 + g * 4) * 4096;
    for (int q = tid; q < 2048; q += NT) { const int ch = q >> 3, cc = q & 7;
      unsigned short v[8];
#pragma unroll
      for (int qq = 0; qq < 8; ++qq) v[qq] = Xs[kperm(cc * 8 + qq) * 264 + ch];
      u32x4 o = {(unsigned)v[0] | ((unsigned)v[1] << 16), (unsigned)v[2] | ((unsigned)v[3] << 16), (unsigned)v[4] | ((unsigned)v[5] << 16), (unsigned)v[6] | ((unsigned)v[7] << 16)};
      *(u32x4*)(XTt + ch * 64 + cc * 8) = o; }
    if (wave < 4) {
      const int ti = wave >> 1, tj = wave & 1, col = lane & 31, h = lane >> 5;
      f32x16 acc;
#pragma unroll
      for (int r = 0; r < 16; ++r) acc[r] = 0.f;
      const bf16_t* cp = Cs + (32 * ti + col) * 136 + 8 * h;
      const bf16_t* bp = Bs + (32 * tj + col) * 136 + 8 * h;
#pragma unroll
      for (int s = 0; s < 8; ++s) { const bf16x8 a = *(const bf16x8*)(cp + 16 * s), b = *(const bf16x8*)(bp + 16 * s); acc = MFMA32(a, b, acc); }
      bf16_t* Gt = p.Gm + (size_t)item * 4096;
#pragma unroll
      for (int r = 0; r < 16; ++r) { const int i = 32 * ti + (r & 3) + 8 * (r >> 2) + 4 * h; Gt[i * 64 + kperm(32 * tj + col)] = f2bf(acc[r]); }
    }
    {
      const int r = wave & 3, dir = wave >> 2, head = g * 4 + r, tk = dir ? 63 - lane : lane;
      const float dt = softplus_f(raw_pre + p.ssm_dt_bias[j * 64 + dir * 32 + head]);
      const float la = -__expf(p.ssm_a_log[j * 64 + dir * 32 + head]) * dt;
      const float cs = wave_scan_incl(la);
      const float tot = __builtin_bit_cast(float, __builtin_amdgcn_readlane(__builtin_bit_cast(int, cs), 63));
      float* vec = p.VEC + ((size_t)(c * 32 + head) * 2 + dir) * 192;
      vec[tk] = cs; vec[64 + tk] = __logf(dt) - cs; vec[128 + tk] = dt * __expf(tot - cs);
    }
    __syncthreads();
  }
}

__device__ __forceinline__ void put4(f32x16& v, int k, u32x4 x) { v[4 * k] = __uint_as_float(x[0]); v[4 * k + 1] = __uint_as_float(x[1]); v[4 * k + 2] = __uint_as_float(x[2]); v[4 * k + 3] = __uint_as_float(x[3]); }
__device__ __forceinline__ u32x4 get4(const f32x16& v, int k) { u32x4 x = {__float_as_uint(v[4 * k]), __float_as_uint(v[4 * k + 1]), __float_as_uint(v[4 * k + 2]), __float_as_uint(v[4 * k + 3])}; return x; }
__device__ __forceinline__ u32x4 scale8(u32x4 x, float f0, float f1, float f2, float f3, float f4, float f5, float f6, float f7) {
  u32x4 o = {cvt2(bflo(x[0]) * f0, bfhi(x[0]) * f1), cvt2(bflo(x[1]) * f2, bfhi(x[1]) * f3), cvt2(bflo(x[2]) * f4, bfhi(x[2]) * f5), cvt2(bflo(x[3]) * f6, bfhi(x[3]) * f7)};
  return o;
}
__device__ __forceinline__ int grp_pos_bytes(int G) { const int w = G & 3; return ((G & ~3) | (((w & 1) << 1) | (w >> 1))) * 8; }
#define SSM_OFF_Q 0
#define SSM_OFF_BT 17408
#define SSM_OFF_M 35840
#define SSM_OFF_W 45056
#define SSM_BUF 45824
#define SSM_OFF_SB (2 * SSM_BUF)
__device__ __forceinline__ void ph_ssm_chain(const P& p, int j, lds_u8* lds) {
  const int tid = tidw(p.wq), wave = __builtin_amdgcn_readfirstlane(tid >> 6), lane = tid & 63, col = lane & 31, h = lane >> 5;
  float* out_state = p.out + (size_t)T_TOK * DM;
  const int nlat = 128, nitem = 1152, G = (int)gridDim.x;
  const int stride = ((int)blockIdx.x < nlat) ? nitem : (G - nlat);
  for (int item = (int)blockIdx.x; item < nitem; item += stride) {
    int seq, dir, head;
    if (item < 128) { const int x = item & 7, k = item >> 3, cmb = x * 4 + (k >> 2); seq = 16 + (cmb >> 4); dir = (cmb >> 3) & 1; head = (cmb & 7) * 4 + (k & 3); }
    else { const int i2 = item - 128, x = i2 & 7, kk = i2 >> 3, cmb = (kk >> 2) * 8 + x; seq = cmb >> 4; dir = (cmb >> 3) & 1; head = (cmb & 7) * 4 + (kk & 3); }
    int chunk0, nch; if (seq < 16) { chunk0 = seq * 4; nch = 4; } else { chunk0 = 64 + (seq - 16) * 64; nch = 64; }
    const int g = head >> 2;
    const float dskip = dir ? 0.f : p.ssm_d[j * 32 + head];
#define SSM_MPIECE(gq_, cs_i_, aj_, ii_, c8_) do { float m_[8]; \
      const int jb_ = 16 * ((c8_) >> 1) + 4 * ((c8_) & 1); \
      _Pragma("unroll") for (int e = 0; e < 8; ++e) { const int jj = jb_ + (e & 3) + 8 * (e >> 2); \
        const float gv = (e & 1) ? bfhi((gq_)[e >> 1]) : bflo((gq_)[e >> 1]); \
        const float val = gv * __expf((cs_i_) + (aj_)[e]); const bool keep = dir ? (jj >= (ii_)) : (jj <= (ii_)); m_[e] = (keep ? val : 0.f) + ((jj == (ii_)) ? dskip : 0.f); } \
      const u32x4 mo_ = {cvt2(m_[0], m_[1]), cvt2(m_[2], m_[3]), cvt2(m_[4], m_[5]), cvt2(m_[6], m_[7])}; \
      *(LAS u32x4*)(buf + SSM_OFF_M + (ii_) * 144 + (c8_) * 16) = mo_; } while (0)
    if (wave >= 4) {
      const int ltid = tid - 256, lrow = ltid >> 4, lc16 = ltid & 15, lc8 = ltid & 7, grow = ltid >> 3;
      const unsigned lo_c = (unsigned)(((ltid >> 4) * 4096 + (ltid & 15) * 8) * 2), lo_t = (unsigned)(ltid * 16);
      u32x4 RCc[2][4], RB[2][4], RG[2], RG2[2]; float RS[2][16];
#define SSM_LLOAD(set, stepn) do { const int c_ = chunk0 + (dir ? nch - 1 - (stepn) : (stepn)); \
        const char* Cb_ = (const char*)(p.A + (size_t)c_ * 64 * 4096 + 3072 + g * 128); const char* BTt_ = (const char*)(p.BT + (size_t)(c_ * 8 + g) * 8192); \
        const char* Gt_ = (const char*)(p.Gm + (size_t)(c_ * 8 + g) * 4096); const float* v0_ = p.VEC + ((size_t)(c_ * 32 + head) * 2 + dir) * 192; \
        _Pragma("unroll") for (int i = 0; i < 4; ++i) { RCc[set][i] = *(const u32x4*)(Cb_ + i * 131072 + lo_c); RB[set][i] = *(const u32x4*)(BTt_ + i * 4096 + lo_t); } \
        RG[set] = *(const u32x4*)(Gt_ + lo_t); RG2[set] = *(const u32x4*)(Gt_ + 4096 + lo_t); RS[set][4] = v0_[grow]; RS[set][7] = v0_[32 + grow]; RS[set][5] = v0_[dir ? 0 : 63]; RS[set][6] = v0_[128 + (ltid & 63)]; RS[set][0] = v0_[ltid & 63]; \
        { const int ao_ = 64 + 16 * (lc8 >> 1) + 4 * (lc8 & 1); const f32x4 a0_ = *(const f32x4*)(v0_ + ao_), a1_ = *(const f32x4*)(v0_ + ao_ + 8); \
          _Pragma("unroll") for (int e = 0; e < 4; ++e) { RS[set][8 + e] = a0_[e]; RS[set][12 + e] = a1_[e]; } } } while (0)
#define SSM_LWRITE(set, bufi) do { lds_u8* buf = lds + (bufi) * SSM_BUF; \
        const int p0 = grp_pos_bytes(2 * lc16), p1 = grp_pos_bytes(2 * lc16 + 1); \
        _Pragma("unroll") for (int i = 0; i < 4; ++i) { const int row = lrow + 16 * i; \
          const u32x4 q0 = RCc[set][i];     \
          *(LAS u32x2*)(buf + SSM_OFF_Q + row * 272 + p0) = (u32x2){q0[0], q0[1]}; \
          *(LAS u32x2*)(buf + SSM_OFF_Q + row * 272 + p1) = (u32x2){q0[2], q0[3]}; \
          const int q = ltid + 256 * i; *(LAS u32x4*)(buf + SSM_OFF_BT + (q >> 3) * 144 + (q & 7) * 16) = RB[set][i]; } \
        SSM_MPIECE(RG[set], RS[set][4], (&RS[set][8]), grow, lc8); SSM_MPIECE(RG2[set], RS[set][7], (&RS[set][8]), 32 + grow, lc8); \
        if (ltid < 64) { LAS float* wv = (LAS float*)(buf + SSM_OFF_W); wv[ltid] = RS[set][6]; wv[128 + ltid] = __expf(RS[set][0]); if (ltid == 0) wv[64] = __expf(RS[set][5]); } } while (0)
      SSM_LLOAD(0, 0);
      if (nch > 1) SSM_LLOAD(1, 1);
      for (int it = 0; it <= nch; it += 2) {
        if (it < nch) SSM_LWRITE(0, 0);
        if (it + 2 < nch) SSM_LLOAD(0, it + 2);
        CH_BARRIER();
        if (it + 1 <= nch) {
          if (it + 1 < nch) SSM_LWRITE(1, 1);
          if (it + 3 < nch) SSM_LLOAD(1, it + 3);
          CH_BARRIER();
        }
      }
    } else {
      const int ph = wave & 1, ecol = ph * 32 + col;
      const bool is_state = wave < 2;
      LAS unsigned char* sbw = (LAS unsigned char*)lds + SSM_OFF_SB + ph * 8192 + lane * 16;
      bf16x8 xf[2][4];
#define SSM_LOADXF(set, stepn) do { const int cx_ = chunk0 + (dir ? nch - 1 - (stepn) : (stepn)); \
        const bf16_t* XTt_ = p.XT + (size_t)(cx_ * 32 + head) * 4096 + ecol * 64 + 8 * h; \
        _Pragma("unroll") for (int s = 0; s < 4; ++s) xf[set][s] = *(const bf16x8*)(XTt_ + 16 * s); } while (0)
      if (is_state) {
        f32x16 S[4];
        if (seq >= 16) {
          const float* s = p.state_ssm + ((((size_t)(seq - 16) * 2 + j) * 2 + dir) * 32 + head) * 8192 + ecol;
#pragma unroll
          for (int db = 0; db < 4; ++db)
#pragma unroll
            for (int r = 0; r < 16; ++r) S[db][r] = s[(32 * db + (r & 3) + 8 * (r >> 2) + 4 * h) * 64];
        } else {
#pragma unroll
          for (int db = 0; db < 4; ++db)
#pragma unroll
            for (int r = 0; r < 16; ++r) S[db][r] = 0.f;
        }
#define SSM_PUBLISH(slot) do { _Pragma("unroll") for (int db = 0; db < 4; ++db) { \
          *(LAS bf16x8*)(sbw + (slot) * 16384 + (2 * db) * 1024) = pack_half(S[db], 0); *(LAS bf16x8*)(sbw + (slot) * 16384 + (2 * db + 1) * 1024) = pack_half(S[db], 1); } } while (0)
#define SSM_SSTEP(set, stepn) do { const int step = (stepn); \
          const lds_u8* buf = lds + (step & 1) * SSM_BUF; const LAS float* wv = (const LAS float*)(buf + SSM_OFF_W); \
          const float dec = wv[64]; bf16x8 xw[4]; \
          _Pragma("unroll") for (int s = 0; s < 4; ++s) { \
            const f32x4 wlo = *(const LAS f32x4*)(wv + 16 * s + 4 * h), whi = *(const LAS f32x4*)(wv + 16 * s + 8 + 4 * h); \
            const u32x4 xq = __builtin_bit_cast(u32x4, xf[set][s]); \
            xw[s] = mk8(cvt2(bflo(xq[0]) * wlo[0], bfhi(xq[0]) * wlo[1]), cvt2(bflo(xq[1]) * wlo[2], bfhi(xq[1]) * wlo[3]), \
                        cvt2(bflo(xq[2]) * whi[0], bfhi(xq[2]) * whi[1]), cvt2(bflo(xq[3]) * whi[2], bfhi(xq[3]) * whi[3])); } \
          if (step + 2 < nch) SSM_LOADXF(set, step + 2); \
          _Pragma("unroll") for (int db = 0; db < 4; ++db) _Pragma("unroll") for (int r = 0; r < 16; ++r) S[db][r] *= dec; \
          _Pragma("unroll") for (int sp = 0; sp < 2; ++sp) { bf16x8 kb[4][2]; \
            _Pragma("unroll") for (int db = 0; db < 4; ++db) _Pragma("unroll") for (int s2 = 0; s2 < 2; ++s2) \
              kb[db][s2] = *(const LAS bf16x8*)(buf + SSM_OFF_BT + (32 * db + col) * 144 + 32 * (2 * sp + s2) + 16 * h); \
            _Pragma("unroll") for (int s2 = 0; s2 < 2; ++s2) _Pragma("unroll") for (int db = 0; db < 4; ++db) S[db] = MFMA32(kb[db][s2], xw[2 * sp + s2], S[db]); } \
          if (step + 1 < nch) SSM_PUBLISH((step + 1) & 1); } while (0)
        SSM_LOADXF(0, 0);
        if (nch > 1) SSM_LOADXF(1, 1);
        SSM_PUBLISH(0);
        for (int it = 0; it <= nch; it += 2) {
          if (it >= 1) SSM_SSTEP(1, it - 1);
          CH_BARRIER();
          if (it + 1 <= nch) { SSM_SSTEP(0, it); CH_BARRIER(); }
        }
        if (seq < 16) {
          float* d = out_state + ((((size_t)seq * 2 + j) * 2 + dir) * 32 + head) * 8192 + ecol;
#pragma unroll
          for (int db = 0; db < 4; ++db)
#pragma unroll
            for (int r = 0; r < 16; ++r) d[(32 * db + (r & 3) + 8 * (r >> 2) + 4 * h) * 64] = S[db][r];
        }
      } else {
#define SSM_OSTEP(set, stepn) do { const int step = (stepn); \
          const int c = chunk0 + (dir ? nch - 1 - step : step), tok0 = c * 64; \
          const lds_u8* buf = lds + (step & 1) * SSM_BUF; const lds_u8* Qb = buf + SSM_OFF_Q; const lds_u8* Mb = buf + SSM_OFF_M; \
          bf16x8 Sb[8]; \
          _Pragma("unroll") for (int f = 0; f < 8; ++f) Sb[f] = *(const LAS bf16x8*)(sbw + (step & 1) * 16384 + f * 1024); \
          bf16_t* Yb = p.Pxbc + ((size_t)dir * T_TOK + tok0) * 2048 + head * 64 + ecol + 4 * h * 2048; \
          f32x16 Oa[2]; \
          _Pragma("unroll") for (int t = 0; t < 2; ++t) _Pragma("unroll") for (int r = 0; r < 16; ++r) Oa[t][r] = 0.f; \
          _Pragma("unroll") for (int sg = 0; sg < 2; ++sg) { bf16x8 qa[2][4]; \
            _Pragma("unroll") for (int t = 0; t < 2; ++t) _Pragma("unroll") for (int s2 = 0; s2 < 4; ++s2) qa[t][s2] = *(const LAS bf16x8*)(Qb + (32 * t + col) * 272 + 32 * (4 * sg + s2) + 16 * h); \
            _Pragma("unroll") for (int s2 = 0; s2 < 4; ++s2) { Oa[0] = MFMA32(qa[0][s2], Sb[4 * sg + s2], Oa[0]); Oa[1] = MFMA32(qa[1][s2], Sb[4 * sg + s2], Oa[1]); } } \
          { const LAS float* ecs = (const LAS float*)(buf + SSM_OFF_W) + 128; \
            _Pragma("unroll") for (int t = 0; t < 2; ++t) _Pragma("unroll") for (int q = 0; q < 4; ++q) { const f32x4 e4 = *(const LAS f32x4*)(ecs + 32 * t + 8 * q + 4 * h); \
              _Pragma("unroll") for (int rr = 0; rr < 4; ++rr) Oa[t][4 * q + rr] *= e4[rr]; } } \
          { bf16x8 ma[2][4]; \
            _Pragma("unroll") for (int t = 0; t < 2; ++t) _Pragma("unroll") for (int s = 0; s < 4; ++s) ma[t][s] = *(const LAS bf16x8*)(Mb + (32 * t + col) * 144 + 32 * s + 16 * h); \
            _Pragma("unroll") for (int s = 0; s < 4; ++s) { Oa[0] = MFMA32(ma[0][s], xf[set][s], Oa[0]); Oa[1] = MFMA32(ma[1][s], xf[set][s], Oa[1]); } } \
          if (step + 2 < nch) SSM_LOADXF(set, step + 2); \
          _Pragma("unroll") for (int t = 0; t < 2; ++t) _Pragma("unroll") for (int r = 0; r < 16; r += 2) { \
            const unsigned pk = cvt2(Oa[t][r], Oa[t][r + 1]); \
            Yb[(size_t)(32 * t + (r & 3) + 8 * (r >> 2)) * 2048] = (bf16_t)(pk & 0xffffu); \
            Yb[(size_t)(32 * t + ((r + 1) & 3) + 8 * ((r + 1) >> 2)) * 2048] = (bf16_t)(pk >> 16); } } while (0)
        SSM_LOADXF(0, 0);
        if (nch > 1) SSM_LOADXF(1, 1);
        for (int it = 0; it <= nch; it += 2) {
          if (it >= 1) SSM_OSTEP(1, it - 1);
          CH_BARRIER();
          if (it + 1 <= nch) { SSM_OSTEP(0, it); CH_BARRIER(); }
        }
      }
    }
  }
}

__device__ __forceinline__ void ph_ssm_post(const P& p, int j) {
  const int wave = tidw(p.wq) >> 6, lane = tidw(p.wq) & 63;
  const int gw = blockIdx.x * 8 + wave, nwv = gridDim.x * 8;
  const bf16_t* Y = p.Pxbc;
  const float* nw = p.ssm_norm_w + (size_t)j * 2048; const float* dsk = p.ssm_d + j * 32;
  for (int it4 = gw; it4 < T_TOK * 2; it4 += nwv) {
    const int t = it4 >> 1, g0 = (it4 & 1) * 4;
    u32x2 yf[4], yb[4], z[4];
#pragma unroll
    for (int k = 0; k < 4; ++k) {
      const int c = (g0 + k) * 256 + lane * 4;
      yf[k] = *(const u32x2*)(Y + (size_t)t * 2048 + c);
      yb[k] = *(const u32x2*)(Y + ((size_t)T_TOK + t) * 2048 + c);
      z[k] = *(const u32x2*)(p.Pz + (size_t)t * 2048 + c);
    }
#pragma unroll
    for (int k = 0; k < 4; ++k) {
      const int c = (g0 + k) * 256 + lane * 4;
      float v[4];
      v[0] = (bflo(yf[k][0]) + bflo(yb[k][0])) * silu_f(bflo(z[k][0]));
      v[1] = (bfhi(yf[k][0]) + bfhi(yb[k][0])) * silu_f(bfhi(z[k][0]));
      v[2] = (bflo(yf[k][1]) + bflo(yb[k][1])) * silu_f(bflo(z[k][1]));
      v[3] = (bfhi(yf[k][1]) + bfhi(yb[k][1])) * silu_f(bfhi(z[k][1]));
      const float ss = wave_sum(v[0] * v[0] + v[1] * v[1] + v[2] * v[2] + v[3] * v[3]);
      const float rstd = rsqrtf(ss * (1.f / 256.f) + EPS);
      const f32x4 w = *(const f32x4*)(nw + c);
      u32x2 o; o[0] = pack2(v[0] * rstd * w[0], v[1] * rstd * w[1]); o[1] = pack2(v[2] * rstd * w[2], v[3] * rstd * w[3]);
      *(u32x2*)(p.H + (size_t)t * 2048 + c) = o;
    }
  }
}

__device__ __forceinline__ void ph_gla_pre(const P& p) {
  const int tid = tidw(p.wq);
  float* G = (float*)p.Pxbc;
  const int per = (T_TOK + (int)gridDim.x - 1) / (int)gridDim.x;
  const int tbeg = (int)blockIdx.x * per, tend = (tbeg + per < T_TOK) ? tbeg + per : T_TOK;
#pragma unroll 1
  for (int half = 0; half < 2; ++half) {
    const int idx = half * NT + tid, e = idx >> 9, kk = idx & 511;
    float w2[16];
#pragma unroll
    for (int r = 0; r < 16; ++r) w2[r] = p.gla_gate_w2[(size_t)e * 16 * 512 + r * 512 + kk];
    const float gb = p.gla_gate_b[e * 512 + kk];
    for (int t = tbeg; t < tend; t += 4) {
      f32x4 lr[4][4];
#pragma unroll
      for (int k = 0; k < 4; ++k)
#pragma unroll
        for (int q = 0; q < 4; ++q) lr[k][q] = *(const f32x4*)(p.small + (size_t)(t + k) * 64 + e * 16 + q * 4);
#pragma unroll
      for (int k = 0; k < 4; ++k) {
        float s = gb;
#pragma unroll
        for (int q = 0; q < 4; ++q) s += lr[k][q][0] * w2[4 * q] + lr[k][q][1] * w2[4 * q + 1] + lr[k][q][2] * w2[4 * q + 2] + lr[k][q][3] * w2[4 * q + 3];
        G[(size_t)(t + k) * 1024 + idx] = -softplus_f(-s) * (1.f / 16.f);
      }
    }
  }
}


template <int DIR>
__device__ __forceinline__ void gla_scan1(const bf16_t* Qr, const bf16_t* Kr, bf16_t* Qs, bf16_t* Ks, bf16_t* qpt, const float (&lgv)[32], float cs, int half, int d) {
  const int ib = DIR ? 63 - 32 * half : 32 * half;
  const bf16_t* qr = Qr + ib * 136 + d; const bf16_t* kr = Kr + ib * 136 + d;
  bf16_t* qs = Qs + (DIR * 64 + ib) * 136 + d; bf16_t* ks = Ks + (DIR * 64 + ib) * 136 + d; bf16_t* qg = qpt + ib * 128;
#pragma unroll
  for (int k = 0; k < 32; ++k) { const int o = DIR ? -k : k;
    cs += lgv[k];
    const float e = __expf(cs);
    const unsigned pk = cvt2(bf2f(qr[o * 136]) * e, bf2f(kr[o * 136]) * __builtin_amdgcn_rcpf(e));
    const bf16_t qb = (bf16_t)(pk & 0xffffu);
    qs[o * 136] = qb; qg[o * 128] = qb; ks[o * 136] = (bf16_t)(pk >> 16); }
}
template <int DIR>
__device__ __forceinline__ void gla_scan2(const bf16_t* Kr, bf16_t* Ks, const float (&lgv)[32], float cs, float cs_tot, int half, int d) {
  const int ib = DIR ? 63 - 32 * half : 32 * half;
  const bf16_t* kr = Kr + ib * 136 + d; bf16_t* ks = Ks + (DIR * 64 + ib) * 136 + d;
#pragma unroll
  for (int k = 0; k < 32; ++k) { const int o = DIR ? -k : k;
    cs += lgv[k];
    ks[o * 136] = f2bf(bf2f(kr[o * 136]) * __expf(cs_tot - cs)); }
}
template <int DIR>
__device__ __forceinline__ void gla_load_lg(const float* lgp  , float (&lga)[64]) {
#pragma unroll
  for (int s = 0; s < 64; ++s) lga[s] = lgp[(DIR ? -s : s) * 1024];
}
__device__ __forceinline__ void ph_gla_tiles(const P& p, unsigned char* shm) {
  const int tid = tidw(p.wq), wave = tid >> 6, lane = tid & 63;
  bf16_t* Qs = (bf16_t*)shm;
  bf16_t* Ks = Qs + 2 * 64 * 136;
  bf16_t* Vs = Ks + 2 * 64 * 136;
  bf16_t* Qr = Vs + 64 * 264;
  bf16_t* Kr = Qr + 64 * 136;
  const float* LG = (const float*)p.Pxbc;
  bf16_t* QP = p.H; bf16_t* KWT = p.H + (size_t)1536 * 8192; bf16_t* AI = p.H + (size_t)2 * 1536 * 8192;
  const int dir = __builtin_amdgcn_readfirstlane((tid >> 7) & 1), half = __builtin_amdgcn_readfirstlane(tid >> 8);
  for (int item = blockIdx.x; item < 192 * 4; item += gridDim.x) {
    const int c = item >> 2, hd = item & 3, tok0 = c * 64;
    int d = tid & 127; asm volatile("" : "+v"(d));
    float lgv[32]; float cs_start = 0.f, cs_tot = 0.f;
    {
      float lga[64];
      { const float* lgp = LG + (size_t)(tok0 + (dir ? 63 : 0)) * 1024 + dir * 512 + hd * 128 + d;
        if (dir) gla_load_lg<1>(lgp, lga); else gla_load_lg<0>(lgp, lga); }
      for (int q = tid; q < 2048; q += NT) { const int row = q >> 5, c16 = q & 31;
        *(u32x4*)(Vs + row * 264 + c16 * 8) = *(const u32x4*)(p.A + (size_t)(tok0 + row) * 2048 + 1024 + hd * 256 + c16 * 8); }
      for (int q = tid; q < 1024; q += NT) { const int row = q >> 4, c16 = q & 15;
        *(u32x4*)(Qr + row * 136 + c16 * 8) = *(const u32x4*)(p.A + (size_t)(tok0 + row) * 2048 + hd * 128 + c16 * 8);
        *(u32x4*)(Kr + row * 136 + c16 * 8) = *(const u32x4*)(p.A + (size_t)(tok0 + row) * 2048 + 512 + hd * 128 + c16 * 8); }
      float acc = 0.f;
#pragma unroll
      for (int s = 0; s < 64; ++s) { if (s == 32) cs_start = half ? acc : 0.f; acc += lga[s]; }
      cs_tot = acc;
#pragma unroll
      for (int k = 0; k < 32; ++k) lgv[k] = half ? lga[32 + k] : lga[k];
    }
    __syncthreads();
    {
      bf16_t* qpt = QP + (size_t)(item * 2 + dir) * 8192 + kperm(d);
      if (dir) gla_scan1<1>(Qr, Kr, Qs, Ks, qpt, lgv, cs_start, half, d); else gla_scan1<0>(Qr, Kr, Qs, Ks, qpt, lgv, cs_start, half, d);
      if (half == 0) p.VEC[(size_t)(item * 2 + dir) * 128 + d] = __expf(cs_tot);
    }
    __syncthreads();
    {
      const int dirw = wave >> 2, ti = (wave >> 1) & 1, tj = wave & 1, col = lane & 31, h = lane >> 5;
      f32x16 acc;
#pragma unroll
      for (int r = 0; r < 16; ++r) acc[r] = 0.f;
      const bf16_t* ap = Qs + (dirw * 64 + 32 * ti + col) * 136 + 8 * h;
      const bf16_t* bp = Ks + (dirw * 64 + 32 * tj + col) * 136 + 8 * h;
#pragma unroll
      for (int s = 0; s < 8; ++s) acc = MFMA32(*(const bf16x8*)(ap + 16 * s), *(const bf16x8*)(bp + 16 * s), acc);
      bf16_t* At = AI + (size_t)(item * 2 + dirw) * 4096;
      const int jj = 32 * tj + col;
#pragma unroll
      for (int r = 0; r < 16; ++r) { const int i = 32 * ti + (r & 3) + 8 * (r >> 2) + 4 * h;
        const bool keep = dirw ? (jj >= i) : (jj <= i);
        At[i * 64 + kperm(jj)] = keep ? f2bf(acc[r]) : (bf16_t)0; }
    }
    {
      bf16_t* VTt = p.BT + (size_t)item * 16384;
      for (int q = tid; q < 2048; q += NT) { const int e = q >> 3, cc = q & 7;
        unsigned short v[8];
#pragma unroll
        for (int qq = 0; qq < 8; ++qq) v[qq] = Vs[kperm(cc * 8 + qq) * 264 + e];
        u32x4 o = {(unsigned)v[0] | ((unsigned)v[1] << 16), (unsigned)v[2] | ((unsigned)v[3] << 16), (unsigned)v[4] | ((unsigned)v[5] << 16), (unsigned)v[6] | ((unsigned)v[7] << 16)};
        *(u32x4*)(VTt + e * 64 + cc * 8) = o; }
    }
    __syncthreads();
    if (dir) gla_scan2<1>(Kr, Ks, lgv, cs_start, cs_tot, half, d); else gla_scan2<0>(Kr, Ks, lgv, cs_start, cs_tot, half, d);
    __syncthreads();
    for (int q = tid; q < 2048; q += NT) { const int dirq = q >> 10, dd = (q >> 3) & 127, cc = q & 7;
      unsigned short v[8];
#pragma unroll
      for (int qq = 0; qq < 8; ++qq) v[qq] = Ks[(dirq * 64 + kperm(cc * 8 + qq)) * 136 + dd];
      u32x4 o = {(unsigned)v[0] | ((unsigned)v[1] << 16), (unsigned)v[2] | ((unsigned)v[3] << 16), (unsigned)v[4] | ((unsigned)v[5] << 16), (unsigned)v[6] | ((unsigned)v[7] << 16)};
      *(u32x4*)(KWT + (size_t)(item * 2 + dirq) * 8192 + dd * 64 + cc * 8) = o; }
    __syncthreads();
  }
}

#define GLA_OFF_Q 0
#define GLA_OFF_K 17408
#define GLA_OFF_A 35840
#define GLA_OFF_D 45056
#define GLA_BUF 45568
#define GLA_OFF_SB (2 * GLA_BUF)
__device__ __forceinline__ void ph_gla_chain(const P& p, lds_u8* lds) {
  const int tid = tidw(p.wq), wave = __builtin_amdgcn_readfirstlane(tid >> 6), lane = tid & 63, col = lane & 31, h = lane >> 5;
  float* out_state = p.out + (size_t)T_TOK * DM + 16777216;
  const bf16_t* QP = p.H; const bf16_t* KWT = p.H + (size_t)1536 * 8192; const bf16_t* AI = p.H + (size_t)2 * 1536 * 8192;
  const int nlat = 64, nitem = 576, G = (int)gridDim.x;
  const int stride = ((int)blockIdx.x < nlat) ? nitem : (G - nlat);
  for (int item = (int)blockIdx.x; item < nitem; item += stride) {
    int seq, dir, hd, quarter;
    if (item < 64) { const int x = item & 7, k = item >> 3, cmb = (k >> 2) * 8 + x; quarter = k & 3; seq = 16 + (cmb >> 3); dir = (cmb >> 2) & 1; hd = cmb & 3; }
    else { const int i2 = item - 64, x = i2 & 7, kk = i2 >> 3, cmb = (kk >> 2) * 8 + x; quarter = kk & 3; seq = cmb >> 3; dir = (cmb >> 2) & 1; hd = cmb & 3; }
    int chunk0, nch; if (seq < 16) { chunk0 = seq * 4; nch = 4; } else { chunk0 = 64 + (seq - 16) * 64; nch = 64; }
    if (wave >= 4) {
      const int ltid = tid - 256;
      const unsigned lo_t = (unsigned)(ltid * 16);
      u32x4 RQ[2][4], RK[2][4], RA[2][2], RD[2];
#define GLA_LLOAD(set, stepn) do { const int c_ = chunk0 + (dir ? nch - 1 - (stepn) : (stepn)); const size_t tix_ = (size_t)((c_ * 4 + hd) * 2 + dir); \
        const char* Qt_ = (const char*)(QP + tix_ * 8192); const char* Kt_ = (const char*)(KWT + tix_ * 8192); const char* At_ = (const char*)(AI + tix_ * 4096); \
        _Pragma("unroll") for (int i = 0; i < 4; ++i) { RQ[set][i] = *(const u32x4*)(Qt_ + i * 4096 + lo_t); RK[set][i] = *(const u32x4*)(Kt_ + i * 4096 + lo_t); } \
        _Pragma("unroll") for (int i = 0; i < 2; ++i) RA[set][i] = *(const u32x4*)(At_ + i * 4096 + lo_t); \
        if (ltid < 32) RD[set] = *(const u32x4*)(p.VEC + tix_ * 128 + ltid * 4); } while (0)
#define GLA_LWRITE(set, bufi) do { lds_u8* buf = lds + (bufi) * GLA_BUF; \
        _Pragma("unroll") for (int i = 0; i < 4; ++i) { const int q = ltid + 256 * i; \
          *(LAS u32x4*)(buf + GLA_OFF_Q + (q >> 4) * 272 + (q & 15) * 16) = RQ[set][i]; \
          *(LAS u32x4*)(buf + GLA_OFF_K + (q >> 3) * 144 + (q & 7) * 16) = RK[set][i]; } \
        _Pragma("unroll") for (int i = 0; i < 2; ++i) { const int q = ltid + 256 * i; *(LAS u32x4*)(buf + GLA_OFF_A + (q >> 3) * 144 + (q & 7) * 16) = RA[set][i]; } \
        if (ltid < 32) *(LAS u32x4*)(buf + GLA_OFF_D + ltid * 16) = RD[set]; } while (0)
      GLA_LLOAD(0, 0);
      if (nch > 1) GLA_LLOAD(1, 1);
      for (int it = 0; it <= nch; it += 2) {
        if (it < nch) GLA_LWRITE(0, 0);
        if (it + 2 < nch) GLA_LLOAD(0, it + 2);
        CH_BARRIER();
        if (it + 1 <= nch) {
          if (it + 1 < nch) GLA_LWRITE(1, 1);
          if (it + 3 < nch) GLA_LLOAD(1, it + 3);
          CH_BARRIER();
        }
      }
    } else {
      const int ph = wave & 1, ecol = (quarter * 2 + ph) * 32 + col;
      LAS unsigned char* sbw = (LAS unsigned char*)lds + GLA_OFF_SB + ph * 8192 + lane * 16;
      bf16x8 vf[2][4];
#define GLA_LOADVF(set, stepn) do { const int cx_ = chunk0 + (dir ? nch - 1 - (stepn) : (stepn)); \
        const bf16_t* Vt_ = p.BT + (size_t)(cx_ * 4 + hd) * 16384 + ecol * 64 + 8 * h; \
        _Pragma("unroll") for (int s = 0; s < 4; ++s) vf[set][s] = *(const bf16x8*)(Vt_ + 16 * s); } while (0)
      if (wave < 2) {
        f32x16 S[4];
        if (seq >= 16) {
          const float* s = p.state_gla + (((size_t)(seq - 16) * 2 + dir) * 4 + hd) * 32768 + ecol;
#pragma unroll
          for (int db = 0; db < 4; ++db)
#pragma unroll
            for (int r = 0; r < 16; ++r) S[db][r] = s[(32 * db + (r & 3) + 8 * (r >> 2) + 4 * h) * 256];
        } else {
#pragma unroll
          for (int db = 0; db < 4; ++db)
#pragma unroll
            for (int r = 0; r < 16; ++r) S[db][r] = 0.f;
        }
#define GLA_PUBLISH(slot) do { _Pragma("unroll") for (int db = 0; db < 4; ++db) { \
          *(LAS bf16x8*)(sbw + (slot) * 16384 + (2 * db) * 1024) = pack_half(S[db], 0); *(LAS bf16x8*)(sbw + (slot) * 16384 + (2 * db + 1) * 1024) = pack_half(S[db], 1); } } while (0)
#define GLA_SSTEP(set, stepn) do { const int step = (stepn); \
          const lds_u8* buf = lds + (step & 1) * GLA_BUF; const LAS float* dect = (const LAS float*)(buf + GLA_OFF_D); \
          _Pragma("unroll") for (int db = 0; db < 4; ++db) _Pragma("unroll") for (int q = 0; q < 4; ++q) { const f32x4 d4 = *(const LAS f32x4*)(dect + 32 * db + 8 * q + 4 * h); \
            _Pragma("unroll") for (int rr = 0; rr < 4; ++rr) S[db][4 * q + rr] *= d4[rr]; } \
          _Pragma("unroll") for (int sp = 0; sp < 2; ++sp) { bf16x8 kb[4][2]; \
            _Pragma("unroll") for (int db = 0; db < 4; ++db) _Pragma("unroll") for (int s2 = 0; s2 < 2; ++s2) \
              kb[db][s2] = *(const LAS bf16x8*)(buf + GLA_OFF_K + (32 * db + col) * 144 + 32 * (2 * sp + s2) + 16 * h); \
            _Pragma("unroll") for (int s2 = 0; s2 < 2; ++s2) _Pragma("unroll") for (int db = 0; db < 4; ++db) S[db] = MFMA32(kb[db][s2], vf[set][2 * sp + s2], S[db]); } \
          if (step + 2 < nch) GLA_LOADVF(set, step + 2); \
          if (step + 1 < nch) GLA_PUBLISH((step + 1) & 1); } while (0)
        GLA_LOADVF(0, 0);
        if (nch > 1) GLA_LOADVF(1, 1);
        GLA_PUBLISH(0);
        for (int it = 0; it <= nch; it += 2) {
          if (it >= 1) GLA_SSTEP(1, it - 1);
          CH_BARRIER();
          if (it + 1 <= nch) { GLA_SSTEP(0, it); CH_BARRIER(); }
        }
        if (seq < 16) {
          float* d_ = out_state + (((size_t)seq * 2 + dir) * 4 + hd) * 32768 + ecol;
#pragma unroll
          for (int db = 0; db < 4; ++db)
#pragma unroll
            for (int r = 0; r < 16; ++r) d_[(32 * db + (r & 3) + 8 * (r >> 2) + 4 * h) * 256] = S[db][r];
        }
      } else {
#define GLA_OSTEP(set, stepn) do { const int step = (stepn); \
          const int c = chunk0 + (dir ? nch - 1 - step : step), tok0 = c * 64; \
          const lds_u8* buf = lds + (step & 1) * GLA_BUF; \
          bf16x8 Sb[8]; \
          _Pragma("unroll") for (int f = 0; f < 8; ++f) Sb[f] = *(const LAS bf16x8*)(sbw + (step & 1) * 16384 + f * 1024); \
          bf16_t* Ob = p.Pxbc + (size_t)T_TOK * 2048 + ((size_t)dir * T_TOK + tok0) * 1024 + hd * 256 + ecol + 4 * h * 1024; \
          f32x16 Oa[2]; \
          _Pragma("unroll") for (int t = 0; t < 2; ++t) _Pragma("unroll") for (int r = 0; r < 16; ++r) Oa[t][r] = 0.f; \
          _Pragma("unroll") for (int sg = 0; sg < 2; ++sg) { bf16x8 qa[2][4]; \
            _Pragma("unroll") for (int t = 0; t < 2; ++t) _Pragma("unroll") for (int s2 = 0; s2 < 4; ++s2) qa[t][s2] = *(const LAS bf16x8*)(buf + GLA_OFF_Q + (32 * t + col) * 272 + 32 * (4 * sg + s2) + 16 * h); \
            _Pragma("unroll") for (int s2 = 0; s2 < 4; ++s2) { Oa[0] = MFMA32(qa[0][s2], Sb[4 * sg + s2], Oa[0]); Oa[1] = MFMA32(qa[1][s2], Sb[4 * sg + s2], Oa[1]); } } \
          { bf16x8 ma[2][4]; \
            _Pragma("unroll") for (int t = 0; t < 2; ++t) _Pragma("unroll") for (int s = 0; s < 4; ++s) ma[t][s] = *(const LAS bf16x8*)(buf + GLA_OFF_A + (32 * t + col) * 144 + 32 * s + 16 * h); \
            _Pragma("unroll") for (int s = 0; s < 4; ++s) { Oa[0] = MFMA32(ma[0][s], vf[set][s], Oa[0]); Oa[1] = MFMA32(ma[1][s], vf[set][s], Oa[1]); } } \
          if (step + 2 < nch) GLA_LOADVF(set, step + 2); \
          _Pragma("unroll") for (int t = 0; t < 2; ++t) _Pragma("unroll") for (int r = 0; r < 16; r += 2) { \
            const unsigned pk = cvt2(Oa[t][r], Oa[t][r + 1]); \
            Ob[(size_t)(32 * t + (r & 3) + 8 * (r >> 2)) * 1024] = (bf16_t)(pk & 0xffffu); \
            Ob[(size_t)(32 * t + ((r + 1) & 3) + 8 * ((r + 1) >> 2)) * 1024] = (bf16_t)(pk >> 16); } } while (0)
        GLA_LOADVF(0, 0);
        if (nch > 1) GLA_LOADVF(1, 1);
        for (int it = 0; it <= nch; it += 2) {
          if (it >= 1) GLA_OSTEP(1, it - 1);
          CH_BARRIER();
          if (it + 1 <= nch) { GLA_OSTEP(0, it); CH_BARRIER(); }
        }
      }
    }
  }
}

__device__ __forceinline__ void ph_headnorm_post(const P& p, const bf16_t* __restrict__ O, int nheads, const float* __restrict__ nw, const bf16_t* __restrict__ gate) {
  const int wave = tidw(p.wq) >> 6, lane = tidw(p.wq) & 63;
  const int gw = blockIdx.x * 8 + wave, nwv = gridDim.x * 8;
  const int C = nheads * 256, npt = nheads >> 2;
  const f32x4 w = *(const f32x4*)(nw + lane * 4);
  for (int it4 = gw; it4 < T_TOK * npt; it4 += nwv) {
    const int t = it4 / npt, h0 = (it4 % npt) * 4;
    u32x2 of[4], ob[4], z[4];
#pragma unroll
    for (int k = 0; k < 4; ++k) {
      const int c = (h0 + k) * 256 + lane * 4;
      of[k] = *(const u32x2*)(O + (size_t)t * C + c);
      ob[k] = *(const u32x2*)(O + ((size_t)T_TOK + t) * C + c);
      z[k] = *(const u32x2*)(gate + (size_t)t * C + c);
    }
#pragma unroll
    for (int k = 0; k < 4; ++k) {
      const int c = (h0 + k) * 256 + lane * 4;
      float v[4];
      v[0] = bflo(of[k][0]) + bflo(ob[k][0]); v[1] = bfhi(of[k][0]) + bfhi(ob[k][0]); v[2] = bflo(of[k][1]) + bflo(ob[k][1]); v[3] = bfhi(of[k][1]) + bfhi(ob[k][1]);
      const float ss = wave_sum(v[0] * v[0] + v[1] * v[1] + v[2] * v[2] + v[3] * v[3]);
      const float rstd = rsqrtf(ss * (1.f / 256.f) + EPS);
      u32x2 o;
      o[0] = pack2(v[0] * rstd * w[0] * silu_f(bflo(z[k][0])), v[1] * rstd * w[1] * silu_f(bfhi(z[k][0])));
      o[1] = pack2(v[2] * rstd * w[2] * silu_f(bflo(z[k][1])), v[3] * rstd * w[3] * silu_f(bfhi(z[k][1])));
      *(u32x2*)(p.H + (size_t)t * C + c) = o;
    }
  }
}

__device__ __forceinline__ void ph_gdn_pre(const P& p) {
  const int tid = tidw(p.wq);
  const float* cw = p.gdn_conv_w;
  const int per = (T_TOK + (int)gridDim.x - 1) / (int)gridDim.x;
  const int tbeg = (int)blockIdx.x * per, tend = (tbeg + per < T_TOK) ? tbeg + per : T_TOK;
  {
    const int c = tid * 8;
    float w[3][8];
#pragma unroll
    for (int k = 0; k < 3; ++k) { const f32x4 w0 = *(const f32x4*)(cw + k * 4096 + c), w1 = *(const f32x4*)(cw + k * 4096 + c + 4);
      w[k][0] = w0[0]; w[k][1] = w0[1]; w[k][2] = w0[2]; w[k][3] = w0[3]; w[k][4] = w1[0]; w[k][5] = w1[1]; w[k][6] = w1[2]; w[k][7] = w1[3]; }
    const u32x4 z4 = {0u, 0u, 0u, 0u};
    for (int t = tbeg; t < tend; t += 4) {
      int t0, L, cond; tok_info(t, t0, L, cond);
      const int pos = t - t0;
      const bf16_t* srcp = p.Pxbc + (size_t)t * 4096 + c;
      u32x4 X[6];
#pragma unroll
      for (int jx = 0; jx < 6; ++jx) X[jx] = (pos + jx - 1 >= 0 && pos + jx - 1 < L) ? *(const u32x4*)(srcp + (jx - 1) * 4096) : z4;
#pragma unroll
      for (int k = 0; k < 4; ++k) {
        float v[8];
#pragma unroll
        for (int q = 0; q < 4; ++q) {
          v[2 * q] = silu_f(w[0][2 * q] * bflo(X[k][q]) + w[1][2 * q] * bflo(X[k + 1][q]) + w[2][2 * q] * bflo(X[k + 2][q]));
          v[2 * q + 1] = silu_f(w[0][2 * q + 1] * bfhi(X[k][q]) + w[1][2 * q + 1] * bfhi(X[k + 1][q]) + w[2][2 * q + 1] * bfhi(X[k + 2][q]));
        }
        if (c < 2048) {
          float ss = 0.f;
#pragma unroll
          for (int q = 0; q < 8; ++q) ss += v[q] * v[q];
          ss += __shfl_xor(ss, 1); ss += __shfl_xor(ss, 2); ss += __shfl_xor(ss, 4); ss += __shfl_xor(ss, 8);
          float sc = rsqrtf(ss + 1e-6f);
          if (c < 1024) sc *= 0.08838834764831845f;
#pragma unroll
          for (int q = 0; q < 8; ++q) v[q] *= sc;
        }
        u32x4 o;
#pragma unroll
        for (int q = 0; q < 4; ++q) o[q] = pack2(v[2 * q], v[2 * q + 1]);
        *(u32x4*)(p.A + (size_t)(t + k) * 4096 + c) = o;
      }
    }
  }
  const int gtid = blockIdx.x * NT + tid, gsz = gridDim.x * NT;
  for (int it = gtid; it < T_TOK * 16; it += gsz) {
    const int t = it >> 4, dh = it & 15;
    const float a_raw = p.small[(size_t)t * 64 + dh], b_raw = p.small[(size_t)t * 64 + 16 + dh];
    const float logg = -__expf(p.gdn_a_log[dh]) * softplus_f(a_raw + p.gdn_dt_bias[dh]);
    p.small2[(size_t)t * 128 + dh] = logg;
    p.small2[(size_t)t * 128 + 16 + dh] = sigmoid_f(b_raw);
  }
}

template <int DIR>
__device__ __forceinline__ void gdn_solve(const float* Ms, const float* csb, bf16_t* Tt0, int wave, int lane) {
  const int part = lane >> 4, cidx = (wave & 3) * 16 + (lane & 15);
  const float* mb = Ms + DIR * 64 * 65 + (DIR ? -part : part);
  float Tr[16];
#pragma unroll
  for (int k = 0; k < 16; ++k) Tr[k] = 0.f;
#pragma unroll
  for (int s = 0; s < 64; ++s) {
    const int i = DIR ? 63 - s : s;
    float a0 = 0.f, a1 = 0.f, a2 = 0.f, a3 = 0.f;
#pragma unroll
    for (int k = 0; 4 * k < s; ++k) {
      const float mv = mb[i * 65 + (DIR ? 63 - 4 * k : 4 * k)];
      if ((k & 3) == 0) a0 -= mv * Tr[k]; else if ((k & 3) == 1) a1 -= mv * Tr[k]; else if ((k & 3) == 2) a2 -= mv * Tr[k]; else a3 -= mv * Tr[k];
    }
    float acc = (a0 + a1) + (a2 + a3);
    acc += __shfl_xor(acc, 16); acc += __shfl_xor(acc, 32);
    const float tv = ((cidx == i) ? 1.f : 0.f) + acc;
    Tr[s >> 2] = ((s & 3) == part) ? tv : Tr[s >> 2];
    if ((s & 3) == 3) asm volatile("" ::: "memory");
  }
  const float bl = csb[128 + DIR * 64 + cidx];
  bf16_t* Tt = Tt0 + kperm(cidx) + (DIR ? -part : part) * 64;
#pragma unroll
  for (int k = 0; k < 16; ++k) Tt[(DIR ? 63 - 4 * k : 4 * k) * 64] = f2bf(Tr[k] * bl);
}

#define GDN_MS 68
template <int DIR>
__device__ __forceinline__ void gdn_solve_col(const float* Ms, const float* csb, bf16_t* Tt0, int lane) {
  typedef float f32x2 __attribute__((ext_vector_type(2)));
  const float* mb = Ms + DIR * 64 * GDN_MS;
  f32x2 X[32];
#pragma unroll
  for (int k = 0; k < 32; ++k) X[k] = (f32x2){0.f, 0.f};
  f32x4 A[8], B[8], An[8];
#pragma unroll
  for (int s = 0; s < 64; ++s) {
    const int i = DIR ? 63 - s : s;
    const int ng = (s + 3) >> 2, nA = ng < 8 ? ng : 8, ngn = (s + 4) >> 2, nAn = (s + 1 < 64) ? (ngn < 8 ? ngn : 8) : 0;
#pragma unroll
    for (int k = 8; k < 16; ++k) if (k < ng) B[k - 8] = *(const f32x4*)(mb + i * GDN_MS + (DIR ? 60 - 4 * k : 4 * k));
    asm volatile("" ::: "memory");
    f32x2 a01 = {0.f, 0.f}, a23 = {0.f, 0.f};
#pragma unroll
    for (int k = 0; k < 8; ++k) if (k < nA) {
      const f32x2 mlo = DIR ? (f32x2){A[k][3], A[k][2]} : (f32x2){A[k][0], A[k][1]}, mhi = DIR ? (f32x2){A[k][1], A[k][0]} : (f32x2){A[k][2], A[k][3]};
      a01 -= mlo * X[2 * k]; a23 -= mhi * X[2 * k + 1];
    }
    {
      const int in = DIR ? 62 - s : s + 1;
#pragma unroll
      for (int k = 0; k < 8; ++k) if (k < nAn) An[k] = *(const f32x4*)(mb + in * GDN_MS + (DIR ? 60 - 4 * k : 4 * k));
    }
    asm volatile("" ::: "memory");
#pragma unroll
    for (int k = 8; k < 16; ++k) if (k < ng) {
      const f32x2 mlo = DIR ? (f32x2){B[k - 8][3], B[k - 8][2]} : (f32x2){B[k - 8][0], B[k - 8][1]}, mhi = DIR ? (f32x2){B[k - 8][1], B[k - 8][0]} : (f32x2){B[k - 8][2], B[k - 8][3]};
      a01 -= mlo * X[2 * k]; a23 -= mhi * X[2 * k + 1];
    }
    const f32x2 a = a01 + a23;
    X[s >> 1][s & 1] = ((lane == s) ? 1.f : 0.f) + (a[0] + a[1]);
#pragma unroll
    for (int k = 0; k < 8; ++k) if (k < nAn) A[k] = An[k];
  }
  const int cidx = DIR ? 63 - lane : lane;
  const float bl = csb[128 + DIR * 64 + cidx];
  bf16_t* Tt = Tt0 + kperm(cidx);
#pragma unroll
  for (int s = 0; s < 64; ++s) Tt[(DIR ? 63 - s : s) * 64] = f2bf(X[s >> 1][s & 1] * bl);
}

__device__ __forceinline__ void ph_gdn_tiles(const P& p, unsigned char* shm) {
  const int tid = tidw(p.wq), wave = tid >> 6, lane = tid & 63;
  float* KK = (float*)shm;
  float* QK = KK + 64 * GDN_MS;
  float* MsB = QK + 64 * GDN_MS;
  float* csb = MsB + 4 * 64 * GDN_MS;
  bf16_t* Kt = (bf16_t*)(csb + 1024);
  bf16_t* Qt = Kt + 64 * 136;
  bf16_t* TP = p.H; bf16_t* AI = p.H + (size_t)3072 * 4096;
  const float* cw = p.gdn_conv_w;
  const int cgi = tid & 63, to = tid >> 6;
  const int G = (int)gridDim.x;
#define GDN_SCAN(itm_, csbp_, dsel_) do { const int dir = (dsel_), tk = dir ? 63 - lane : lane; const size_t t = (size_t)((itm_) >> 3) * 64 + tk; const int dh = dir * 8 + ((itm_) & 7); \
      const float a_raw = p.small[t * 64 + dh], b_raw = p.small[t * 64 + 16 + dh]; \
      const float cs = wave_scan_incl(-__expf(p.gdn_a_log[dh]) * softplus_f(a_raw + p.gdn_dt_bias[dh])); \
      const float bt = sigmoid_f(b_raw); \
      (csbp_)[dir * 64 + tk] = cs; (csbp_)[128 + dir * 64 + tk] = bt; \
      p.VEC[(size_t)((itm_) * 2 + dir) * 64 + tk] = cs; } while (0)
  auto ai_gather = [&](int item, const float* csbc, int t2, int nthr) {
    for (int q = t2; q < 1024; q += nthr) {
      const int dir = q >> 9, i = (q >> 3) & 63, m = q & 7;
      const float ci = csbc[dir * 64 + i];
      float v[8];
#pragma unroll
      for (int e = 0; e < 8; ++e) {
        const int jx = kperm(8 * m + e);
        const bool incl = dir ? (jx >= i) : (jx <= i);
        v[e] = incl ? QK[i * GDN_MS + jx] * __expf(ci - csbc[dir * 64 + jx]) : 0.f;
      }
      const u32x4 o = {cvt2(v[0], v[1]), cvt2(v[2], v[3]), cvt2(v[4], v[5]), cvt2(v[6], v[7])};
      *(u32x4*)(AI + (size_t)(item * 2 + dir) * 4096 + i * 64 + 8 * m) = o;
    }
    for (int q = t2; q < 1024; q += nthr) { const int d = q >> 3, cc = q & 7;
      unsigned short v[8];
#pragma unroll
      for (int qq = 0; qq < 8; ++qq) v[qq] = Kt[kperm(cc * 8 + qq) * 136 + d];
      u32x4 o = {(unsigned)v[0] | ((unsigned)v[1] << 16), (unsigned)v[2] | ((unsigned)v[3] << 16), (unsigned)v[4] | ((unsigned)v[5] << 16), (unsigned)v[6] | ((unsigned)v[7] << 16)};
      *(u32x4*)(p.BT + (size_t)item * 8192 + d * 64 + cc * 8) = o; }
  };
  auto prefetch_rows = [&](int nxt, int l2) {
    const int tokn = (nxt >> 3) * 64, hdn = nxt & 7;
    const bf16_t* pa[5];
#pragma unroll
    for (int jj = 0; jj < 5; ++jj) {
      int idx = l2 + 128 * jj; idx = idx < 528 ? idx : 527;
      const int row = idx >> 3, seg = idx & 7;
      int tr = tokn - 1 + row; tr = tr < 0 ? 0 : (tr > T_TOK - 1 ? T_TOK - 1 : tr);
      const int eo = (seg < 2) ? (hdn * 128 + seg * 64) : ((seg < 4) ? (1024 + hdn * 128 + (seg - 2) * 64) : (2048 + hdn * 256 + (seg - 4) * 64));
      pa[jj] = p.Pxbc + (size_t)tr * 4096 + eo;
    }
    unsigned d0, d1, d2, d3, d4;
    asm volatile("global_load_dword %0, %5, off\n\tglobal_load_dword %1, %6, off\n\tglobal_load_dword %2, %7, off\n\tglobal_load_dword %3, %8, off\n\tglobal_load_dword %4, %9, off\n\ts_waitcnt vmcnt(0)"
                 : "=&v"(d0), "=&v"(d1), "=&v"(d2), "=&v"(d3), "=&v"(d4) : "v"(pa[0]), "v"(pa[1]), "v"(pa[2]), "v"(pa[3]), "v"(pa[4]) : "memory");
  };
  if (wave >= 6) {
    if ((int)blockIdx.x < 192 * 8) GDN_SCAN((int)blockIdx.x, csb, wave - 6);
    if ((int)blockIdx.x + G < 192 * 8) GDN_SCAN((int)blockIdx.x + G, csb + 256, wave - 6);
  }
  int itn = 0;
  for (int item0 = blockIdx.x; item0 < 192 * 8; item0 += 2 * G, ++itn) {
    float* csbp = csb + (itn & 1) * 512; float* csbn = csb + ((itn + 1) & 1) * 512;
    const bool has_b = item0 + G < 192 * 8;
#pragma nounroll
    for (int e = 0; e < 2; ++e) {
      if (e == 1 && !has_b) break;
      const int item = item0 + e * G;
      const int c = item >> 3, hd = item & 7, tok0 = c * 64;
      float* Ms = MsB + e * 2 * 64 * GDN_MS; const float* csbc = csbp + e * 256;
      {
        const int chg = (cgi < 16) ? (hd * 128 + cgi * 8) : ((cgi < 32) ? (1024 + hd * 128 + (cgi - 16) * 8) : (2048 + hd * 256 + (cgi - 32) * 8));
        float w[3][8];
#pragma unroll
        for (int k = 0; k < 3; ++k) { const f32x4 w0 = *(const f32x4*)(cw + k * 4096 + chg), w1 = *(const f32x4*)(cw + k * 4096 + chg + 4);
          w[k][0] = w0[0]; w[k][1] = w0[1]; w[k][2] = w0[2]; w[k][3] = w0[3]; w[k][4] = w1[0]; w[k][5] = w1[1]; w[k][6] = w1[2]; w[k][7] = w1[3]; }
        int t0, L, cond; tok_info(tok0, t0, L, cond);
        const int posb = tok0 - t0 + 8 * to - 1;
        const bf16_t* srcp = p.Pxbc + (size_t)(tok0 + 8 * to - 1) * 4096 + chg;
        const u32x4 z4 = {0u, 0u, 0u, 0u};
        u32x4 X[10];
#pragma unroll
        for (int r = 0; r < 10; ++r) X[r] = (posb + r >= 0 && posb + r < L) ? *(const u32x4*)(srcp + (size_t)r * 4096) : z4;
#pragma unroll
        for (int k = 0; k < 8; ++k) {
          float v[8];
#pragma unroll
          for (int q = 0; q < 4; ++q) {
            v[2 * q] = silu_f(w[0][2 * q] * bflo(X[k][q]) + w[1][2 * q] * bflo(X[k + 1][q]) + w[2][2 * q] * bflo(X[k + 2][q]));
            v[2 * q + 1] = silu_f(w[0][2 * q + 1] * bfhi(X[k][q]) + w[1][2 * q + 1] * bfhi(X[k + 1][q]) + w[2][2 * q + 1] * bfhi(X[k + 2][q]));
          }
          if (cgi < 32) {
            float ss = 0.f;
#pragma unroll
            for (int q = 0; q < 8; ++q) ss += v[q] * v[q];
            ss = row16_allsum(ss);
            float sc = rsqrtf(ss + 1e-6f);
            if (cgi < 16) sc *= 0.08838834764831845f;
#pragma unroll
            for (int q = 0; q < 8; ++q) v[q] *= sc;
          }
          u32x4 o;
#pragma unroll
          for (int q = 0; q < 4; ++q) o[q] = pack2(v[2 * q], v[2 * q + 1]);
          *(u32x4*)(p.A + (size_t)(tok0 + 8 * to + k) * 4096 + chg) = o;
          if (cgi < 16) *(u32x4*)(Qt + (8 * to + k) * 136 + cgi * 8) = o;
          else if (cgi < 32) *(u32x4*)(Kt + (8 * to + k) * 136 + (cgi - 16) * 8) = o;
        }
      }
      __syncthreads();
      {
        const int which = wave >> 2, ti = (wave >> 1) & 1, tj = wave & 1, col = lane & 31, h = lane >> 5;
        f32x16 acc;
#pragma unroll
        for (int r = 0; r < 16; ++r) acc[r] = 0.f;
        const bf16_t* ap = (which ? Qt : Kt) + (32 * ti + col) * 136 + 8 * h;
        const bf16_t* bp = Kt + (32 * tj + col) * 136 + 8 * h;
#pragma unroll
        for (int s = 0; s < 8; ++s) acc = MFMA32(*(const bf16x8*)(ap + 16 * s), *(const bf16x8*)(bp + 16 * s), acc);
        float* dst = which ? QK : KK;
#pragma unroll
        for (int r = 0; r < 16; ++r) dst[(32 * ti + (r & 3) + 8 * (r >> 2) + 4 * h) * GDN_MS + 32 * tj + col] = acc[r];
      }
      __syncthreads();
      for (int idx = tid; idx < 2 * 4096; idx += NT) {
        const int dir = idx >> 12, i = (idx >> 6) & 63, jx = idx & 63;
        const float ci = csbc[dir * 64 + i], cj = csbc[dir * 64 + jx];
        const bool before = dir ? (jx > i) : (jx < i);
        Ms[(dir * 64 + i) * GDN_MS + jx] = before ? csbc[128 + dir * 64 + i] * KK[i * GDN_MS + jx] * __expf(ci - cj) : 0.f;
      }
      __syncthreads();
      if (e == 0 && has_b) {
        ai_gather(item, csbc, tid, NT);
        __syncthreads();
      }
    }
    const int last = has_b ? 1 : 0;
    if (wave < 4) {
      const int e = wave >> 1;
      if (e <= last) {
        const float* Ms = MsB + e * 2 * 64 * GDN_MS; const float* csbc = csbp + e * 256; const int item = item0 + e * G;
        if (wave & 1) gdn_solve_col<1>(Ms, csbc, TP + (size_t)(item * 2 + 1) * 4096, lane);
        else gdn_solve_col<0>(Ms, csbc, TP + (size_t)(item * 2) * 4096, lane);
      }
    } else if (wave < 6) {
      ai_gather(item0 + last * G, csbp + last * 256, tid - 256, 128);
    } else {
      const int n0 = item0 + 2 * G, n1 = n0 + G;
      if (n0 < 192 * 8) { GDN_SCAN(n0, csbn, wave - 6); prefetch_rows(n0, tid - 384); }
      if (n1 < 192 * 8) { GDN_SCAN(n1, csbn + 256, wave - 6); prefetch_rows(n1, tid - 384); }
    }
    __syncthreads();
  }
}

#define GDN_OFF_K 0
#define GDN_OFF_Q 17408
#define GDN_OFF_KT 34816
#define GDN_OFF_T 53248
#define GDN_OFF_A 62464
#define GDN_OFF_CS 71680
#define GDN_BUF 71936
__device__ __forceinline__ void ph_gdn_chain(const P& p, lds_u8* lds) {
  const int tid = tidw(p.wq), wave = __builtin_amdgcn_readfirstlane(tid >> 6), lane = tid & 63, col = lane & 31, h = lane >> 5;
  const bool consumer = wave < 4;
  const int ltid = tid - 256;
  float* out_state = p.out + (size_t)T_TOK * DM + 16777216 + 4194304;
  const bf16_t* TP = p.H; const bf16_t* AI = p.H + (size_t)3072 * 4096;
  const int nlat = 64, nitem = 576, G = (int)gridDim.x;
  const int stride = ((int)blockIdx.x < nlat) ? nitem : (G - nlat);
  for (int item = (int)blockIdx.x; item < nitem; item += stride) {
    int seq, dir, hd, half;
    if (item < 64) { const int x = item & 7, k = item >> 3, cmb = (k >> 1) * 8 + x; half = k & 1; seq = 16 + (cmb >> 4); dir = (cmb >> 3) & 1; hd = cmb & 7; }
    else { const int i2 = item - 64, x = i2 & 7, kk = i2 >> 3, cmb = (kk >> 1) * 8 + x; half = kk & 1; seq = cmb >> 4; dir = (cmb >> 3) & 1; hd = cmb & 7; }
    int chunk0, nch; if (seq < 16) { chunk0 = seq * 4; nch = 4; } else { chunk0 = 64 + (seq - 16) * 64; nch = 64; }
    if (!consumer) {
      const int lrow = ltid >> 4, lc16 = ltid & 15, lc8 = ltid & 7;
      u32x4 RK[2][4], RQ[2][4], RKT[2][4], RT[2][2], RA[2][2]; float RC[2][13];
      const unsigned lo_kq = (unsigned)(((ltid >> 4) * 4096 + (ltid & 15) * 8) * 2), lo_t = (unsigned)(ltid * 16), lo_c = (unsigned)(lrow * 4), lo_c8 = (unsigned)((16 * (lc8 >> 1) + 4 * (lc8 & 1)) * 4);
#define GDN_LLOAD(set, stepn) do { const int c_ = chunk0 + (dir ? nch - 1 - (stepn) : (stepn)); const size_t tix_ = (size_t)((c_ * 8 + hd) * 2 + dir); \
        const char* qb_ = (const char*)(p.A + (size_t)c_ * 64 * 4096 + hd * 128); const char* kb_ = qb_ + 2048; \
        const char* KTt_ = (const char*)(p.BT + (size_t)(c_ * 8 + hd) * 8192); const char* Tt_ = (const char*)(TP + tix_ * 4096); const char* At_ = (const char*)(AI + tix_ * 4096); \
        const char* cs_ = (const char*)(p.VEC + tix_ * 64); \
        _Pragma("unroll") for (int i = 0; i < 4; ++i) { \
          RK[set][i] = *(const u32x4*)(kb_ + i * 131072 + lo_kq); RQ[set][i] = *(const u32x4*)(qb_ + i * 131072 + lo_kq); \
          RKT[set][i] = *(const u32x4*)(KTt_ + i * 4096 + lo_t); RC[set][1 + i] = *(const float*)(cs_ + i * 64 + lo_c); } \
        _Pragma("unroll") for (int i = 0; i < 2; ++i) { RT[set][i] = *(const u32x4*)(Tt_ + i * 4096 + lo_t); RA[set][i] = *(const u32x4*)(At_ + i * 4096 + lo_t); } \
        RC[set][0] = *(const float*)(cs_ + (dir ? 0 : 252)); \
        { const f32x4 a_ = *(const f32x4*)(cs_ + lo_c8), b_ = *(const f32x4*)(cs_ + 32 + lo_c8); \
          RC[set][5] = a_[0]; RC[set][6] = a_[1]; RC[set][7] = a_[2]; RC[set][8] = a_[3]; RC[set][9] = b_[0]; RC[set][10] = b_[1]; RC[set][11] = b_[2]; RC[set][12] = b_[3]; } } while (0)
#define GDN_LWRITE(set, bufi) do { lds_u8* buf = lds + (bufi) * GDN_BUF; \
        const float cs_tot = RC[set][0]; float ks[8]; \
        _Pragma("unroll") for (int e = 0; e < 8; ++e) ks[e] = __expf(cs_tot - RC[set][5 + e]); \
        const int p0 = grp_pos_bytes(2 * lc16), p1 = grp_pos_bytes(2 * lc16 + 1); \
        _Pragma("unroll") for (int i = 0; i < 4; ++i) { \
          const float ec = __expf(RC[set][1 + i]); const int row = lrow + 16 * i; \
          const u32x4 kk = scale8(RK[set][i], -ec, -ec, -ec, -ec, -ec, -ec, -ec, -ec); \
          const u32x4 qq = scale8(RQ[set][i], ec, ec, ec, ec, ec, ec, ec, ec); \
          *(LAS u32x2*)(buf + GDN_OFF_K + row * 272 + p0) = (u32x2){kk[0], kk[1]}; \
          *(LAS u32x2*)(buf + GDN_OFF_K + row * 272 + p1) = (u32x2){kk[2], kk[3]}; \
          *(LAS u32x2*)(buf + GDN_OFF_Q + row * 272 + p0) = (u32x2){qq[0], qq[1]}; \
          *(LAS u32x2*)(buf + GDN_OFF_Q + row * 272 + p1) = (u32x2){qq[2], qq[3]}; \
          const int q = ltid + 256 * i; \
          *(LAS u32x4*)(buf + GDN_OFF_KT + (q >> 3) * 144 + (q & 7) * 16) = scale8(RKT[set][i], ks[0], ks[1], ks[2], ks[3], ks[4], ks[5], ks[6], ks[7]); } \
        _Pragma("unroll") for (int i = 0; i < 2; ++i) { const int q = ltid + 256 * i; \
          *(LAS u32x4*)(buf + GDN_OFF_T + (q >> 3) * 144 + (q & 7) * 16) = RT[set][i]; \
          *(LAS u32x4*)(buf + GDN_OFF_A + (q >> 3) * 144 + (q & 7) * 16) = RA[set][i]; } \
        if (ltid == 0) *(LAS float*)(buf + GDN_OFF_CS) = __expf(cs_tot); } while (0)
      GDN_LLOAD(0, 0);
      if (nch > 1) GDN_LLOAD(1, 1);
      for (int it = 0; it <= nch; it += 2) {
        if (it < nch) GDN_LWRITE(0, 0);
        if (it + 2 < nch) GDN_LLOAD(0, it + 2);
        CH_BARRIER();
        if (it + 1 <= nch) {
          if (it + 1 < nch) GDN_LWRITE(1, 1);
          if (it + 3 < nch) GDN_LLOAD(1, it + 3);
          CH_BARRIER();
        }
      }
    } else {
      const int ecol = (half * 4 + (wave & 3)) * 32 + col;
      f32x16 S[4];
      f32x16 XX[2];
      if (seq >= 16) {
        const float* s = p.state_gdn + (((size_t)(seq - 16) * 2 + dir) * 8 + hd) * 32768 + ecol;
#pragma unroll
        for (int db = 0; db < 4; ++db)
#pragma unroll
          for (int r = 0; r < 16; ++r) S[db][r] = s[(32 * db + (r & 3) + 8 * (r >> 2) + 4 * h) * 256];
      } else {
#pragma unroll
        for (int db = 0; db < 4; ++db)
#pragma unroll
          for (int r = 0; r < 16; ++r) S[db][r] = 0.f;
      }
      bf16x8 vr[2][2];
      const int vcol0 = 2048 + hd * 256 + (half * 4 + (wave & 3)) * 32 + 8 * h;
      {
        const int c0 = chunk0 + (dir ? nch - 1 : 0);
#pragma unroll
        for (int t = 0; t < 2; ++t)
#pragma unroll
          for (int s = 0; s < 2; ++s) vr[t][s] = *(const bf16x8*)(p.A + (size_t)(c0 * 64 + 32 * t + col) * 4096 + vcol0 + 16 * s);
      }
      for (int it = 0; it <= nch; ++it) {
        if (it >= 1) {
          const int step = it - 1;
        const int c = chunk0 + (dir ? nch - 1 - step : step), tok0 = c * 64;
        const lds_u8* buf = lds + (step & 1) * GDN_BUF;
        bf16_t* Ob = p.Pxbc + ((size_t)dir * T_TOK + tok0) * 2048 + hd * 256 + 4 * h * 2048 + ecol;
        bf16x8 Sb[8];
#pragma unroll
        for (int db = 0; db < 4; ++db) { Sb[2 * db] = pack_half(S[db], 0); Sb[2 * db + 1] = pack_half(S[db], 1); }
        f32x16 Q1[2];
#pragma unroll
        for (int t = 0; t < 2; ++t)
#pragma unroll
          for (int r = 0; r < 16; ++r) { Q1[t][r] = 0.f; XX[t][r] = 0.f; }
#pragma unroll
        for (int sg = 0; sg < 4; ++sg) {
          bf16x8 ka[2][2], qa[2][2];
#pragma unroll
          for (int t = 0; t < 2; ++t)
#pragma unroll
            for (int s2 = 0; s2 < 2; ++s2) {
              ka[t][s2] = *(const LAS bf16x8*)(buf + GDN_OFF_K + (32 * t + col) * 272 + 32 * (2 * sg + s2) + 16 * h);
              qa[t][s2] = *(const LAS bf16x8*)(buf + GDN_OFF_Q + (32 * t + col) * 272 + 32 * (2 * sg + s2) + 16 * h);
            }
#pragma unroll
          for (int s2 = 0; s2 < 2; ++s2) {
            XX[0] = MFMA32(ka[0][s2], Sb[2 * sg + s2], XX[0]);
            XX[1] = MFMA32(ka[1][s2], Sb[2 * sg + s2], XX[1]);
            Q1[0] = MFMA32(qa[0][s2], Sb[2 * sg + s2], Q1[0]);
            Q1[1] = MFMA32(qa[1][s2], Sb[2 * sg + s2], Q1[1]);
          }
        }
        { int cx = col - 8 * h; asm volatile("" : "+v"(cx));
#pragma unroll
          for (int s = 0; s < 2; ++s) { u32x4 u;
#pragma unroll
            for (int q = 0; q < 4; ++q) { const int k0 = 16 * s + 2 * q; u[q] = ((cx == k0) ? 0x3F80u : 0u) | ((cx == k0 + 1) ? 0x3F800000u : 0u); }
            const bf16x8 Id = __builtin_bit_cast(bf16x8, u);
            XX[0] = MFMA32(vr[0][s], Id, XX[0]); XX[1] = MFMA32(vr[1][s], Id, XX[1]); } }
        bf16x8 Xb[4];
#pragma unroll
        for (int t = 0; t < 2; ++t) { Xb[2 * t] = pack_half(XX[t], 0); Xb[2 * t + 1] = pack_half(XX[t], 1); }
        f32x16 Vn[2];
        {
          bf16x8 ta[2][4];
#pragma unroll
          for (int t = 0; t < 2; ++t) {
#pragma unroll
            for (int r = 0; r < 16; ++r) Vn[t][r] = 0.f;
#pragma unroll
            for (int s = 0; s < 4; ++s) ta[t][s] = *(const LAS bf16x8*)(buf + GDN_OFF_T + (32 * t + col) * 144 + 32 * s + 16 * h);
          }
#pragma unroll
          for (int s = 0; s < 4; ++s) { Vn[0] = MFMA32(ta[0][s], Xb[s], Vn[0]); Vn[1] = MFMA32(ta[1][s], Xb[s], Vn[1]); }
        }
        bf16x8 Vnb[4];
#pragma unroll
        for (int t = 0; t < 2; ++t) { Vnb[2 * t] = pack_half(Vn[t], 0); Vnb[2 * t + 1] = pack_half(Vn[t], 1); }
        {
          bf16x8 aa[2][4];
#pragma unroll
          for (int t = 0; t < 2; ++t)
#pragma unroll
            for (int s = 0; s < 4; ++s) aa[t][s] = *(const LAS bf16x8*)(buf + GDN_OFF_A + (32 * t + col) * 144 + 32 * s + 16 * h);
#pragma unroll
          for (int s = 0; s < 4; ++s) { Q1[0] = MFMA32(aa[0][s], Vnb[s], Q1[0]); Q1[1] = MFMA32(aa[1][s], Vnb[s], Q1[1]); }
        }
#pragma unroll
        for (int t = 0; t < 2; ++t) {
#pragma unroll
          for (int r = 0; r < 16; r += 2) {
            const unsigned pk = cvt2(Q1[t][r], Q1[t][r + 1]);
            Ob[(size_t)(32 * t + (r & 3) + 8 * (r >> 2)) * 2048] = (bf16_t)(pk & 0xffffu);
            Ob[(size_t)(32 * t + ((r + 1) & 3) + 8 * ((r + 1) >> 2)) * 2048] = (bf16_t)(pk >> 16);
          }
        }
        if (step + 1 < nch) {
          const int cn = chunk0 + (dir ? nch - 2 - step : step + 1);
#pragma unroll
          for (int t = 0; t < 2; ++t)
#pragma unroll
            for (int s = 0; s < 2; ++s) vr[t][s] = *(const bf16x8*)(p.A + (size_t)(cn * 64 + 32 * t + col) * 4096 + vcol0 + 16 * s);
        }
        const float dec = *(const __attribute__((address_space(3))) float*)(buf + GDN_OFF_CS);
#pragma unroll
        for (int db = 0; db < 4; ++db)
#pragma unroll
          for (int r = 0; r < 16; ++r) S[db][r] *= dec;
#pragma unroll
        for (int sp = 0; sp < 2; ++sp) {
          bf16x8 kb[4][2];
#pragma unroll
          for (int db = 0; db < 4; ++db)
#pragma unroll
            for (int s2 = 0; s2 < 2; ++s2) kb[db][s2] = *(const LAS bf16x8*)(buf + GDN_OFF_KT + (32 * db + col) * 144 + 32 * (2 * sp + s2) + 16 * h);
#pragma unroll
          for (int s2 = 0; s2 < 2; ++s2)
#pragma unroll
            for (int db = 0; db < 4; ++db) S[db] = MFMA32(kb[db][s2], Vnb[2 * sp + s2], S[db]);
        }
        }
        CH_BARRIER();
      }
      if (seq < 16) {
        float* d_ = out_state + (((size_t)seq * 2 + dir) * 8 + hd) * 32768 + ecol;
#pragma unroll
        for (int db = 0; db < 4; ++db)
#pragma unroll
          for (int r = 0; r < 16; ++r) d_[(32 * db + (r & 3) + 8 * (r >> 2) + 4 * h) * 256] = S[db][r];
      }
    }
  }
}

__device__ __forceinline__ void ph_ffn_glu(const P& p, int layer, unsigned char* shm) {
  const int tid = tidw(p.wq);
  const bf16_t* Pa = p.Pz; const bf16_t* Pv = p.Pz + (size_t)T_TOK * DFF;
  const float* cw = p.ffn_conv_w + (size_t)layer * 9 * DFF; const float* cb = p.ffn_conv_b + (size_t)layer * DFF;
  float* wl = (float*)shm;
  for (int i = tid; i < 9 * DFF / 4; i += NT) *(f32x4*)(wl + i * 4) = *(const f32x4*)(cw + i * 4);
  for (int i = tid; i < DFF / 4; i += NT) *(f32x4*)(wl + 9 * DFF + i * 4) = *(const f32x4*)(cb + i * 4);
  __syncthreads();
  const int ngrp = T_TOK / 4, per = (ngrp + (int)gridDim.x - 1) / (int)gridDim.x;
  const int gbeg = (int)blockIdx.x * per, gend = (gbeg + per < ngrp) ? gbeg + per : ngrp;
  const int nitems = (gend - gbeg) * (DFF / 8);
  const u32x4 z4 = {0u, 0u, 0u, 0u};
  for (int it = tid; it < nitems; it += NT) {
    const int gi = gbeg + it / (DFF / 8), c = (it % (DFF / 8)) * 8;
    const int t = gi * 4;
    const bool lat = t >= T_CTX;
    const int pos = lat ? ((t - T_CTX) & 4095) : (t & 255);
    const int W = lat ? 64 : 256;
    const int col = lat ? (pos & 63) : pos, row = lat ? (pos >> 6) : 0;
    u32x4 A[3][6], vv[4];
#pragma unroll
    for (int iy = 0; iy < 3; ++iy) {
      const bool rok = lat ? (row + iy - 1 >= 0 && row + iy - 1 < 64) : (iy == 1);
#pragma unroll
      for (int jx = 0; jx < 6; ++jx) {
        const int cc = col + jx - 1;
        A[iy][jx] = (rok && cc >= 0 && cc < W) ? *(const u32x4*)(Pa + (size_t)(t + (iy - 1) * 64 + jx - 1) * DFF + c) : z4;
      }
    }
#pragma unroll
    for (int k = 0; k < 4; ++k) vv[k] = *(const u32x4*)(Pv + (size_t)(t + k) * DFF + c);
    float acc[4][8];
    { const f32x4 b0 = *(const f32x4*)(wl + 9 * DFF + c), b1 = *(const f32x4*)(wl + 9 * DFF + c + 4);
#pragma unroll
      for (int k = 0; k < 4; ++k) { acc[k][0] = b0[0]; acc[k][1] = b0[1]; acc[k][2] = b0[2]; acc[k][3] = b0[3]; acc[k][4] = b1[0]; acc[k][5] = b1[1]; acc[k][6] = b1[2]; acc[k][7] = b1[3]; } }
#pragma unroll
    for (int iy = 0; iy < 3; ++iy)
#pragma unroll
      for (int jx = 0; jx < 3; ++jx) {
        const f32x4 w0 = *(const f32x4*)(wl + (iy * 3 + jx) * DFF + c), w1 = *(const f32x4*)(wl + (iy * 3 + jx) * DFF + c + 4);
#pragma unroll
        for (int k = 0; k < 4; ++k) {
          const u32x4 a = A[iy][k + jx];
          acc[k][0] += w0[0] * bflo(a[0]); acc[k][1] += w0[1] * bfhi(a[0]); acc[k][2] += w0[2] * bflo(a[1]); acc[k][3] += w0[3] * bfhi(a[1]);
          acc[k][4] += w1[0] * bflo(a[2]); acc[k][5] += w1[1] * bfhi(a[2]); acc[k][6] += w1[2] * bflo(a[3]); acc[k][7] += w1[3] * bfhi(a[3]);
        }
      }
#pragma unroll
    for (int k = 0; k < 4; ++k) {
      u32x4 o;
#pragma unroll
      for (int q = 0; q < 4; ++q) o[q] = pack2(silu_f(acc[k][2 * q]) * bflo(vv[k][q]), silu_f(acc[k][2 * q + 1]) * bfhi(vv[k][q]));
      *(u32x4*)(p.H + (size_t)(t + k) * DFF + c) = o;
    }
  }
  __syncthreads();
}

__device__ __forceinline__ void ph_final_norm(const P& p) {
  const int wave = tidw(p.wq) >> 6, lane = tidw(p.wq) & 63;
  const int gw = blockIdx.x * 8 + wave, nwv = gridDim.x * 8;
  for (int tb = gw; tb < T_TOK; tb += 3 * nwv) {
    f32x4 v[3][4]; float ss[3];
#pragma unroll
    for (int j = 0; j < 3; ++j) {
      const int t = tb + j * nwv; ss[j] = 0.f;
      if (t < T_TOK) {
        const float* xr = p.out + (size_t)t * DM;
#pragma unroll
        for (int i = 0; i < 4; ++i) v[j][i] = *(const f32x4*)(xr + i * 256 + lane * 4);
      }
    }
#pragma unroll
    for (int j = 0; j < 3; ++j) {
      const int t = tb + j * nwv;
      if (t < T_TOK) {
#pragma unroll
        for (int i = 0; i < 4; ++i) ss[j] += v[j][i][0] * v[j][i][0] + v[j][i][1] * v[j][i][1] + v[j][i][2] * v[j][i][2] + v[j][i][3] * v[j][i][3];
        const float rstd = rsqrtf(wave_sum(ss[j]) * (1.f / DM) + EPS);
        float* xr = p.out + (size_t)t * DM;
#pragma unroll
        for (int i = 0; i < 4; ++i) {
          const f32x4 w = *(const f32x4*)(p.final_norm_w + i * 256 + lane * 4);
          f32x4 o = v[j][i] * rstd * w;
          *(f32x4*)(xr + i * 256 + lane * 4) = o;
        }
      }
    }
  }
}

#define XB_TMO      128
#define XB_XCNT(j)  (256  + 64 * (j))
#define XB_XSUB(j)  (1280 + 64 * (j))
#define XB_XGEN(j)  (2304 + 64 * (j))
#define XB_TOP      3328
#define XB_TOPGEN   3392
#define XCD_BAR_WORDS 3456
#define XB_SPIN_CAP (1u << 18)


__device__ __forceinline__ unsigned xb_ld(unsigned* p)              { return __hip_atomic_load(p, __ATOMIC_RELAXED, __HIP_MEMORY_SCOPE_AGENT); }
__device__ __forceinline__ unsigned xb_add(unsigned* p, unsigned v) { return __hip_atomic_fetch_add(p, v, __ATOMIC_RELAXED, __HIP_MEMORY_SCOPE_AGENT); }
__device__ __forceinline__ unsigned xb_xcc_id() { return (unsigned)__builtin_amdgcn_s_getreg((3 << 11) | 20) & 0xFu; }
#define XB_SPIN(cond, bar) do { unsigned _sp = 0; while (cond) { __builtin_amdgcn_s_sleep(1); \
    if ((++_sp & 255u) == 0u) { if (xb_ld(&(bar)[XB_TMO])) break; if (_sp > XB_SPIN_CAP) { atomicAdd(&(bar)[XB_TMO], 1u); break; } } } } while (0)

struct XcdBarrier {
    unsigned* bar; unsigned x;
    volatile LAS unsigned* st;
};

__device__ __forceinline__ XcdBarrier xcd_barrier_post(unsigned* bar, volatile LAS unsigned* st) {
    XcdBarrier b; b.bar = bar; b.x = xb_xcc_id(); b.st = st;
    if (threadIdx.x == 0) (void)xb_add(&bar[XB_XCNT(b.x)], 1u);
    return b;
}
__device__ __forceinline__ void xcd_barrier_complete(unsigned* bar, unsigned x, unsigned& nloc, unsigned& nx) {
    const unsigned G = gridDim.x * gridDim.y * gridDim.z;
    unsigned sum, cnt, mine, sp = 0u;
    for (;;) {
        sum = 0u; cnt = 0u; mine = 0u;
#pragma unroll
        for (unsigned j = 0; j < 16; ++j) { const unsigned c = xb_ld(&bar[XB_XCNT(j)]); sum += c; cnt += (c > 0u) ? 1u : 0u; mine = (j == x) ? c : mine; }
        if (sum == G) break;
        __builtin_amdgcn_s_sleep(1);
        if ((++sp & 255u) == 0u) { if (xb_ld(&bar[XB_TMO])) break; if (sp > XB_SPIN_CAP) { atomicAdd(&bar[XB_TMO], 1u); break; } }
    }
    nloc = mine > 0u ? mine : 1u; nx = cnt > 0u ? cnt : 1u;
}

__device__ __forceinline__ void xcd_barrier(const XcdBarrier& b) {
    asm volatile("s_waitcnt vmcnt(0)" ::: "memory");
    __syncthreads();
    if (threadIdx.x == 0) {
        unsigned* bar = b.bar;
        __builtin_amdgcn_s_waitcnt(0);
        unsigned nloc = b.st[0], nx = b.st[1];
        if (nloc == 0u) { xcd_barrier_complete(bar, b.x, nloc, nx); b.st[0] = nloc; b.st[1] = nx; }
        const unsigned old = xb_add(&bar[XB_XSUB(b.x)], 1u);
        const unsigned gen = old / nloc;
        if (old + 1u == (gen + 1u) * nloc) {
            __builtin_amdgcn_fence(__ATOMIC_RELEASE, "agent");
            asm volatile("s_waitcnt vmcnt(0)" ::: "memory");
            const unsigned og = xb_add(&bar[XB_TOP], 1u);
            const unsigned tg = og / nx;
            if (og + 1u == (tg + 1u) * nx) xb_add(&bar[XB_TOPGEN], 1u);
            else XB_SPIN(xb_ld(&bar[XB_TOPGEN]) == tg, bar);
            __builtin_amdgcn_fence(__ATOMIC_ACQUIRE, "agent");
            xb_add(&bar[XB_XGEN(b.x)], 1u);
            asm volatile("s_waitcnt vmcnt(0)" ::: "memory");
        } else {
            XB_SPIN(xb_ld(&bar[XB_XGEN(b.x)]) == gen, bar);
            __builtin_amdgcn_fence(__ATOMIC_ACQUIRE, "agent");
            asm volatile("s_waitcnt vmcnt(0)" ::: "memory");
        }
    }
    __syncthreads();
}

typedef const __attribute__((address_space(4))) P* kargp_t;
__device__ __forceinline__ kargp_t getP() {
  kargp_t k = (kargp_t)__builtin_amdgcn_kernarg_segment_ptr();
  asm volatile("" : "+s"(k));
  return k;
}
#if defined(__HIP_DEVICE_COMPILE__)
#define LP() P p = *getP(); p.wq = widx_k
#else
#define LP() P p = p_arg; p.wq = widx_k
#endif

#define GSYNC() do { LP(); XcdBarrier b_; b_.bar = p.bar; b_.x = xb_xcc_id(); b_.st = (volatile LAS unsigned*)(lds + LDS_BYTES - 16); xcd_barrier(b_); } while (0)
__global__ void __launch_bounds__(NT) fwd_megakernel(P p_arg) {
  const int widx_k = __builtin_amdgcn_readfirstlane((int)(threadIdx.x >> 6));
  extern __shared__ __attribute__((aligned(16))) unsigned char shm[];
  float* tile = (float*)shm;
  lds_u8* lds = (lds_u8*)shm;

  volatile LAS unsigned* xst = (volatile LAS unsigned*)(lds + LDS_BYTES - 16);
  if (threadIdx.x == 0) { xst[0] = 0u; xst[1] = 0u; xst[2] = 0u; xst[3] = 0u; }
  __syncthreads();
  { LP(); (void)xcd_barrier_post(p.bar, xst); }
  { LP(); ph_ada_direct(p, 0, 1, shm, (int)blockIdx.x, (int)gridDim.x); }
  { LP(); ph_convert(p, 0, 1, tile, (int)blockIdx.x, (int)gridDim.x); }
  GSYNC();

  {
    constexpr int layer = 0; constexpr int kind = layer % 3, j = layer / 3;
    if constexpr (layer == 0) { { LP(); ph_norm_mod<true>(p, p.norm_mix_w + layer * DM, p.mod + (size_t)layer * 3 * 6144, 0, 1024, p.H); }
      GSYNC(); }
    if constexpr (kind == 0) {
      { LP(); gemm_phase8(lds, layer == 0 ? p.H : p.A, p.Win, T_TOK, 6400, DM, EpiSsmIn{p.Pz, p.Pxbc, p.small}, p.wq); }
      if constexpr (layer == 0) { LP(); const int g_ = (int)gridDim.x, b0_ = (g_ >= 192) ? 176 : 0; if ((int)blockIdx.x >= b0_) { ph_convert(p, 0, 2, tile, (int)blockIdx.x - b0_, g_ - b0_); ph_ada_direct(p, 1, 2, shm, (int)blockIdx.x - b0_, g_ - b0_); } }
      GSYNC();
      { LP(); ph_ssm_tiles(p, j, shm); }
      GSYNC();
      { LP(); ph_ssm_chain(p, j, lds); }
      { LP(); if ((int)blockIdx.x >= 128) ph_convert(p, layer, 8, tile, (int)blockIdx.x - 128, (int)gridDim.x - 128); }
      GSYNC();
      { LP(); ph_ssm_post(p, j); }
      GSYNC();
      { LP(); gemm_phase_residnorm192<false>(lds, p.H, p.Wout, 2048, p.out, p.mod + (size_t)layer * 3 * 6144 + 2048, p.adap, p.bar + XCD_BAR_WORDS + (layer * 2) * 4096,
                                             p.norm_ffn_w + layer * DM, p.mod + (size_t)layer * 3 * 6144, 3072, 4096, p.A, p.wq); }
    } else if constexpr (kind == 1) {
      { LP(); gemm_phase8(lds, p.Pxbc + (size_t)T_TOK * 2048, p.Win, T_TOK, 4096, DM, EpiGlaIn{p.A, p.Pz, (float*)p.Pxbc, p.gla_gate_b}, p.wq); }
      GSYNC();
      { LP(); ph_gla_tiles(p, shm); }
      GSYNC();
      { LP(); ph_gla_chain(p, lds); }
      { LP(); if ((int)blockIdx.x >= 64) ph_convert(p, layer, 8, tile, (int)blockIdx.x - 64, (int)gridDim.x - 64); }
      GSYNC();
      { LP(); ph_headnorm_post(p, p.Pxbc + (size_t)T_TOK * 2048, 4, p.gla_norm_w, p.Pz); }
      GSYNC();
      { LP(); gemm_phase_residnorm192<false>(lds, p.H, p.Wout, 1024, p.out, p.mod + (size_t)layer * 3 * 6144 + 2048, p.adap, p.bar + XCD_BAR_WORDS + (layer * 2) * 4096,
                                             p.norm_ffn_w + layer * DM, p.mod + (size_t)layer * 3 * 6144, 3072, 4096, p.A, p.wq); }
    } else {
      { LP(); gemm_phase8(lds, p.A, p.Win, T_TOK, 6400, DM, EpiGdnIn{p.Pz, p.Pxbc, p.small}, p.wq); }
      GSYNC();
      { LP(); ph_gdn_tiles(p, shm); }
      GSYNC();
      { LP(); ph_gdn_chain(p, lds); }
      { LP(); if ((int)blockIdx.x >= 64) ph_convert(p, layer, 8, tile, (int)blockIdx.x - 64, (int)gridDim.x - 64); }
      GSYNC();
      { LP(); ph_headnorm_post(p, p.Pxbc, 8, p.gdn_norm_w, p.Pz); }
      GSYNC();
      { LP(); gemm_phase_residnorm192<false>(lds, p.H, p.Wout, 2048, p.out, p.mod + (size_t)layer * 3 * 6144 + 2048, p.adap, p.bar + XCD_BAR_WORDS + (layer * 2) * 4096,
                                             p.norm_ffn_w + layer * DM, p.mod + (size_t)layer * 3 * 6144, 3072, 4096, p.A, p.wq); }
    }
    GSYNC();
    { LP(); gemm_phase8(lds, p.A, p.Wfi, T_TOK, 5632, DM, EpiFfnIn{p.Pz, p.Pz + (size_t)T_TOK * DFF}, p.wq); }
    { LP(); const int g_ = (int)gridDim.x, b0_ = (g_ >= 64) ? 32 : 0;
      if ((int)blockIdx.x >= b0_) { ph_convert(p, layer, 16, tile, (int)blockIdx.x - b0_, g_ - b0_); if (layer < 3) ph_convert(p, layer + 1, 3, tile, (int)blockIdx.x - b0_, g_ - b0_);
                                    if (layer < 2) ph_ada_direct(p, layer + 2, layer + 3, shm, (int)blockIdx.x - b0_, g_ - b0_); } }
    GSYNC();
    { LP(); ph_ffn_glu(p, layer, shm); }
    GSYNC();
    if constexpr (layer < 3) { LP(); gemm_phase_residnorm192<false>(lds, p.H, p.Wfo, DFF, p.out, p.mod + (size_t)layer * 3 * 6144 + 5120, p.adap, p.bar + XCD_BAR_WORDS + (layer * 2 + 1) * 4096,
                                             p.norm_mix_w + (layer + 1) * DM, p.mod + (size_t)(layer + 1) * 3 * 6144, 0, 1024, ((layer + 1) % 3 == 1) ? p.Pxbc + (size_t)T_TOK * 2048 : p.A, p.wq); }
    else { LP(); gemm_phase_residnorm192<true>(lds, p.H, p.Wfo, DFF, p.out, p.mod + (size_t)layer * 3 * 6144 + 5120, p.adap, p.bar + XCD_BAR_WORDS + (layer * 2 + 1) * 4096,
                                             p.final_norm_w, nullptr, 0, 0, nullptr, p.wq); }
    GSYNC();
    }
  {
    constexpr int layer = 1; constexpr int kind = layer % 3, j = layer / 3;
    if constexpr (layer == 0) { { LP(); ph_norm_mod<true>(p, p.norm_mix_w + layer * DM, p.mod + (size_t)layer * 3 * 6144, 0, 1024, p.H); }
      GSYNC(); }
    if constexpr (kind == 0) {
      { LP(); gemm_phase8(lds, layer == 0 ? p.H : p.A, p.Win, T_TOK, 6400, DM, EpiSsmIn{p.Pz, p.Pxbc, p.small}, p.wq); }
      if constexpr (layer == 0) { LP(); const int g_ = (int)gridDim.x, b0_ = (g_ >= 192) ? 176 : 0; if ((int)blockIdx.x >= b0_) { ph_convert(p, 0, 2, tile, (int)blockIdx.x - b0_, g_ - b0_); ph_ada_direct(p, 1, 2, shm, (int)blockIdx.x - b0_, g_ - b0_); } }
      GSYNC();
      { LP(); ph_ssm_tiles(p, j, shm); }
      GSYNC();
      { LP(); ph_ssm_chain(p, j, lds); }
      { LP(); if ((int)blockIdx.x >= 128) ph_convert(p, layer, 8, tile, (int)blockIdx.x - 128, (int)gridDim.x - 128); }
      GSYNC();
      { LP(); ph_ssm_post(p, j); }
      GSYNC();
      { LP(); gemm_phase_residnorm192<false>(lds, p.H, p.Wout, 2048, p.out, p.mod + (size_t)layer * 3 * 6144 + 2048, p.adap, p.bar + XCD_BAR_WORDS + (layer * 2) * 4096,
                                             p.norm_ffn_w + layer * DM, p.mod + (size_t)layer * 3 * 6144, 3072, 4096, p.A, p.wq); }
    } else if constexpr (kind == 1) {
      { LP(); gemm_phase8(lds, p.Pxbc + (size_t)T_TOK * 2048, p.Win, T_TOK, 4096, DM, EpiGlaIn{p.A, p.Pz, (float*)p.Pxbc, p.gla_gate_b}, p.wq); }
      GSYNC();
      { LP(); ph_gla_tiles(p, shm); }
      GSYNC();
      { LP(); ph_gla_chain(p, lds); }
      { LP(); if ((int)blockIdx.x >= 64) ph_convert(p, layer, 8, tile, (int)blockIdx.x - 64, (int)gridDim.x - 64); }
      GSYNC();
      { LP(); ph_headnorm_post(p, p.Pxbc + (size_t)T_TOK * 2048, 4, p.gla_norm_w, p.Pz); }
      GSYNC();
      { LP(); gemm_phase_residnorm192<false>(lds, p.H, p.Wout, 1024, p.out, p.mod + (size_t)layer * 3 * 6144 + 2048, p.adap, p.bar + XCD_BAR_WORDS + (layer * 2) * 4096,
                                             p.norm_ffn_w + layer * DM, p.mod + (size_t)layer * 3 * 6144, 3072, 4096, p.A, p.wq); }
    } else {
      { LP(); gemm_phase8(lds, p.A, p.Win, T_TOK, 6400, DM, EpiGdnIn{p.Pz, p.Pxbc, p.small}, p.wq); }
      GSYNC();
      { LP(); ph_gdn_tiles(p, shm); }
      GSYNC();
      { LP(); ph_gdn_chain(p, lds); }
      { LP(); if ((int)blockIdx.x >= 64) ph_convert(p, layer, 8, tile, (int)blockIdx.x - 64, (int)gridDim.x - 64); }
      GSYNC();
      { LP(); ph_headnorm_post(p, p.Pxbc, 8, p.gdn_norm_w, p.Pz); }
      GSYNC();
      { LP(); gemm_phase_residnorm192<false>(lds, p.H, p.Wout, 2048, p.out, p.mod + (size_t)layer * 3 * 6144 + 2048, p.adap, p.bar + XCD_BAR_WORDS + (layer * 2) * 4096,
                                             p.norm_ffn_w + layer * DM, p.mod + (size_t)layer * 3 * 6144, 3072, 4096, p.A, p.wq); }
    }
    GSYNC();
    { LP(); gemm_phase8(lds, p.A, p.Wfi, T_TOK, 5632, DM, EpiFfnIn{p.Pz, p.Pz + (size_t)T_TOK * DFF}, p.wq); }
    { LP(); const int g_ = (int)gridDim.x, b0_ = (g_ >= 64) ? 32 : 0;
      if ((int)blockIdx.x >= b0_) { ph_convert(p, layer, 16, tile, (int)blockIdx.x - b0_, g_ - b0_); if (layer < 3) ph_convert(p, layer + 1, 3, tile, (int)blockIdx.x - b0_, g_ - b0_);
                                    if (layer < 2) ph_ada_direct(p, layer + 2, layer + 3, shm, (int)blockIdx.x - b0_, g_ - b0_); } }
    GSYNC();
    { LP(); ph_ffn_glu(p, layer, shm); }
    GSYNC();
    if constexpr (layer < 3) { LP(); gemm_phase_residnorm192<false>(lds, p.H, p.Wfo, DFF, p.out, p.mod + (size_t)layer * 3 * 6144 + 5120, p.adap, p.bar + XCD_BAR_WORDS + (layer * 2 + 1) * 4096,
                                             p.norm_mix_w + (layer + 1) * DM, p.mod + (size_t)(layer + 1) * 3 * 6144, 0, 1024, ((layer + 1) % 3 == 1) ? p.Pxbc + (size_t)T_TOK * 2048 : p.A, p.wq); }
    else { LP(); gemm_phase_residnorm192<true>(lds, p.H, p.Wfo, DFF, p.out, p.mod + (size_t)layer * 3 * 6144 + 5120, p.adap, p.bar + XCD_BAR_WORDS + (layer * 2 + 1) * 4096,
                                             p.final_norm_w, nullptr, 0, 0, nullptr, p.wq); }
    GSYNC();
    }
  {
    constexpr int layer = 2; constexpr int kind = layer % 3, j = layer / 3;
    if constexpr (layer == 0) { { LP(); ph_norm_mod<true>(p, p.norm_mix_w + layer * DM, p.mod + (size_t)layer * 3 * 6144, 0, 1024, p.H); }
      GSYNC(); }
    if constexpr (kind == 0) {
      { LP(); gemm_phase8(lds, layer == 0 ? p.H : p.A, p.Win, T_TOK, 6400, DM, EpiSsmIn{p.Pz, p.Pxbc, p.small}, p.wq); }
      if constexpr (layer == 0) { LP(); const int g_ = (int)gridDim.x, b0_ = (g_ >= 192) ? 176 : 0; if ((int)blockIdx.x >= b0_) { ph_convert(p, 0, 2, tile, (int)blockIdx.x - b0_, g_ - b0_); ph_ada_direct(p, 1, 2, shm, (int)blockIdx.x - b0_, g_ - b0_); } }
      GSYNC();
      { LP(); ph_ssm_tiles(p, j, shm); }
      GSYNC();
      { LP(); ph_ssm_chain(p, j, lds); }
      { LP(); if ((int)blockIdx.x >= 128) ph_convert(p, layer, 8, tile, (int)blockIdx.x - 128, (int)gridDim.x - 128); }
      GSYNC();
      { LP(); ph_ssm_post(p, j); }
      GSYNC();
      { LP(); gemm_phase_residnorm192<false>(lds, p.H, p.Wout, 2048, p.out, p.mod + (size_t)layer * 3 * 6144 + 2048, p.adap, p.bar + XCD_BAR_WORDS + (layer * 2) * 4096,
                                             p.norm_ffn_w + layer * DM, p.mod + (size_t)layer * 3 * 6144, 3072, 4096, p.A, p.wq); }
    } else if constexpr (kind == 1) {
      { LP(); gemm_phase8(lds, p.Pxbc + (size_t)T_TOK * 2048, p.Win, T_TOK, 4096, DM, EpiGlaIn{p.A, p.Pz, (float*)p.Pxbc, p.gla_gate_b}, p.wq); }
      GSYNC();
      { LP(); ph_gla_tiles(p, shm); }
      GSYNC();
      { LP(); ph_gla_chain(p, lds); }
      { LP(); if ((int)blockIdx.x >= 64) ph_convert(p, layer, 8, tile, (int)blockIdx.x - 64, (int)gridDim.x - 64); }
      GSYNC();
      { LP(); ph_headnorm_post(p, p.Pxbc + (size_t)T_TOK * 2048, 4, p.gla_norm_w, p.Pz); }
      GSYNC();
      { LP(); gemm_phase_residnorm192<false>(lds, p.H, p.Wout, 1024, p.out, p.mod + (size_t)layer * 3 * 6144 + 2048, p.adap, p.bar + XCD_BAR_WORDS + (layer * 2) * 4096,
                                             p.norm_ffn_w + layer * DM, p.mod + (size_t)layer * 3 * 6144, 3072, 4096, p.A, p.wq); }
    } else {
      { LP(); gemm_phase8(lds, p.A, p.Win, T_TOK, 6400, DM, EpiGdnIn{p.Pz, p.Pxbc, p.small}, p.wq); }
      GSYNC();
      { LP(); ph_gdn_tiles(p, shm); }
      GSYNC();
      { LP(); ph_gdn_chain(p, lds); }
      { LP(); if ((int)blockIdx.x >= 64) ph_convert(p, layer, 8, tile, (int)blockIdx.x - 64, (int)gridDim.x - 64); }
      GSYNC();
      { LP(); ph_headnorm_post(p, p.Pxbc, 8, p.gdn_norm_w, p.Pz); }
      GSYNC();
      { LP(); gemm_phase_residnorm192<false>(lds, p.H, p.Wout, 2048, p.out, p.mod + (size_t)layer * 3 * 6144 + 2048, p.adap, p.bar + XCD_BAR_WORDS + (layer * 2) * 4096,
                                             p.norm_ffn_w + layer * DM, p.mod + (size_t)layer * 3 * 6144, 3072, 4096, p.A, p.wq); }
    }
    GSYNC();
    { LP(); gemm_phase8(lds, p.A, p.Wfi, T_TOK, 5632, DM, EpiFfnIn{p.Pz, p.Pz + (size_t)T_TOK * DFF}, p.wq); }
    { LP(); const int g_ = (int)gridDim.x, b0_ = (g_ >= 64) ? 32 : 0;
      if ((int)blockIdx.x >= b0_) { ph_convert(p, layer, 16, tile, (int)blockIdx.x - b0_, g_ - b0_); if (layer < 3) ph_convert(p, layer + 1, 3, tile, (int)blockIdx.x - b0_, g_ - b0_);
                                    if (layer < 2) ph_ada_direct(p, layer + 2, layer + 3, shm, (int)blockIdx.x - b0_, g_ - b0_); } }
    GSYNC();
    { LP(); ph_ffn_glu(p, layer, shm); }
    GSYNC();
    if constexpr (layer < 3) { LP(); gemm_phase_residnorm192<false>(lds, p.H, p.Wfo, DFF, p.out, p.mod + (size_t)layer * 3 * 6144 + 5120, p.adap, p.bar + XCD_BAR_WORDS + (layer * 2 + 1) * 4096,
                                             p.norm_mix_w + (layer + 1) * DM, p.mod + (size_t)(layer + 1) * 3 * 6144, 0, 1024, ((layer + 1) % 3 == 1) ? p.Pxbc + (size_t)T_TOK * 2048 : p.A, p.wq); }
    else { LP(); gemm_phase_residnorm192<true>(lds, p.H, p.Wfo, DFF, p.out, p.mod + (size_t)layer * 3 * 6144 + 5120, p.adap, p.bar + XCD_BAR_WORDS + (layer * 2 + 1) * 4096,
                                             p.final_norm_w, nullptr, 0, 0, nullptr, p.wq); }
    GSYNC();
    }
  {
    constexpr int layer = 3; constexpr int kind = layer % 3, j = layer / 3;
    if constexpr (layer == 0) { { LP(); ph_norm_mod<true>(p, p.norm_mix_w + layer * DM, p.mod + (size_t)layer * 3 * 6144, 0, 1024, p.H); }
      GSYNC(); }
    if constexpr (kind == 0) {
      { LP(); gemm_phase8(lds, layer == 0 ? p.H : p.A, p.Win, T_TOK, 6400, DM, EpiSsmIn{p.Pz, p.Pxbc, p.small}, p.wq); }
      if constexpr (layer == 0) { LP(); const int g_ = (int)gridDim.x, b0_ = (g_ >= 192) ? 176 : 0; if ((int)blockIdx.x >= b0_) { ph_convert(p, 0, 2, tile, (int)blockIdx.x - b0_, g_ - b0_); ph_ada_direct(p, 1, 2, shm, (int)blockIdx.x - b0_, g_ - b0_); } }
      GSYNC();
      { LP(); ph_ssm_tiles(p, j, shm); }
      GSYNC();
      { LP(); ph_ssm_chain(p, j, lds); }
      { LP(); if ((int)blockIdx.x >= 128) ph_convert(p, layer, 8, tile, (int)blockIdx.x - 128, (int)gridDim.x - 128); }
      GSYNC();
      { LP(); ph_ssm_post(p, j); }
      GSYNC();
      { LP(); gemm_phase_residnorm192<false>(lds, p.H, p.Wout, 2048, p.out, p.mod + (size_t)layer * 3 * 6144 + 2048, p.adap, p.bar + XCD_BAR_WORDS + (layer * 2) * 4096,
                                             p.norm_ffn_w + layer * DM, p.mod + (size_t)layer * 3 * 6144, 3072, 4096, p.A, p.wq); }
    } else if constexpr (kind == 1) {
      { LP(); gemm_phase8(lds, p.Pxbc + (size_t)T_TOK * 2048, p.Win, T_TOK, 4096, DM, EpiGlaIn{p.A, p.Pz, (float*)p.Pxbc, p.gla_gate_b}, p.wq); }
      GSYNC();
      { LP(); ph_gla_tiles(p, shm); }
      GSYNC();
      { LP(); ph_gla_chain(p, lds); }
      { LP(); if ((int)blockIdx.x >= 64) ph_convert(p, layer, 8, tile, (int)blockIdx.x - 64, (int)gridDim.x - 64); }
      GSYNC();
      { LP(); ph_headnorm_post(p, p.Pxbc + (size_t)T_TOK * 2048, 4, p.gla_norm_w, p.Pz); }
      GSYNC();
      { LP(); gemm_phase_residnorm192<false>(lds, p.H, p.Wout, 1024, p.out, p.mod + (size_t)layer * 3 * 6144 + 2048, p.adap, p.bar + XCD_BAR_WORDS + (layer * 2) * 4096,
                                             p.norm_ffn_w + layer * DM, p.mod + (size_t)layer * 3 * 6144, 3072, 4096, p.A, p.wq); }
    } else {
      { LP(); gemm_phase8(lds, p.A, p.Win, T_TOK, 6400, DM, EpiGdnIn{p.Pz, p.Pxbc, p.small}, p.wq); }
      GSYNC();
      { LP(); ph_gdn_tiles(p, shm); }
      GSYNC();
      { LP(); ph_gdn_chain(p, lds); }
      { LP(); if ((int)blockIdx.x >= 64) ph_convert(p, layer, 8, tile, (int)blockIdx.x - 64, (int)gridDim.x - 64); }
      GSYNC();
      { LP(); ph_headnorm_post(p, p.Pxbc, 8, p.gdn_norm_w, p.Pz); }
      GSYNC();
      { LP(); gemm_phase_residnorm192<false>(lds, p.H, p.Wout, 2048, p.out, p.mod + (size_t)layer * 3 * 6144 + 2048, p.adap, p.bar + XCD_BAR_WORDS + (layer * 2) * 4096,
                                             p.norm_ffn_w + layer * DM, p.mod + (size_t)layer * 3 * 6144, 3072, 4096, p.A, p.wq); }
    }
    GSYNC();
    { LP(); gemm_phase8(lds, p.A, p.Wfi, T_TOK, 5632, DM, EpiFfnIn{p.Pz, p.Pz + (size_t)T_TOK * DFF}, p.wq); }
    { LP(); const int g_ = (int)gridDim.x, b0_ = (g_ >= 64) ? 32 : 0;
      if ((int)blockIdx.x >= b0_) { ph_convert(p, layer, 16, tile, (int)blockIdx.x - b0_, g_ - b0_); if (layer < 3) ph_convert(p, layer + 1, 3, tile, (int)blockIdx.x - b0_, g_ - b0_);
                                    if (layer < 2) ph_ada_direct(p, layer + 2, layer + 3, shm, (int)blockIdx.x - b0_, g_ - b0_); } }
    GSYNC();
    { LP(); ph_ffn_glu(p, layer, shm); }
    GSYNC();
    if constexpr (layer < 3) { LP(); gemm_phase_residnorm192<false>(lds, p.H, p.Wfo, DFF, p.out, p.mod + (size_t)layer * 3 * 6144 + 5120, p.adap, p.bar + XCD_BAR_WORDS + (layer * 2 + 1) * 4096,
                                             p.norm_mix_w + (layer + 1) * DM, p.mod + (size_t)(layer + 1) * 3 * 6144, 0, 1024, ((layer + 1) % 3 == 1) ? p.Pxbc + (size_t)T_TOK * 2048 : p.A, p.wq); }
    else { LP(); gemm_phase_residnorm192<true>(lds, p.H, p.Wfo, DFF, p.out, p.mod + (size_t)layer * 3 * 6144 + 5120, p.adap, p.bar + XCD_BAR_WORDS + (layer * 2 + 1) * 4096,
                                             p.final_norm_w, nullptr, 0, 0, nullptr, p.wq); }
    GSYNC();
    }

}

extern "C" void kernel_launch(void* const* d_in, const int* in_sizes, int n_in, void* d_out, int out_size, void* d_ws, size_t ws_size, hipStream_t stream) {
  P p{};
  const float** pp = (const float**)&p;
  for (int i = 0; i < 36; ++i) pp[i] = (const float*)d_in[i];
  p.out = (float*)d_out;
  char* w = (char*)d_ws; size_t off = 0;
  auto take = [&](size_t bytes) { char* r = w + off; off += (bytes + 255) & ~(size_t)255; return r; };
  p.Win = (bf16_t*)take((size_t)6400 * 1024 * 2);
  p.Wout = (bf16_t*)take((size_t)1024 * 2048 * 2);
  p.Wfi = (bf16_t*)take((size_t)5632 * 1024 * 2);
  p.Wfo = (bf16_t*)take((size_t)1024 * 2816 * 2);
  p.H = (bf16_t*)take((size_t)T_TOK * 2816 * 2);
  p.Pz = (bf16_t*)take((size_t)T_TOK * 2048 * 2);
  p.Pxbc = (bf16_t*)take((size_t)T_TOK * 4096 * 2);
  p.A = (bf16_t*)take((size_t)T_TOK * 4096 * 2);
  p.small = (float*)take((size_t)T_TOK * 64 * 4);
  p.small2 = (float*)take((size_t)T_TOK * 128 * 4);
  p.adap = (float*)take((size_t)16 * 4 * 3 * 6144 * 4);
  p.mod = (float*)take((size_t)4 * 3 * 6144 * 4);
  p.XT = p.H; p.Gm = p.H + (size_t)192 * 32 * 4096;
  p.BT = (bf16_t*)take((size_t)192 * 8 * 8192 * 2);
  p.VEC = (float*)take((size_t)192 * 64 * 192 * 4);
  p.bar = (unsigned*)take((size_t)(XCD_BAR_WORDS + 8 * 4096) * 4);
  if (off > ws_size) { fprintf(stderr, "workspace too small: need %zu have %zu\n", off, ws_size); return; }
  static int grid_blocks = 0;
  if (!grid_blocks) {
    int dev = 0, cus = 0, per_cu = 0;
    (void)hipGetDevice(&dev);
    (void)hipDeviceGetAttribute(&cus, hipDeviceAttributeMultiprocessorCount, dev);
    if (hipFuncSetAttribute((const void*)fwd_megakernel, hipFuncAttributeMaxDynamicSharedMemorySize, LDS_BYTES) != hipSuccess) { fprintf(stderr, "hipFuncSetAttribute failed\n"); return; }
    (void)hipOccupancyMaxActiveBlocksPerMultiprocessor(&per_cu, fwd_megakernel, NT, LDS_BYTES);
    if (per_cu < 1) { fprintf(stderr, "occupancy query returned %d\n", per_cu); return; }
    grid_blocks = cus;
  }
  if (hipMemsetAsync(p.bar, 0, (size_t)(XCD_BAR_WORDS + 8 * 4096) * 4, stream) != hipSuccess) { fprintf(stderr, "memset failed\n"); return; }
  void* args[] = {&p};
  hipError_t e = hipLaunchCooperativeKernel((void*)fwd_megakernel, dim3(grid_blocks), dim3(NT), args, LDS_BYTES, stream);
  if (e != hipSuccess) fprintf(stderr, "cooperative launch failed: %s (grid %d)\n", hipGetErrorString(e), grid_blocks);
}
```

```cpp
#include <hip/hip_runtime.h>
#include <cstdio>

typedef unsigned short bf16_t;
typedef short bf16x8 __attribute__((ext_vector_type(8)));
typedef float f32x4 __attribute__((ext_vector_type(4)));
typedef unsigned u32x2 __attribute__((ext_vector_type(2)));
typedef unsigned u32x4 __attribute__((ext_vector_type(4)));

#define NT 512
#define CH_BARRIER() do { asm volatile("s_waitcnt lgkmcnt(0)" ::: "memory"); __builtin_amdgcn_s_barrier(); asm volatile("" ::: "memory"); } while (0)
#define LAS __attribute__((address_space(3)))
#define T_TOK 12288
#define T_CTX 4096
#define DM 1024
#define DFF 2816
#define EPS 1e-6f

struct P {
  const float *x_prompt, *x_sample, *state_ssm, *state_gla, *state_gdn, *c, *c_ctx;
  const float *norm_mix_w, *norm_ffn_w, *ada_w, *ada_b, *ffn_in_w, *ffn_conv_w, *ffn_conv_b, *ffn_out_w;
  const float *ssm_in_w, *ssm_conv_w, *ssm_conv_b, *ssm_dt_bias, *ssm_a_log, *ssm_d, *ssm_norm_w, *ssm_out_w;
  const float *gla_in_w, *gla_gate_w1, *gla_gate_w2, *gla_gate_b, *gla_norm_w, *gla_out_w;
  const float *gdn_in_w, *gdn_conv_w, *gdn_dt_bias, *gdn_a_log, *gdn_norm_w, *gdn_out_w, *final_norm_w;
  float* out;
  bf16_t *Win, *Wout, *Wfi, *Wfo;
  bf16_t *H;
  bf16_t *Pz, *Pxbc;
  bf16_t *A;
  float *small, *small2, *adap, *mod;
  bf16_t *XT, *Gm, *BT; float* VEC;
  unsigned* bar;
  int wq, pad_;
};

__device__ __forceinline__ bf16_t f2bf(float f) {
  unsigned u = __float_as_uint(f);
  u += 0x7fffu + ((u >> 16) & 1u);
  return (bf16_t)(u >> 16);
}
__device__ __forceinline__ float bf2f(bf16_t b) { return __uint_as_float(((unsigned)b) << 16); }
__device__ __forceinline__ float bflo(unsigned u) { return __uint_as_float(u << 16); }
__device__ __forceinline__ float bfhi(unsigned u) { return __uint_as_float(u & 0xffff0000u); }
__device__ __forceinline__ unsigned cvt2(float a, float b);
__device__ __forceinline__ unsigned pack2(float a, float b) { return cvt2(a, b); }

typedef float f32x2 __attribute__((ext_vector_type(2)));
typedef float f32x16 __attribute__((ext_vector_type(16)));
typedef __bf16 hwbf16x2 __attribute__((ext_vector_type(2)));
__device__ __forceinline__ unsigned cvt2(float a, float b) { f32x2 v = {a, b}; return __builtin_bit_cast(unsigned, __builtin_convertvector(v, hwbf16x2)); }
__device__ __forceinline__ bf16x8 mk8(unsigned a, unsigned b, unsigned c, unsigned d) { u32x4 u = {a, b, c, d}; return __builtin_bit_cast(bf16x8, u); }
#define MFMA32(a, b, c) __builtin_amdgcn_mfma_f32_32x32x16_bf16((a), (b), (c), 0, 0, 0)
__device__ __forceinline__ int kperm(int k) { const int g4 = (k >> 2) & 3; return (k & ~12) | ((((g4 & 1) << 1) | (g4 >> 1)) << 2); }
__device__ __forceinline__ bf16x8 pack_half(const f32x16& x, int half) {
  return half == 0 ? mk8(cvt2(x[0], x[1]), cvt2(x[2], x[3]), cvt2(x[4], x[5]), cvt2(x[6], x[7]))
                   : mk8(cvt2(x[8], x[9]), cvt2(x[10], x[11]), cvt2(x[12], x[13]), cvt2(x[14], x[15]));
}
__device__ __forceinline__ float silu_f(float x) { return x * __builtin_amdgcn_rcpf(1.f + __expf(-x)); }
__device__ __forceinline__ float softplus_f(float x) { return fmaxf(x, 0.f) + log1pf(__expf(-fabsf(x))); }
__device__ __forceinline__ float sigmoid_f(float x) { return __builtin_amdgcn_rcpf(1.f + __expf(-x)); }
__device__ __forceinline__ float softplus_fast(float x) { return fmaxf(x, 0.f) + __logf(1.f + __expf(-fabsf(x))); }
__device__ __forceinline__ float dpp_row_shr(float v, int n) {
  const int iv = __builtin_bit_cast(int, v); int r;
  switch (n) { case 1: r = __builtin_amdgcn_update_dpp(0, iv, 0x111, 0xf, 0xf, true); break; case 2: r = __builtin_amdgcn_update_dpp(0, iv, 0x112, 0xf, 0xf, true); break;
               case 4: r = __builtin_amdgcn_update_dpp(0, iv, 0x114, 0xf, 0xf, true); break; default: r = __builtin_amdgcn_update_dpp(0, iv, 0x118, 0xf, 0xf, true); break; }
  return __builtin_bit_cast(float, r);
}
__device__ __forceinline__ float wave_scan_incl(float v) {
  v += dpp_row_shr(v, 1); v += dpp_row_shr(v, 2); v += dpp_row_shr(v, 4); v += dpp_row_shr(v, 8);
  v += __builtin_bit_cast(float, __builtin_amdgcn_update_dpp(0, __builtin_bit_cast(int, v), 0x142, 0xa, 0xf, false));
  v += __builtin_bit_cast(float, __builtin_amdgcn_update_dpp(0, __builtin_bit_cast(int, v), 0x143, 0xc, 0xf, false));
  return v;
}
__device__ __forceinline__ float row16_allsum(float v) {
  v += __builtin_bit_cast(float, __builtin_amdgcn_update_dpp(0, __builtin_bit_cast(int, v), 0xB1, 0xf, 0xf, false));
  v += __builtin_bit_cast(float, __builtin_amdgcn_update_dpp(0, __builtin_bit_cast(int, v), 0x4E, 0xf, 0xf, false));
  v += __builtin_bit_cast(float, __builtin_amdgcn_update_dpp(0, __builtin_bit_cast(int, v), 0x141, 0xf, 0xf, false));
  v += __builtin_bit_cast(float, __builtin_amdgcn_update_dpp(0, __builtin_bit_cast(int, v), 0x140, 0xf, 0xf, false));
  return v;
}
__device__ __forceinline__ float xor16_sum(float x) {
  const auto r = __builtin_amdgcn_permlane16_swap(__builtin_bit_cast(unsigned, x), __builtin_bit_cast(unsigned, x), false, false);
  return __builtin_bit_cast(float, r[0]) + __builtin_bit_cast(float, r[1]);
}
__device__ __forceinline__ float xor32_sum(float x) {
  const auto r = __builtin_amdgcn_permlane32_swap(__builtin_bit_cast(unsigned, x), __builtin_bit_cast(unsigned, x), false, false);
  return __builtin_bit_cast(float, r[0]) + __builtin_bit_cast(float, r[1]);
}
__device__ __forceinline__ float wave_sum(float v) {
  v += dpp_row_shr(v, 1); v += dpp_row_shr(v, 2); v += dpp_row_shr(v, 4); v += dpp_row_shr(v, 8);
  v += __builtin_bit_cast(float, __builtin_amdgcn_update_dpp(0, __builtin_bit_cast(int, v), 0x142, 0xa, 0xf, false));
  v += __builtin_bit_cast(float, __builtin_amdgcn_update_dpp(0, __builtin_bit_cast(int, v), 0x143, 0xc, 0xf, false));
  return __builtin_bit_cast(float, __builtin_amdgcn_readlane(__builtin_bit_cast(int, v), 63));
}
__device__ __forceinline__ int tidw(int wq) { int l; asm volatile("v_mbcnt_lo_u32_b32 %0, -1, 0\n\tv_mbcnt_hi_u32_b32 %0, -1, %0" : "=v"(l)); return (wq << 6) | l; }
__device__ __forceinline__ void tok_info(int t, int& t0, int& L, int& cond) {
  if (t < T_CTX) { t0 = t & ~255; L = 256; cond = 0; }
  else { int b = (t - T_CTX) >> 12; t0 = T_CTX + (b << 12); L = 4096; cond = 1 + b; }
}

__device__ __forceinline__ void convert_wt(const float* __restrict__ W, int K, int N, bf16_t* __restrict__ Wt, int row0, int ncover, float* tile  , int wq, int bid, int nb) {
  const int tk = K / 64, tn = ncover / 64, ntile = tk * tn;
  const int tid = tidw(wq);
  const int r = tid >> 4, c4 = (tid & 15) * 4;
  for (int ti0 = bid * 4; ti0 < ntile; ti0 += nb * 4) {
    f32x4 v[4][2];
#pragma unroll
    for (int u = 0; u < 4; ++u) {
      const int ti = ti0 + u, kt = ti % tk, nt = ti / tk;
#pragma unroll
      for (int h = 0; h < 2; ++h) {
        const int k = kt * 64 + r + h * 32, n = nt * 64 + c4;
        v[u][h] = (f32x4){0.f, 0.f, 0.f, 0.f};
        if (ti < ntile && n < N) v[u][h] = __builtin_nontemporal_load((const f32x4*)(W + (size_t)k * N + n));
      }
    }
#pragma unroll
    for (int u = 0; u < 4; ++u) {
      float* tl = tile + u * (64 * 65);
#pragma unroll
      for (int h = 0; h < 2; ++h) { float* d = tl + (r + h * 32) * 65 + c4; d[0] = v[u][h][0]; d[1] = v[u][h][1]; d[2] = v[u][h][2]; d[3] = v[u][h][3]; }
    }
    __syncthreads();
#pragma unroll
    for (int u = 0; u < 4; ++u) {
      const int ti = ti0 + u, kt = ti % tk, nt = ti / tk;
      if (ti < ntile) {
        const float* tl = tile + u * (64 * 65);
        const int n = tid >> 3, k8 = (tid & 7) * 8;
        u32x4 o;
        o[0] = pack2(tl[(k8 + 0) * 65 + n], tl[(k8 + 1) * 65 + n]);
        o[1] = pack2(tl[(k8 + 2) * 65 + n], tl[(k8 + 3) * 65 + n]);
        o[2] = pack2(tl[(k8 + 4) * 65 + n], tl[(k8 + 5) * 65 + n]);
        o[3] = pack2(tl[(k8 + 6) * 65 + n], tl[(k8 + 7) * 65 + n]);
        *(u32x4*)(Wt + (size_t)(row0 + nt * 64 + n) * K + kt * 64 + k8) = o;
      }
    }
    __syncthreads();
  }
}

__device__ __forceinline__ void ph_convert(const P& p, int layer, int which, float* tile, int bid, int nb) {
  const int kind = layer % 3, j = layer / 3;
  if (kind == 0) {
    if (which & 1) convert_wt(p.ssm_in_w + (size_t)j * 1024 * 6208, 1024, 6208, p.Win, 0, 6400, tile, p.wq, bid, nb);
    if (which & 2) convert_wt(p.ssm_out_w + (size_t)j * 2048 * 1024, 2048, 1024, p.Wout, 0, 1024, tile, p.wq, bid, nb);
  } else if (kind == 1) {
    if (which & 1) {
      convert_wt(p.gla_in_w, 1024, 3072, p.Win, 0, 3072, tile, p.wq, bid, nb);
      {
        const int tid_ = tidw(p.wq);
        for (int it = bid * NT + tid_; it < 1024 * 128; it += nb * NT) {
          const int n = it >> 7, k8 = (it & 127) * 8, e = n >> 9, kk = n & 511;
          float w2c[16];
#pragma unroll
          for (int r = 0; r < 16; ++r) w2c[r] = p.gla_gate_w2[(size_t)e * 16 * 512 + r * 512 + kk];
          float o[8];
#pragma unroll
          for (int q = 0; q < 8; ++q) {
            const float* w1 = p.gla_gate_w1 + ((size_t)e * 1024 + k8 + q) * 16;
            const f32x4 a0 = *(const f32x4*)(w1), a1 = *(const f32x4*)(w1 + 4), a2 = *(const f32x4*)(w1 + 8), a3 = *(const f32x4*)(w1 + 12);
            o[q] = (a0[0] * w2c[0] + a0[1] * w2c[1] + a0[2] * w2c[2] + a0[3] * w2c[3]) + (a1[0] * w2c[4] + a1[1] * w2c[5] + a1[2] * w2c[6] + a1[3] * w2c[7])
                 + (a2[0] * w2c[8] + a2[1] * w2c[9] + a2[2] * w2c[10] + a2[3] * w2c[11]) + (a3[0] * w2c[12] + a3[1] * w2c[13] + a3[2] * w2c[14] + a3[3] * w2c[15]);
          }
          u32x4 ov = {pack2(o[0], o[1]), pack2(o[2], o[3]), pack2(o[4], o[5]), pack2(o[6], o[7])};
          *(u32x4*)(p.Win + (size_t)(3072 + n) * 1024 + k8) = ov;
        }
      }
    }
    if (which & 2) convert_wt(p.gla_out_w, 1024, 1024, p.Wout, 0, 1024, tile, p.wq, bid, nb);
  } else {
    if (which & 1) convert_wt(p.gdn_in_w, 1024, 6176, p.Win, 0, 6400, tile, p.wq, bid, nb);
    if (which & 2) convert_wt(p.gdn_out_w, 2048, 1024, p.Wout, 0, 1024, tile, p.wq, bid, nb);
  }
  if (which & (4 | 8)) convert_wt(p.ffn_in_w + (size_t)layer * 1024 * 5632, 1024, 5632, p.Wfi, 0, 5632, tile, p.wq, bid, nb);
  if (which & (4 | 16)) convert_wt(p.ffn_out_w + (size_t)layer * 2816 * 1024, 2816, 1024, p.Wfo, 0, 1024, tile, p.wq, bid, nb);
}

__device__ __forceinline__ void ph_ada_partial(const P& p) {
  const int gtid = blockIdx.x * NT + tidw(p.wq), gsz = gridDim.x * NT;
  for (int it = gtid; it < 4 * 16 * 1536; it += gsz) {
    const int n4 = it % 1536, kp = (it / 1536) & 15, l = it / (1536 * 16);
    const float* w = p.ada_w + (size_t)l * 1024 * 6144 + (size_t)(kp * 64) * 6144 + n4 * 4;
    f32x4 a0 = {0.f, 0.f, 0.f, 0.f}, a1 = a0, a2 = a0;
#pragma unroll 8
    for (int k = 0; k < 64; ++k) {
      const int kk = kp * 64 + k;
      const float c0 = silu_f(p.c_ctx[kk]), c1 = silu_f(p.c[kk]), c2 = silu_f(p.c[1024 + kk]);
      const f32x4 wv = *(const f32x4*)(w + (size_t)k * 6144);
      a0 += c0 * wv; a1 += c1 * wv; a2 += c2 * wv;
    }
    float* d = p.adap + ((size_t)(kp * 4 + l) * 3) * 6144 + n4 * 4;
    *(f32x4*)(d) = a0; *(f32x4*)(d + 6144) = a1; *(f32x4*)(d + 2 * 6144) = a2;
  }
}
__device__ __forceinline__ void ph_ada_reduce(const P& p) {
  const int gtid = blockIdx.x * NT + tidw(p.wq), gsz = gridDim.x * NT;
  for (int it = gtid; it < 4 * 3 * 6144; it += gsz) {
    const int n = it % 6144, lc = it / 6144, l = lc / 3;
    float s = p.ada_b[l * 6144 + n];
#pragma unroll
    for (int kp = 0; kp < 16; ++kp) s += p.adap[(size_t)(kp * 12 + lc) * 6144 + n];
    p.mod[it] = s;
  }
}
__device__ __forceinline__ void ph_ada_direct(const P& p, int l_lo, int l_hi, unsigned char* shm, int bid, int nb) {
  const int tid = tidw(p.wq), part = tid >> 3, l8 = tid & 7;
  float* red = (float*)shm;
  const int nitem = (l_hi - l_lo) * 192;
  for (int item = bid; item < nitem; item += nb) {
    const int l = l_lo + item / 192, cg = item % 192;
    const float* w = p.ada_w + ((size_t)l * 1024 + part * 16) * 6144 + cg * 32 + l8 * 4;
    f32x4 wv[16];
#pragma unroll
    for (int k = 0; k < 16; ++k) wv[k] = *(const f32x4*)(w + (size_t)k * 6144);
    f32x4 a0 = {0.f, 0.f, 0.f, 0.f}, a1 = a0, a2 = a0;
#pragma unroll
    for (int k = 0; k < 16; ++k) {
      const int kk = part * 16 + k;
      const float c0 = silu_f(p.c_ctx[kk]), c1 = silu_f(p.c[kk]), c2 = silu_f(p.c[1024 + kk]);
      a0 += c0 * wv[k]; a1 += c1 * wv[k]; a2 += c2 * wv[k];
    }
    float* r = red + (part * 3) * 32 + l8 * 4;
    *(f32x4*)(r) = a0; *(f32x4*)(r + 32) = a1; *(f32x4*)(r + 64) = a2;
    __syncthreads();
    if (tid < 96) {
      const int cond = tid >> 5, n = tid & 31;
      float sacc = p.ada_b[l * 6144 + cg * 32 + n];
#pragma unroll 16
      for (int q = 0; q < 64; ++q) sacc += red[(q * 3 + cond) * 32 + n];
      p.mod[((size_t)l * 3 + cond) * 6144 + cg * 32 + n] = sacc;
    }
    __syncthreads();
  }
}
__device__ __forceinline__ void ph_copy_x(const P& p) {
  const int gtid = blockIdx.x * NT + tidw(p.wq), gsz = gridDim.x * NT;
  const int n1 = T_CTX * DM / 4, n2 = T_TOK * DM / 4;
  f32x4* o = (f32x4*)p.out;
  for (int i = gtid; i < n2; i += gsz) o[i] = (i < n1) ? ((const f32x4*)p.x_prompt)[i] : ((const f32x4*)p.x_sample)[i - n1];
}

template <bool FROM_INPUT>
__device__ __forceinline__ void ph_norm_mod(const P& p, const float* __restrict__ nw, const float* __restrict__ modl  , int sh_off, int sc_off, bf16_t* __restrict__ hout) {
  const int wave = tidw(p.wq) >> 6, lane = tidw(p.wq) & 63;
  const int gw = blockIdx.x * 8 + wave, nw_ = gridDim.x * 8;
  const float* x = p.out;
  for (int tb = gw; tb < T_TOK; tb += 3 * nw_) {
    f32x4 v[3][4]; float ss[3];
#pragma unroll
    for (int j = 0; j < 3; ++j) {
      const int t = tb + j * nw_; ss[j] = 0.f;
      if (t < T_TOK) {
        const float* xr = FROM_INPUT ? ((t < T_CTX) ? p.x_prompt + (size_t)t * DM : p.x_sample + (size_t)(t - T_CTX) * DM) : x + (size_t)t * DM;
#pragma unroll
        for (int i = 0; i < 4; ++i) v[j][i] = *(const f32x4*)(xr + i * 256 + lane * 4);
      }
    }
#pragma unroll
    for (int j = 0; j < 3; ++j) {
      const int t = tb + j * nw_;
      if (t < T_TOK) {
#pragma unroll
        for (int i = 0; i < 4; ++i) { ss[j] += v[j][i][0] * v[j][i][0] + v[j][i][1] * v[j][i][1] + v[j][i][2] * v[j][i][2] + v[j][i][3] * v[j][i][3];
          if (FROM_INPUT) *(f32x4*)(p.out + (size_t)t * DM + i * 256 + lane * 4) = v[j][i]; }
      }
    }
#pragma unroll
    for (int j = 0; j < 3; ++j) {
      const int t = tb + j * nw_;
      if (t < T_TOK) {
        int t0, L, cond; tok_info(t, t0, L, cond);
        const float rstd = rsqrtf(wave_sum(ss[j]) * (1.f / DM) + EPS);
        const float* mr = modl + cond * 6144;
#pragma unroll
        for (int i = 0; i < 4; ++i) {
          const int d = i * 256 + lane * 4;
          const f32x4 w = *(const f32x4*)(nw + d), sc = *(const f32x4*)(mr + sc_off + d), sh = *(const f32x4*)(mr + sh_off + d);
          float o0 = v[j][i][0] * rstd * w[0] * (1.f + sc[0]) + sh[0];
          float o1 = v[j][i][1] * rstd * w[1] * (1.f + sc[1]) + sh[1];
          float o2 = v[j][i][2] * rstd * w[2] * (1.f + sc[2]) + sh[2];
          float o3 = v[j][i][3] * rstd * w[3] * (1.f + sc[3]) + sh[3];
          u32x2 o; o[0] = pack2(o0, o1); o[1] = pack2(o2, o3);
          *(u32x2*)(hout + (size_t)t * DM + d) = o;
        }
      }
    }
  }
}

namespace pg8 {
#define PG8_LAS __attribute__((address_space(3)))
typedef unsigned short bf16_t;
typedef short bf16x8 __attribute__((ext_vector_type(8)));
typedef float f32x4 __attribute__((ext_vector_type(4)));
typedef unsigned u32x4 __attribute__((ext_vector_type(4)));
constexpr int BM = 256, BK = 64, HALF = 128, HTB = HALF * BK * 2  , STAGE_BYTES = 8 * HTB, NXCD = 8, WGM = 8;

__host__ __device__ __forceinline__ int lds_byte(int r, int c) { const int st = (r >> 4) * 2 + (c >> 5), rr = r & 15, cc = c & 31, ob = rr * 64 + cc * 2; return st * 1024 + (ob ^ (((ob >> 9) & 1) << 5)); }
__host__ __device__ __forceinline__ void stage_rc(int b, int& R, int& C) { const int st = b / 1024, sb = b % 1024, swz = sb ^ (((sb >> 9) & 1) << 5); R = (st >> 1) * 16 + swz / 64; C = (st & 1) * 32 + (swz % 64) / 2; }
__host__ __device__ __forceinline__ int perm32(int rho) { const int n = rho >> 4, i = rho & 15; return 8 * (i >> 2) + 4 * n + (i & 3); }

struct Unit { int pm, pn; };
struct Gemm { const bf16_t* A; const bf16_t* Bt; int M, N, K; };

struct StaticOrder {
    int nM, nN, nwg, G, c;
    __host__ __device__ void init(int M, int N, int G_, int c_, int bm = BM) { nM = M / bm; nN = N / BM; nwg = nM * nN; G = G_; c = c_; }
    __host__ __device__ bool next(int i, Unit& u) const {
        const long L = (long)i * G + c; if (L >= nwg) return false;
        int wgid = (int)L; { const int q = nwg / NXCD, r = nwg % NXCD, xcd = wgid % NXCD, off = wgid / NXCD; wgid = (xcd < r ? xcd * (q + 1) : r * (q + 1) + (xcd - r) * q) + off; }
        const int nig = WGM * nN, gid = wgid / nig, fm = gid * WGM, gsz = (nM - fm) < WGM ? (nM - fm) : WGM;
        u.pm = fm + ((wgid % nig) % gsz); u.pn = (wgid % nig) / gsz; return true;
    }
    __device__ __forceinline__ void a_ready(const Unit&) const {}
    __device__ __forceinline__ void done(const Unit&) const {}
};
template <class Epi, class Sched, bool ALIGN_EPI = false, bool SP2 = false, int BMR = 256, bool ONE_UNIT = false>
__device__ __forceinline__ void gemm_phase(PG8_LAS unsigned char* lds, const Gemm g, const Sched& S, const Epi& E, const int tid) {
    constexpr int HR = BMR / 2, MF = HR / 32;
    const int wid = __builtin_amdgcn_readfirstlane(tid >> 6), lane = tid & 63, wr = wid >> 2, wc = wid & 3, fr = lane & 15, fq = lane >> 4;
    const int K = g.K, nt = K / BK;
    unsigned voffA[2], voffB[2];
#pragma unroll
    for (int i = 0; i < 2; ++i) { int R, C; stage_rc(tid * 16 + i * 8192, R, C); const int Rb = Epi::PERM ? ((R & ~31) + perm32(R & 31)) : R;
        voffA[i] = (unsigned)(R * K + C) * 2u; voffB[i] = (unsigned)(Rb * K + C) * 2u; }
    const size_t kstep = (size_t)(BK * 2);
    const size_t hstep = (size_t)HALF * K * 2;
    const size_t tstep = 2 * hstep;
    const size_t hstepA = (size_t)HR * K * 2, tstepA = 2 * hstepA;
    const unsigned ldsw = (unsigned)wid * 1024u;
    const int aoff = lds_byte(wr * (HR / 2) + fr, fq * 8), boff = lds_byte(wc * 32 + fr, fq * 8);
#define PG8_SA(b, h) (((b) * 2 + (h)) * HTB)
#define PG8_SB(b, h) ((4 + (b) * 2 + (h)) * HTB)
#define PG8_STAGE(bufoff, gbase, voff) do { _Pragma("unroll") for (int _i = 0; _i < 2; ++_i) \
        __builtin_amdgcn_global_load_lds((const unsigned*)((const char*)(gbase) + (voff)[_i]), (PG8_LAS unsigned*)(lds + (bufoff) + ldsw + _i * 8192), 16, 0, 0); } while (0)
#define PG8_LDA(dst, b, h) do { _Pragma("unroll") for (int m = 0; m < MF; ++m) _Pragma("unroll") for (int k = 0; k < 2; ++k) dst[m][k] = *(const PG8_LAS bf16x8*)(lds + PG8_SA(b, h) + aoff + m * 2048 + k * 1024); } while (0)
#define PG8_LDB(dst, b, h) do { _Pragma("unroll") for (int n = 0; n < 2; ++n) _Pragma("unroll") for (int k = 0; k < 2; ++k) dst[n][k] = *(const PG8_LAS bf16x8*)(lds + PG8_SB(b, h) + boff + n * 2048 + k * 1024); } while (0)
#define PG8_MMA(ai, bj, At, Bt) do { __builtin_amdgcn_s_setprio(1); _Pragma("unroll") for (int m = 0; m < MF; ++m) _Pragma("unroll") for (int n = 0; n < 2; ++n) _Pragma("unroll") for (int k = 0; k < 2; ++k) \
        acc[ai][bj][m][n] = __builtin_amdgcn_mfma_f32_16x16x32_bf16(Bt[n][k], At[m][k], acc[ai][bj][m][n], 0, 0, 0); __builtin_amdgcn_s_setprio(0); } while (0)
#define PG8_WAIT_V(n) asm volatile("s_waitcnt vmcnt(" #n ")" ::: "memory")
#define PG8_WAIT_L(n) asm volatile("s_waitcnt lgkmcnt(" #n ")" ::: "memory")
#define PG8_BAR __builtin_amdgcn_s_barrier()
#define PG8_SCHED __builtin_amdgcn_sched_barrier(0)
    Unit cur, nxt; int ui = 0;
    if (!S.next(0, cur)) return;
    f32x4 acc[2][2][MF][2];
#pragma unroll
    for (int a = 0; a < 2; ++a)
#pragma unroll
        for (int b = 0; b < 2; ++b)
#pragma unroll
            for (int m = 0; m < MF; ++m)
#pragma unroll
                for (int n = 0; n < 2; ++n) acc[a][b][m][n] = (f32x4){0.f, 0.f, 0.f, 0.f};
    bf16x8 At[MF][2], B0[2][2], B1[2][2];
    const char* cA = (const char*)g.A + (size_t)cur.pm * tstepA; const char* cB = (const char*)g.Bt + (size_t)cur.pn * tstep;
    S.a_ready(cur);
    if constexpr (SP2) {
        PG8_STAGE(PG8_SB(0, 0), cB, voffB); PG8_STAGE(PG8_SB(0, 1), cB + hstep, voffB); PG8_STAGE(PG8_SA(0, 0), cA, voffA); PG8_STAGE(PG8_SA(0, 1), cA + hstepA, voffA);
        if (wr == 1) PG8_BAR;
        PG8_WAIT_V(2); PG8_BAR;
        PG8_STAGE(PG8_SB(1, 0), cB + kstep, voffB); PG8_STAGE(PG8_SA(1, 0), cA + kstep, voffA); PG8_STAGE(PG8_SB(1, 1), cB + hstep + kstep, voffB);
        PG8_WAIT_V(6); PG8_BAR;
    } else {
        PG8_STAGE(PG8_SB(0, 0), cB, voffB); PG8_STAGE(PG8_SA(0, 0), cA, voffA); PG8_STAGE(PG8_SB(0, 1), cB + hstep, voffB); PG8_STAGE(PG8_SA(0, 1), cA + hstepA, voffA);
        if (wr == 1) PG8_BAR;
        PG8_WAIT_V(4); PG8_BAR;
        PG8_STAGE(PG8_SB(1, 0), cB + kstep, voffB); PG8_STAGE(PG8_SA(1, 0), cA + kstep, voffA); PG8_STAGE(PG8_SB(1, 1), cB + hstep + kstep, voffB);
        PG8_WAIT_V(6); PG8_BAR;
    }
    for (;;) {
        const bool has_next = ONE_UNIT ? false : S.next(ui + 1, nxt);
        const char* nA = has_next ? (const char*)g.A + (size_t)nxt.pm * tstepA : cA; const char* nB = has_next ? (const char*)g.Bt + (size_t)nxt.pn * tstep : cB;
        for (int t = 0; t < nt; t += 2) {
            const bool last = (t == nt - 2);
            const char* a1 = cA + (size_t)(t + 1) * kstep;
            const char* a2 = last ? nA : cA + (size_t)(t + 2) * kstep; const char* b2 = last ? nB : cB + (size_t)(t + 2) * kstep;
            const char* a3 = a2 + kstep; const char* b3 = b2 + kstep;
            if (last && has_next) S.a_ready(nxt);
            if constexpr (SP2) {
            PG8_LDB(B0, 0, 0); PG8_LDB(B1, 0, 1); PG8_SCHED; PG8_LDA(At, 0, 0); PG8_STAGE(PG8_SA(1, 1), a1 + hstepA, voffA);
            PG8_WAIT_V(8); PG8_WAIT_L(0); PG8_BAR; PG8_MMA(0, 0, At, B0); PG8_MMA(0, 1, At, B1); PG8_BAR; PG8_SCHED;
            PG8_LDA(At, 0, 1); PG8_STAGE(PG8_SB(0, 0), b2, voffB); PG8_STAGE(PG8_SB(0, 1), b2 + hstep, voffB); PG8_STAGE(PG8_SA(0, 0), a2, voffA);
            PG8_WAIT_V(8); PG8_WAIT_L(0); PG8_BAR; PG8_MMA(1, 0, At, B0); PG8_MMA(1, 1, At, B1); PG8_BAR; PG8_SCHED;
            PG8_LDB(B0, 1, 0); PG8_LDB(B1, 1, 1); PG8_SCHED; PG8_LDA(At, 1, 0); PG8_STAGE(PG8_SA(0, 1), a2 + hstepA, voffA);
            PG8_WAIT_V(8); PG8_WAIT_L(0); PG8_BAR; PG8_MMA(0, 0, At, B0); PG8_MMA(0, 1, At, B1); PG8_BAR; PG8_SCHED;
            PG8_LDA(At, 1, 1); PG8_STAGE(PG8_SB(1, 0), b3, voffB); PG8_STAGE(PG8_SB(1, 1), b3 + hstep, voffB); PG8_STAGE(PG8_SA(1, 0), a3, voffA);
            PG8_WAIT_V(8); PG8_WAIT_L(0); PG8_BAR; PG8_MMA(1, 0, At, B0); PG8_MMA(1, 1, At, B1); PG8_BAR; PG8_SCHED;
            } else {
            PG8_LDB(B0, 0, 0); PG8_SCHED; PG8_LDA(At, 0, 0); PG8_STAGE(PG8_SA(1, 1), a1 + hstepA, voffA);
            PG8_WAIT_L(8); PG8_BAR; PG8_WAIT_L(0); PG8_MMA(0, 0, At, B0); PG8_BAR; PG8_SCHED;
            PG8_LDB(B1, 0, 1); PG8_STAGE(PG8_SB(0, 0), b2, voffB);
            PG8_BAR; PG8_WAIT_L(0); PG8_MMA(0, 1, At, B1); PG8_BAR;
            PG8_LDA(At, 0, 1); PG8_STAGE(PG8_SA(0, 0), a2, voffA);
            PG8_BAR; PG8_WAIT_L(0); PG8_MMA(1, 0, At, B0); PG8_BAR; PG8_SCHED;
            PG8_STAGE(PG8_SB(0, 1), b2 + hstep, voffB);
            PG8_WAIT_V(6); PG8_BAR; PG8_MMA(1, 1, At, B1); PG8_BAR;
            PG8_LDB(B0, 1, 0); PG8_SCHED; PG8_LDA(At, 1, 0); PG8_STAGE(PG8_SA(0, 1), a2 + hstepA, voffA);
            PG8_WAIT_L(8); PG8_BAR; PG8_WAIT_L(0); PG8_MMA(0, 0, At, B0); PG8_BAR; PG8_SCHED;
            PG8_LDB(B1, 1, 1); PG8_STAGE(PG8_SB(1, 0), b3, voffB);
            PG8_BAR; PG8_WAIT_L(0); PG8_MMA(0, 1, At, B1); PG8_BAR;
            PG8_LDA(At, 1, 1); PG8_STAGE(PG8_SA(1, 0), a3, voffA);
            PG8_BAR; PG8_WAIT_L(0); PG8_MMA(1, 0, At, B0); PG8_BAR; PG8_SCHED;
            PG8_STAGE(PG8_SB(1, 1), b3 + hstep, voffB);
            PG8_WAIT_V(6); PG8_BAR; PG8_MMA(1, 1, At, B1); PG8_BAR;
            }
        }
        if constexpr (ALIGN_EPI) { if (wr == 0) PG8_BAR; }
        if constexpr (!Epi::AFTER_DRAIN) { E(acc, cur, wr, wc, fr, fq); S.done(cur); }
        if (!has_next) break;
#pragma unroll
        for (int a = 0; a < 2; ++a)
#pragma unroll
            for (int b = 0; b < 2; ++b)
#pragma unroll
                for (int m = 0; m < MF; ++m)
#pragma unroll
                    for (int n = 0; n < 2; ++n) acc[a][b][m][n] = (f32x4){0.f, 0.f, 0.f, 0.f};
        cur = nxt; cA = nA; cB = nB; ++ui;
        if constexpr (ALIGN_EPI) { if (wr == 1) PG8_BAR; }
    }
    PG8_WAIT_V(0);
    if constexpr (!ALIGN_EPI) { if (wr == 0) PG8_BAR; }
    PG8_BAR;
    if constexpr (Epi::AFTER_DRAIN) { E.fused(acc, cur, wr, wc, fr, fq, lds, wid, lane); S.done(cur); }
#undef PG8_SA
#undef PG8_SB
#undef PG8_STAGE
#undef PG8_LDA
#undef PG8_LDB
#undef PG8_MMA
#undef PG8_WAIT_V
#undef PG8_WAIT_L
#undef PG8_BAR
#undef PG8_SCHED
}
}

#define LDS_BYTES 147456
typedef __attribute__((address_space(3))) unsigned char lds_u8;
template <class F> struct EpiAdapt {
  static constexpr bool PERM = false, AFTER_DRAIN = false;
  F f;
  __device__ __forceinline__ void operator()(const f32x4 (&acc)[2][2][4][2], const pg8::Unit& u, int wr, int wc, int fr, int fq) const {
#pragma unroll
    for (int ai = 0; ai < 2; ++ai)
#pragma unroll
      for (int m = 0; m < 4; ++m) {
        const int row = u.pm * 256 + ai * 128 + wr * 64 + m * 16 + fr;
#pragma unroll
        for (int bj = 0; bj < 2; ++bj)
#pragma unroll
          for (int n = 0; n < 2; ++n) f(row, u.pn * 256 + bj * 128 + wc * 32 + n * 16 + fq * 4, acc[ai][bj][m][n]);
        asm volatile("" ::: "memory");
      }
  }
};
template <class F>
__device__ __forceinline__ void gemm_phase(lds_u8* lds, const bf16_t* A, const bf16_t* Bt, int M, int Npad, int K, const F& f, int wq) {
  pg8::Gemm g{A, Bt, M, Npad, K};
  pg8::StaticOrder S; S.init(M, Npad, (int)gridDim.x, (int)blockIdx.x);
  EpiAdapt<F> E{f};
  pg8::gemm_phase<EpiAdapt<F>, pg8::StaticOrder, false, true>(lds, g, S, E, tidw(wq));
  __syncthreads();
}

struct EpiResidP {
  static constexpr bool PERM = false, AFTER_DRAIN = false;
  float* x; const float* g;
  __device__ __forceinline__ void operator()(const f32x4 (&acc)[2][2][4][2], const pg8::Unit& u, int wr, int wc, int fr, int fq) const {
    const int cond = (u.pm < 16) ? 0 : ((u.pm < 32) ? 1 : 2);
    const int col0 = u.pn * 256 + wc * 32 + 4 * fq;
    f32x4 gv[2][2];
#pragma unroll
    for (int bj = 0; bj < 2; ++bj)
#pragma unroll
      for (int n = 0; n < 2; ++n) gv[bj][n] = *(const f32x4*)(g + cond * 6144 + col0 + bj * 128 + n * 16);
#pragma unroll
    for (int ai = 0; ai < 2; ++ai) {
      float* xb = x + (size_t)(u.pm * 256 + ai * 128 + wr * 64 + fr) * DM + col0;
      f32x4 xv[4][2][2];
#pragma unroll
      for (int m = 0; m < 4; ++m)
#pragma unroll
        for (int bj = 0; bj < 2; ++bj)
#pragma unroll
          for (int n = 0; n < 2; ++n) xv[m][bj][n] = *(const f32x4*)(xb + (size_t)m * 16 * DM + bj * 128 + n * 16);
#pragma unroll
      for (int m = 0; m < 4; ++m)
#pragma unroll
        for (int bj = 0; bj < 2; ++bj)
#pragma unroll
          for (int n = 0; n < 2; ++n) *(f32x4*)(xb + (size_t)m * 16 * DM + bj * 128 + n * 16) = xv[m][bj][n] + gv[bj][n] * acc[ai][bj][m][n];
      asm volatile("" ::: "memory");
    }
  }
};
struct EpiResidP192 {
  static constexpr bool PERM = false, AFTER_DRAIN = false;
  float* x; const float* g;
  __device__ __forceinline__ void operator()(const f32x4 (&acc)[2][2][3][2], const pg8::Unit& u, int wr, int wc, int fr, int fq) const {
    const int col0 = u.pn * 256 + wc * 32 + 4 * fq;
#pragma unroll
    for (int ai = 0; ai < 2; ++ai) {
      const int row0 = u.pm * 192 + ai * 96 + wr * 48;
      float* xb = x + (size_t)(row0 + fr) * DM + col0;
      f32x4 xv[3][2][2], gv[3][2][2];
#pragma unroll
      for (int m = 0; m < 3; ++m) {
        const int rf = row0 + m * 16, cond = (rf < T_CTX) ? 0 : 1 + ((rf - T_CTX) >> 12);
#pragma unroll
        for (int bj = 0; bj < 2; ++bj)
#pragma unroll
          for (int n = 0; n < 2; ++n) { xv[m][bj][n] = *(const f32x4*)(xb + (size_t)m * 16 * DM + bj * 128 + n * 16); gv[m][bj][n] = *(const f32x4*)(g + cond * 6144 + col0 + bj * 128 + n * 16); }
      }
#pragma unroll
      for (int m = 0; m < 3; ++m)
#pragma unroll
        for (int bj = 0; bj < 2; ++bj)
#pragma unroll
          for (int n = 0; n < 2; ++n) *(f32x4*)(xb + (size_t)m * 16 * DM + bj * 128 + n * 16) = xv[m][bj][n] + gv[m][bj][n] * acc[ai][bj][m][n];
      asm volatile("" ::: "memory");
    }
  }
};
template <bool FINAL>
struct EpiResidNorm192 {
  static constexpr bool PERM = false, AFTER_DRAIN = false;
  float* x; const float* g; float* part; unsigned* cnt; const float* nw; const float* modl; int sh_off, sc_off; bf16_t* hout;
  template <bool UNI>
  __device__ __forceinline__ void run(f32x4 (&acc)[2][2][3][2], const pg8::Unit& u, int wr, int wc, int fr, int fq) const {
    const int col0 = u.pn * 256 + wc * 32 + 4 * fq;
    const int tile0 = u.pm * 192, cond0 = (tile0 < T_CTX) ? 0 : 1 + ((tile0 - T_CTX) >> 12);
    f32x4 wsu[2][2];
    if (UNI) {
#pragma unroll
      for (int bj = 0; bj < 2; ++bj)
#pragma unroll
        for (int n = 0; n < 2; ++n) { const int c = col0 + bj * 128 + n * 16;
          const f32x4 w = *(const f32x4*)(nw + c);
          if (FINAL) wsu[bj][n] = w;
          else { const f32x4 sc = *(const f32x4*)(modl + cond0 * 6144 + sc_off + c); wsu[bj][n] = w * (1.f + sc); } }
    }
#pragma unroll
    for (int ai = 0; ai < 2; ++ai) {
      const int row0 = tile0 + ai * 96 + wr * 48;
      float* xb = x + (unsigned)(row0 + fr) * DM + col0;
#pragma unroll
      for (int m = 0; m < 3; ++m) {
        const int rf = row0 + m * 16, cond = UNI ? cond0 : ((rf < T_CTX) ? 0 : 1 + ((rf - T_CTX) >> 12));
        f32x4 xv[2][2];
#pragma unroll
        for (int bj = 0; bj < 2; ++bj)
#pragma unroll
          for (int n = 0; n < 2; ++n) xv[bj][n] = *(const f32x4*)(xb + (unsigned)m * 16 * DM + bj * 128 + n * 16);
        float ss = 0.f;
#pragma unroll
        for (int bj = 0; bj < 2; ++bj)
#pragma unroll
          for (int n = 0; n < 2; ++n) {
            const f32x4 gv = *(const f32x4*)(g + cond * 6144 + col0 + bj * 128 + n * 16);
            const f32x4 xn = xv[bj][n] + gv * acc[ai][bj][m][n];
            acc[ai][bj][m][n] = xn;
            if (!FINAL) *(f32x4*)(xb + (unsigned)m * 16 * DM + bj * 128 + n * 16) = xn;
            ss += xn[0] * xn[0] + xn[1] * xn[1] + xn[2] * xn[2] + xn[3] * xn[3];
          }
        ss += __shfl_xor(ss, 16); ss += __shfl_xor(ss, 32);
        if (fq == 0) { float* d = part + (unsigned)(rf + fr) * 16 + u.pn * 4 + wc; asm volatile("global_store_dword %0, %1, off sc1" :: "v"(d), "v"(ss) : "memory"); }
      }
    }
    asm volatile("s_waitcnt vmcnt(0)" ::: "memory");
    __syncthreads();
    if (wr == 0 && wc == 0) {
      unsigned* cw = cnt + u.pm * 64;
      if (fq * 16 + fr == 0) __hip_atomic_fetch_add(cw, 1u, __ATOMIC_RELAXED, __HIP_MEMORY_SCOPE_AGENT);
      unsigned spins = 0;
      while ((unsigned)__builtin_amdgcn_readfirstlane(__hip_atomic_load(cw, __ATOMIC_RELAXED, __HIP_MEMORY_SCOPE_AGENT)) < 4u) {
        __builtin_amdgcn_s_sleep(1);
        if (++spins > (1u << 22)) break;
      }
      __builtin_amdgcn_fence(__ATOMIC_ACQUIRE, "agent");
      asm volatile("s_waitcnt vmcnt(0)" ::: "memory");
    }
    __syncthreads();
#pragma unroll
    for (int ai = 0; ai < 2; ++ai) {
      const int row0 = tile0 + ai * 96 + wr * 48;
      f32x4 p4[3];
#pragma unroll
      for (int m = 0; m < 3; ++m) p4[m] = *(const f32x4*)(part + (unsigned)(row0 + m * 16 + fr) * 16 + 4 * fq);
#pragma unroll
      for (int m = 0; m < 3; ++m) {
        const int rf = row0 + m * 16, cond = UNI ? cond0 : ((rf < T_CTX) ? 0 : 1 + ((rf - T_CTX) >> 12));
        float tot = (p4[m][0] + p4[m][1]) + (p4[m][2] + p4[m][3]);
        tot += __shfl_xor(tot, 16); tot += __shfl_xor(tot, 32);
        const float rstd = rsqrtf(tot * (1.f / DM) + EPS);
#pragma unroll
        for (int bj = 0; bj < 2; ++bj)
#pragma unroll
          for (int n = 0; n < 2; ++n) {
            const int c = col0 + bj * 128 + n * 16;
            const f32x4 xn = acc[ai][bj][m][n];
            f32x4 ws, sh;
            if (UNI) { ws = wsu[bj][n]; if (!FINAL) sh = *(const f32x4*)(modl + cond0 * 6144 + sh_off + c); }
            else { const f32x4 w = *(const f32x4*)(nw + c);
              if (FINAL) ws = w; else { ws = w * (1.f + *(const f32x4*)(modl + cond * 6144 + sc_off + c)); sh = *(const f32x4*)(modl + cond * 6144 + sh_off + c); } }
            if (FINAL) {
              __builtin_nontemporal_store(xn * rstd * ws, (f32x4*)(x + (unsigned)(rf + fr) * DM + c));
            } else {
              u32x2 o; o[0] = pack2(xn[0] * rstd * ws[0] + sh[0], xn[1] * rstd * ws[1] + sh[1]);
              o[1] = pack2(xn[2] * rstd * ws[2] + sh[2], xn[3] * rstd * ws[3] + sh[3]);
              *(u32x2*)(hout + (unsigned)(rf + fr) * DM + c) = o;
            }
          }
      }
    }
  }
  __device__ __forceinline__ void operator()(f32x4 (&acc)[2][2][3][2], const pg8::Unit& u, int wr, int wc, int fr, int fq) const {
    const int t0 = u.pm * 192, t1 = t0 + 191;
    const int c0 = (t0 < T_CTX) ? 0 : 1 + ((t0 - T_CTX) >> 12), c1 = (t1 < T_CTX) ? 0 : 1 + ((t1 - T_CTX) >> 12);
    if (c0 == c1) run<true>(acc, u, wr, wc, fr, fq); else run<false>(acc, u, wr, wc, fr, fq);
  }
};
template <bool FINAL>
__device__ __forceinline__ void gemm_phase_residnorm192(lds_u8* lds, const bf16_t* A, const bf16_t* Bt, int K, float* x, const float* g, float* part, unsigned* cnt,
                                                        const float* nw, const float* modl, int sh_off, int sc_off, bf16_t* hout, int wq) {
  pg8::Gemm gm{A, Bt, T_TOK, 1024, K};
  pg8::StaticOrder S; S.init(T_TOK, 1024, (int)gridDim.x, (int)blockIdx.x, 192);
  EpiResidNorm192<FINAL> E{x, g, part, cnt, nw, modl, sh_off, sc_off, hout};
  pg8::gemm_phase<EpiResidNorm192<FINAL>, pg8::StaticOrder, true, true, 192, true>(lds, gm, S, E, tidw(wq));
  __syncthreads();
}
__device__ __forceinline__ void gemm_phase_resid192(lds_u8* lds, const bf16_t* A, const bf16_t* Bt, int M, int Npad, int K, float* x, const float* g, int wq) {
  pg8::Gemm gm{A, Bt, M, Npad, K};
  pg8::StaticOrder S; S.init(M, Npad, (int)gridDim.x, (int)blockIdx.x, 192);
  EpiResidP192 E{x, g};
  pg8::gemm_phase<EpiResidP192, pg8::StaticOrder, false, true, 192>(lds, gm, S, E, tidw(wq));
  __syncthreads();
}
__device__ __forceinline__ void gemm_phase_resid(lds_u8* lds, const bf16_t* A, const bf16_t* Bt, int M, int Npad, int K, float* x, const float* g, int wq) {
  pg8::Gemm gm{A, Bt, M, Npad, K};
  pg8::StaticOrder S; S.init(M, Npad, (int)gridDim.x, (int)blockIdx.x);
  EpiResidP E{x, g};
  pg8::gemm_phase<EpiResidP, pg8::StaticOrder, false, true>(lds, gm, S, E, tidw(wq));
  __syncthreads();
}
template <class F> struct EpiAdapt8 {
  static constexpr bool PERM = true, AFTER_DRAIN = false;
  F f;
  __device__ __forceinline__ void operator()(const f32x4 (&acc)[2][2][4][2], const pg8::Unit& u, int wr, int wc, int fr, int fq) const {
#pragma unroll
    for (int ai = 0; ai < 2; ++ai)
#pragma unroll
      for (int m = 0; m < 4; ++m) {
        const int row = u.pm * 256 + ai * 128 + wr * 64 + m * 16 + fr;
#pragma unroll
        for (int bj = 0; bj < 2; ++bj) f.st8(row, u.pn * 256 + bj * 128 + wc * 32 + fq * 8, acc[ai][bj][m][0], acc[ai][bj][m][1]);
      }
  }
};
template <class F>
__device__ __forceinline__ void gemm_phase8(lds_u8* lds, const bf16_t* A, const bf16_t* Bt, int M, int Npad, int K, const F& f, int wq) {
  pg8::Gemm g{A, Bt, M, Npad, K};
  pg8::StaticOrder S; S.init(M, Npad, (int)gridDim.x, (int)blockIdx.x);
  EpiAdapt8<F> E{f};
  pg8::gemm_phase<EpiAdapt8<F>, pg8::StaticOrder, false, true>(lds, g, S, E, tidw(wq));
  __syncthreads();
}
__device__ __forceinline__ void st_bf8(bf16_t* d, f32x4 a, f32x4 b) { u32x4 o = {cvt2(a[0], a[1]), cvt2(a[2], a[3]), cvt2(b[0], b[1]), cvt2(b[2], b[3])}; *(u32x4*)d = o; }
__device__ __forceinline__ void st_bf4(bf16_t* d, f32x4 v) { u32x2 o; o[0] = pack2(v[0], v[1]); o[1] = pack2(v[2], v[3]); *(u32x2*)d = o; }

struct EpiSsmIn { bf16_t *Pz, *Pxbc; float* small;
  __device__ __forceinline__ void operator()(int m, int n, f32x4 v) const {
    if (n < 2048) st_bf4(Pz + (size_t)m * 2048 + n, v);
    else if (n < 6144) st_bf4(Pxbc + (size_t)m * 4096 + (n - 2048), v);
    else if (n < 6208) *(f32x4*)(small + (size_t)m * 64 + (n - 6144)) = v;
  }
  __device__ __forceinline__ void st8(int m, int n, f32x4 a, f32x4 b) const {
    if (n < 2048) st_bf8(Pz + (size_t)m * 2048 + n, a, b);
    else if (n < 6144) st_bf8(Pxbc + (size_t)m * 4096 + (n - 2048), a, b);
    else if (n < 6208) { float* d = small + (size_t)m * 64 + (n - 6144); *(f32x4*)d = a; *(f32x4*)(d + 4) = b; }
  } };
struct EpiGlaIn { bf16_t *A, *Pz; float* G; const float* gb;
  __device__ __forceinline__ void st8(int m, int n, f32x4 a, f32x4 b) const {
    if (n < 512) st_bf8(A + (size_t)m * 2048 + n, a * 0.08838834764831845f, b * 0.08838834764831845f);
    else if (n < 2048) st_bf8(A + (size_t)m * 2048 + n, a, b);
    else if (n < 3072) st_bf8(Pz + (size_t)m * 1024 + (n - 2048), a, b);
    else {
      const int c = n - 3072;
      const f32x4 b0 = *(const f32x4*)(gb + c), b1 = *(const f32x4*)(gb + c + 4);
      f32x4 o0, o1;
#pragma unroll
      for (int q = 0; q < 4; ++q) { o0[q] = -softplus_fast(-(a[q] + b0[q])) * (1.f / 16.f); o1[q] = -softplus_fast(-(b[q] + b1[q])) * (1.f / 16.f); }
      float* d = G + (size_t)m * 1024 + c; *(f32x4*)d = o0; *(f32x4*)(d + 4) = o1;
    }
  } };
struct EpiGdnIn { bf16_t *Pz, *Pxbc; float* small;
  __device__ __forceinline__ void operator()(int m, int n, f32x4 v) const {
    if (n < 4096) st_bf4(Pxbc + (size_t)m * 4096 + n, v);
    else if (n < 6144) st_bf4(Pz + (size_t)m * 2048 + (n - 4096), v);
    else if (n < 6176) *(f32x4*)(small + (size_t)m * 64 + (n - 6144)) = v;
  }
  __device__ __forceinline__ void st8(int m, int n, f32x4 a, f32x4 b) const {
    if (n < 4096) st_bf8(Pxbc + (size_t)m * 4096 + n, a, b);
    else if (n < 6144) st_bf8(Pz + (size_t)m * 2048 + (n - 4096), a, b);
    else if (n < 6176) { float* d = small + (size_t)m * 64 + (n - 6144); *(f32x4*)d = a; *(f32x4*)(d + 4) = b; }
  } };
struct EpiFfnIn { bf16_t *Pa, *Pv;
  __device__ __forceinline__ void operator()(int m, int n, f32x4 v) const {
    if (n < DFF) st_bf4(Pa + (size_t)m * DFF + n, v); else st_bf4(Pv + (size_t)m * DFF + (n - DFF), v);
  }
  __device__ __forceinline__ void st8(int m, int n, f32x4 a, f32x4 b) const {
    if (n < DFF) st_bf8(Pa + (size_t)m * DFF + n, a, b); else st_bf8(Pv + (size_t)m * DFF + (n - DFF), a, b);
  } };
struct EpiResid { float* x; const float* g;
  __device__ __forceinline__ void operator()(int m, int n, f32x4 v) const {
    const int cond = (m < T_CTX) ? 0 : 1 + ((m - T_CTX) >> 12);
    const f32x4 gv = *(const f32x4*)(g + cond * 6144 + n);
    f32x4* d = (f32x4*)(x + (size_t)m * DM + n);
    f32x4 o = *d; o += gv * v; *d = o;
  } };

__device__ __forceinline__ void ph_ssm_pre(const P& p, int j) {
  const int tid = tidw(p.wq);
  const int gtid = blockIdx.x * NT + tid, gsz = gridDim.x * NT;
  const float* cw = p.ssm_conv_w + (size_t)j * 3 * 4096; const float* cb = p.ssm_conv_b + (size_t)j * 4096;
  const int per = (T_TOK + (int)gridDim.x - 1) / (int)gridDim.x;
  const int tbeg = (int)blockIdx.x * per, tend = (tbeg + per < T_TOK) ? tbeg + per : T_TOK;
  {
    const int c = tid * 8;
    float w[3][8], bias[8];
#pragma unroll
    for (int k = 0; k < 3; ++k) { const f32x4 w0 = *(const f32x4*)(cw + k * 4096 + c), w1 = *(const f32x4*)(cw + k * 4096 + c + 4);
      w[k][0] = w0[0]; w[k][1] = w0[1]; w[k][2] = w0[2]; w[k][3] = w0[3]; w[k][4] = w1[0]; w[k][5] = w1[1]; w[k][6] = w1[2]; w[k][7] = w1[3]; }
    { const f32x4 b0 = *(const f32x4*)(cb + c), b1 = *(const f32x4*)(cb + c + 4);
      bias[0] = b0[0]; bias[1] = b0[1]; bias[2] = b0[2]; bias[3] = b0[3]; bias[4] = b1[0]; bias[5] = b1[1]; bias[6] = b1[2]; bias[7] = b1[3]; }
    const u32x4 z4 = {0u, 0u, 0u, 0u};
    for (int t = tbeg; t < tend; t += 4) {
      int t0, L, cond; tok_info(t, t0, L, cond);
      const int pos = t - t0;
      const bf16_t* srcp = p.Pxbc + (size_t)t * 4096 + c;
      u32x4 X[6];
#pragma unroll
      for (int jx = 0; jx < 6; ++jx) X[jx] = (pos + jx - 1 >= 0 && pos + jx - 1 < L) ? *(const u32x4*)(srcp + (jx - 1) * 4096) : z4;
#pragma unroll
      for (int k = 0; k < 4; ++k) {
        u32x4 o;
#pragma unroll
        for (int q = 0; q < 4; ++q) {
          const float v0 = bias[2 * q] + w[0][2 * q] * bflo(X[k][q]) + w[1][2 * q] * bflo(X[k + 1][q]) + w[2][2 * q] * bflo(X[k + 2][q]);
          const float v1 = bias[2 * q + 1] + w[0][2 * q + 1] * bfhi(X[k][q]) + w[1][2 * q + 1] * bfhi(X[k + 1][q]) + w[2][2 * q + 1] * bfhi(X[k + 2][q]);
          o[q] = pack2(silu_f(v0), silu_f(v1));
        }
        *(u32x4*)(p.A + (size_t)(t + k) * 4096 + c) = o;
      }
    }
  }
  for (int it = gtid; it < T_TOK * 64; it += gsz) {
    const int t = it >> 6, dh = it & 63;
    const float raw = p.small[(size_t)t * 64 + dh];
    const float dt = softplus_f(raw + p.ssm_dt_bias[j * 64 + dh]);
    const float la = -__expf(p.ssm_a_log[j * 64 + dh]) * dt;
    p.small2[(size_t)t * 128 + dh] = dt; p.small2[(size_t)t * 128 + 64 + dh] = la;
  }
}

__device__ __forceinline__ void ph_ssm_tiles(const P& p, int j, unsigned char* shm) {
  const int tid = tidw(p.wq), wave = tid >> 6, lane = tid & 63;
  bf16_t* Bs = (bf16_t*)shm;
  bf16_t* Xs = Bs + 64 * 136;
  bf16_t* Cs = Xs + 64 * 264;
  const float* cw = p.ssm_conv_w + (size_t)j * 3 * 4096; const float* cb = p.ssm_conv_b + (size_t)j * 4096;
  const int cgi = tid & 63, to = tid >> 6;
  const u32x4 z4 = {0u, 0u, 0u, 0u};
#define SSM_LOADX(itm_) do { const int g_ = (itm_) & 7, tk0_ = ((itm_) >> 3) * 64; \
      const int chg_ = (cgi < 32) ? (g_ * 256 + cgi * 8) : ((cgi < 48) ? (2048 + g_ * 128 + (cgi - 32) * 8) : (3072 + g_ * 128 + (cgi - 48) * 8)); \
      int t0_, L_, cond_; tok_info(tk0_, t0_, L_, cond_); const int posb_ = tk0_ - t0_ + 8 * to - 1; \
      const bf16_t* srcp_ = p.Pxbc + (size_t)(tk0_ + 8 * to - 1) * 4096 + chg_; \
      _Pragma("unroll") for (int r = 0; r < 10; ++r) X[r] = (posb_ + r >= 0 && posb_ + r < L_) ? *(const u32x4*)(srcp_ + (size_t)r * 4096) : z4; } while (0)
  u32x4 X[10];
  if ((int)blockIdx.x < 192 * 8) SSM_LOADX((int)blockIdx.x);
  float w[3][8], bias[8]; int gcur = -1;
  for (int item = blockIdx.x; item < 192 * 8; item += gridDim.x) {
    const int c = item >> 3, g = item & 7, tok0 = c * 64;
    const int sr_ = wave & 3, sdir_ = wave >> 2, shead_ = g * 4 + sr_, stk_ = sdir_ ? 63 - lane : lane;
    const float raw_pre = p.small[(size_t)(tok0 + stk_) * 64 + sdir_ * 32 + shead_];
    {
      const int chg = (cgi < 32) ? (g * 256 + cgi * 8) : ((cgi < 48) ? (2048 + g * 128 + (cgi - 32) * 8) : (3072 + g * 128 + (cgi - 48) * 8));
      bf16_t* ld = (cgi < 32) ? (Xs + cgi * 8) : ((cgi < 48) ? (Bs + (cgi - 32) * 8) : (Cs + (cgi - 48) * 8));
      const int lstride = (cgi < 32) ? 264 : 136;
      if (g != gcur) {
        gcur = g;
#pragma unroll
        for (int k = 0; k < 3; ++k) { const f32x4 w0 = *(const f32x4*)(cw + k * 4096 + chg), w1 = *(const f32x4*)(cw + k * 4096 + chg + 4);
          w[k][0] = w0[0]; w[k][1] = w0[1]; w[k][2] = w0[2]; w[k][3] = w0[3]; w[k][4] = w1[0]; w[k][5] = w1[1]; w[k][6] = w1[2]; w[k][7] = w1[3]; }
        { const f32x4 b0 = *(const f32x4*)(cb + chg), b1 = *(const f32x4*)(cb + chg + 4);
          bias[0] = b0[0]; bias[1] = b0[1]; bias[2] = b0[2]; bias[3] = b0[3]; bias[4] = b1[0]; bias[5] = b1[1]; bias[6] = b1[2]; bias[7] = b1[3]; }
      }
      u32x4 oo[8];
#pragma unroll
      for (int k = 0; k < 8; ++k) {
#pragma unroll
        for (int q = 0; q < 4; ++q) {
          const float v0 = bias[2 * q] + w[0][2 * q] * bflo(X[k][q]) + w[1][2 * q] * bflo(X[k + 1][q]) + w[2][2 * q] * bflo(X[k + 2][q]);
          const float v1 = bias[2 * q + 1] + w[0][2 * q + 1] * bfhi(X[k][q]) + w[1][2 * q + 1] * bfhi(X[k + 1][q]) + w[2][2 * q + 1] * bfhi(X[k + 2][q]);
          oo[k][q] = pack2(silu_f(v0), silu_f(v1));
        }
      }
      { const int nxt = item + (int)gridDim.x; if (nxt < 192 * 8) SSM_LOADX(nxt); }
#pragma unroll
      for (int k = 0; k < 8; ++k) {
        if (cgi >= 48) *(u32x4*)(p.A + (size_t)(tok0 + 8 * to + k) * 4096 + chg) = oo[k];
        *(u32x4*)(ld + (8 * to + k) * lstride) = oo[k];
      }
    }
    __syncthreads();
    bf16_t* BTt = p.BT + (size_t)item * 8192;
    for (int q = tid; q < 1024; q += NT) { const int n = q >> 3, cc = q & 7;
      unsigned short v[8];
#pragma unroll
      for (int qq = 0; qq < 8; ++qq) v[qq] = Bs[kperm(cc * 8 + qq) * 136 + n];
      u32x4 o = {(unsigned)v[0] | ((unsigned)v[1] << 16), (unsigned)v[2] | ((unsigned)v[3] << 16), (unsigned)v[4] | ((unsigned)v[5] << 16), (unsigned)v[6] | ((unsigned)v[7] << 16)};
      *(u32x4*)(BTt + n * 64 + cc * 8) = o; }
    bf16_t* XTt = p.XT + (size_t)(c * 32 + g * 4) * 4096;
    for (int q = tid; q < 2048; q += NT) { const int ch = q >> 3, cc = q & 7;
      unsigned short v[8];
#pragma unroll
      for (int qq = 0; qq < 8; ++qq) v[qq] = Xs[kperm(cc * 8 + qq) * 264 + ch];
      u32x4 o = {(unsigned)v[0] | ((unsigned)v[1] << 16), (unsigned)v[2] | ((unsigned)v[3] << 16), (unsigned)v[4] | ((unsigned)v[5] << 16), (unsigned)v[6] | ((unsigned)v[7] << 16)};
      *(u32x4*)(XTt + ch * 64 + cc * 8) = o; }
    if (wave < 4) {
      const int ti = wave >> 1, tj = wave & 1, col = lane & 31, h = lane >> 5;
      f32x16 acc;
#pragma unroll
      for (int r = 0; r < 16; ++r) acc[r] = 0.f;
      const bf16_t* cp = Cs + (32 * ti + col) * 136 + 8 * h;
      const bf16_t* bp = Bs + (32 * tj + col) * 136 + 8 * h;
#pragma unroll
      for (int s = 0; s < 8; ++s) { const bf16x8 a = *(const bf16x8*)(cp + 16 * s), b = *(const bf16x8*)(bp + 16 * s); acc = MFMA32(a, b, acc); }
      bf16_t* Gt = p.Gm + (size_t)item * 4096;
#pragma unroll
      for (int r = 0; r < 16; ++r) { const int i = 32 * ti + (r & 3) + 8 * (r >> 2) + 4 * h; Gt[i * 64 + kperm(32 * tj + col)] = f2bf(acc[r]); }
    }
    {
      const int r = wave & 3, dir = wave >> 2, head = g * 4 + r, tk = dir ? 63 - lane : lane;
      const float dt = softplus_f(raw_pre + p.ssm_dt_bias[j * 64 + dir * 32 + head]);
      const float la = -__expf(p.ssm_a_log[j * 64 + dir * 32 + head]) * dt;
      const float cs = wave_scan_incl(la);
      const float tot = __builtin_bit_cast(float, __builtin_amdgcn_readlane(__builtin_bit_cast(int, cs), 63));
      float* vec = p.VEC + ((size_t)(c * 32 + head) * 2 + dir) * 192;
      vec[tk] = cs; vec[64 + tk] = __logf(dt) - cs; vec[128 + tk] = dt * __expf(tot - cs);
    }
    __syncthreads();
  }
}

__device__ __forceinline__ void put4(f32x16& v, int k, u32x4 x) { v[4 * k] = __uint_as_float(x[0]); v[4 * k + 1] = __uint_as_float(x[1]); v[4 * k + 2] = __uint_as_float(x[2]); v[4 * k + 3] = __uint_as_float(x[3]); }
__device__ __forceinline__ u32x4 get4(const f32x16& v, int k) { u32x4 x = {__float_as_uint(v[4 * k]), __float_as_uint(v[4 * k + 1]), __float_as_uint(v[4 * k + 2]), __float_as_uint(v[4 * k + 3])}; return x; }
__device__ __forceinline__ u32x4 scale8(u32x4 x, float f0, float f1, float f2, float f3, float f4, float f5, float f6, float f7) {
  u32x4 o = {cvt2(bflo(x[0]) * f0, bfhi(x[0]) * f1), cvt2(bflo(x[1]) * f2, bfhi(x[1]) * f3), cvt2(bflo(x[2]) * f4, bfhi(x[2]) * f5), cvt2(bflo(x[3]) * f6, bfhi(x[3]) * f7)};
  return o;
}
__device__ __forceinline__ int grp_pos_bytes(int G) { const int w = G & 3; return ((G & ~3) | (((w & 1) << 1) | (w >> 1))) * 8; }
#define SSM_OFF_Q 0
#define SSM_OFF_BT 17408
#define SSM_OFF_M 35840
#define SSM_OFF_W 45056
#define SSM_BUF 45568
#define SSM_OFF_SB (2 * SSM_BUF)
__device__ __forceinline__ void ph_ssm_chain(const P& p, int j, lds_u8* lds) {
  const int tid = tidw(p.wq), wave = __builtin_amdgcn_readfirstlane(tid >> 6), lane = tid & 63, col = lane & 31, h = lane >> 5;
  float* out_state = p.out + (size_t)T_TOK * DM;
  const int nlat = 128, nitem = 1152, G = (int)gridDim.x;
  const int stride = ((int)blockIdx.x < nlat) ? nitem : (G - nlat);
  for (int item = (int)blockIdx.x; item < nitem; item += stride) {
    int seq, dir, head;
    if (item < 128) { const int x = item & 7, k = item >> 3, cmb = x * 4 + (k >> 2); seq = 16 + (cmb >> 4); dir = (cmb >> 3) & 1; head = (cmb & 7) * 4 + (k & 3); }
    else { const int i2 = item - 128, x = i2 & 7, kk = i2 >> 3, cmb = (kk >> 2) * 8 + x; seq = cmb >> 4; dir = (cmb >> 3) & 1; head = (cmb & 7) * 4 + (kk & 3); }
    int chunk0, nch; if (seq < 16) { chunk0 = seq * 4; nch = 4; } else { chunk0 = 64 + (seq - 16) * 64; nch = 64; }
    const int g = head >> 2;
    const float dskip = dir ? 0.f : p.ssm_d[j * 32 + head];
#define SSM_MPIECE(gq_, cs_i_, aj_, ii_, c8_) do { float m_[8]; \
      const int jb_ = 16 * ((c8_) >> 1) + 4 * ((c8_) & 1); \
      _Pragma("unroll") for (int e = 0; e < 8; ++e) { const int jj = jb_ + (e & 3) + 8 * (e >> 2); \
        const float gv = (e & 1) ? bfhi((gq_)[e >> 1]) : bflo((gq_)[e >> 1]); \
        const float val = gv * __expf((cs_i_) + (aj_)[e]); const bool keep = dir ? (jj >= (ii_)) : (jj <= (ii_)); m_[e] = (keep ? val : 0.f) + ((jj == (ii_)) ? dskip : 0.f); } \
      const u32x4 mo_ = {cvt2(m_[0], m_[1]), cvt2(m_[2], m_[3]), cvt2(m_[4], m_[5]), cvt2(m_[6], m_[7])}; \
      *(LAS u32x4*)(buf + SSM_OFF_M + (ii_) * 144 + (c8_) * 16) = mo_; } while (0)
    if (wave >= 4) {
      const int ltid = tid - 256, lrow = ltid >> 4, lc16 = ltid & 15, lc8 = ltid & 7, grow = ltid >> 3;
      const unsigned lo_c = (unsigned)(((ltid >> 4) * 4096 + (ltid & 15) * 8) * 2), lo_t = (unsigned)(ltid * 16);
      u32x4 RCc[2][4], RB[2][4], RG[2], RG2[2]; float RS[2][16];
#define SSM_LLOAD(set, stepn) do { const int c_ = chunk0 + (dir ? nch - 1 - (stepn) : (stepn)); \
        const char* Cb_ = (const char*)(p.A + (size_t)c_ * 64 * 4096 + 3072 + g * 128); const char* BTt_ = (const char*)(p.BT + (size_t)(c_ * 8 + g) * 8192); \
        const char* Gt_ = (const char*)(p.Gm + (size_t)(c_ * 8 + g) * 4096); const float* v0_ = p.VEC + ((size_t)(c_ * 32 + head) * 2 + dir) * 192; \
        _Pragma("unroll") for (int i = 0; i < 4; ++i) { RCc[set][i] = *(const u32x4*)(Cb_ + i * 131072 + lo_c); RB[set][i] = *(const u32x4*)(BTt_ + i * 4096 + lo_t); RS[set][i] = v0_[lrow + 16 * i]; } \
        RG[set] = *(const u32x4*)(Gt_ + lo_t); RG2[set] = *(const u32x4*)(Gt_ + 4096 + lo_t); RS[set][4] = v0_[grow]; RS[set][7] = v0_[32 + grow]; RS[set][5] = v0_[dir ? 0 : 63]; RS[set][6] = v0_[128 + (ltid & 63)]; \
        { const int ao_ = 64 + 16 * (lc8 >> 1) + 4 * (lc8 & 1); const f32x4 a0_ = *(const f32x4*)(v0_ + ao_), a1_ = *(const f32x4*)(v0_ + ao_ + 8); \
          _Pragma("unroll") for (int e = 0; e < 4; ++e) { RS[set][8 + e] = a0_[e]; RS[set][12 + e] = a1_[e]; } } } while (0)
#define SSM_LWRITE(set, bufi) do { lds_u8* buf = lds + (bufi) * SSM_BUF; \
        const int p0 = grp_pos_bytes(2 * lc16), p1 = grp_pos_bytes(2 * lc16 + 1); \
        _Pragma("unroll") for (int i = 0; i < 4; ++i) { const int row = lrow + 16 * i; const float e0 = __expf(RS[set][i]); \
          const u32x4 q0 = scale8(RCc[set][i], e0, e0, e0, e0, e0, e0, e0, e0); \
          *(LAS u32x2*)(buf + SSM_OFF_Q + row * 272 + p0) = (u32x2){q0[0], q0[1]}; \
          *(LAS u32x2*)(buf + SSM_OFF_Q + row * 272 + p1) = (u32x2){q0[2], q0[3]}; \
          const int q = ltid + 256 * i; *(LAS u32x4*)(buf + SSM_OFF_BT + (q >> 3) * 144 + (q & 7) * 16) = RB[set][i]; } \
        SSM_MPIECE(RG[set], RS[set][4], (&RS[set][8]), grow, lc8); SSM_MPIECE(RG2[set], RS[set][7], (&RS[set][8]), 32 + grow, lc8); \
        if (ltid < 64) { LAS float* wv = (LAS float*)(buf + SSM_OFF_W); wv[ltid] = RS[set][6]; if (ltid == 0) wv[64] = __expf(RS[set][5]); } } while (0)
      SSM_LLOAD(0, 0);
      if (nch > 1) SSM_LLOAD(1, 1);
      for (int it = 0; it <= nch; it += 2) {
        if (it < nch) SSM_LWRITE(0, 0);
        if (it + 2 < nch) SSM_LLOAD(0, it + 2);
        CH_BARRIER();
        if (it + 1 <= nch) {
          if (it + 1 < nch) SSM_LWRITE(1, 1);
          if (it + 3 < nch) SSM_LLOAD(1, it + 3);
          CH_BARRIER();
        }
      }
    } else {
      const int ph = wave & 1, ecol = ph * 32 + col;
      const bool is_state = wave < 2;
      LAS unsigned char* sbw = (LAS unsigned char*)lds + SSM_OFF_SB + ph * 8192 + lane * 16;
      bf16x8 xf[2][4];
#define SSM_LOADXF(set, stepn) do { const int cx_ = chunk0 + (dir ? nch - 1 - (stepn) : (stepn)); \
        const bf16_t* XTt_ = p.XT + (size_t)(cx_ * 32 + head) * 4096 + ecol * 64 + 8 * h; \
        _Pragma("unroll") for (int s = 0; s < 4; ++s) xf[set][s] = *(const bf16x8*)(XTt_ + 16 * s); } while (0)
      if (is_state) {
        f32x16 S[4];
        if (seq >= 16) {
          const float* s = p.state_ssm + ((((size_t)(seq - 16) * 2 + j) * 2 + dir) * 32 + head) * 8192 + ecol;
#pragma unroll
          for (int db = 0; db < 4; ++db)
#pragma unroll
            for (int r = 0; r < 16; ++r) S[db][r] = s[(32 * db + (r & 3) + 8 * (r >> 2) + 4 * h) * 64];
        } else {
#pragma unroll
          for (int db = 0; db < 4; ++db)
#pragma unroll
            for (int r = 0; r < 16; ++r) S[db][r] = 0.f;
        }
#define SSM_PUBLISH(slot) do { _Pragma("unroll") for (int db = 0; db < 4; ++db) { \
          *(LAS bf16x8*)(sbw + (slot) * 16384 + (2 * db) * 1024) = pack_half(S[db], 0); *(LAS bf16x8*)(sbw + (slot) * 16384 + (2 * db + 1) * 1024) = pack_half(S[db], 1); } } while (0)
#define SSM_SSTEP(set, stepn) do { const int step = (stepn); \
          const lds_u8* buf = lds + (step & 1) * SSM_BUF; const LAS float* wv = (const LAS float*)(buf + SSM_OFF_W); \
          const float dec = wv[64]; bf16x8 xw[4]; \
          _Pragma("unroll") for (int s = 0; s < 4; ++s) { \
            const f32x4 wlo = *(const LAS f32x4*)(wv + 16 * s + 4 * h), whi = *(const LAS f32x4*)(wv + 16 * s + 8 + 4 * h); \
            const u32x4 xq = __builtin_bit_cast(u32x4, xf[set][s]); \
            xw[s] = mk8(cvt2(bflo(xq[0]) * wlo[0], bfhi(xq[0]) * wlo[1]), cvt2(bflo(xq[1]) * wlo[2], bfhi(xq[1]) * wlo[3]), \
                        cvt2(bflo(xq[2]) * whi[0], bfhi(xq[2]) * whi[1]), cvt2(bflo(xq[3]) * whi[2], bfhi(xq[3]) * whi[3])); } \
          if (step + 2 < nch) SSM_LOADXF(set, step + 2); \
          _Pragma("unroll") for (int db = 0; db < 4; ++db) _Pragma("unroll") for (int r = 0; r < 16; ++r) S[db][r] *= dec; \
          _Pragma("unroll") for (int sp = 0; sp < 2; ++sp) { bf16x8 kb[4][2]; \
            _Pragma("unroll") for (int db = 0; db < 4; ++db) _Pragma("unroll") for (int s2 = 0; s2 < 2; ++s2) \
              kb[db][s2] = *(const LAS bf16x8*)(buf + SSM_OFF_BT + (32 * db + col) * 144 + 32 * (2 * sp + s2) + 16 * h); \
            _Pragma("unroll") for (int s2 = 0; s2 < 2; ++s2) _Pragma("unroll") for (int db = 0; db < 4; ++db) S[db] = MFMA32(kb[db][s2], xw[2 * sp + s2], S[db]); } \
          if (step + 1 < nch) SSM_PUBLISH((step + 1) & 1); } while (0)
        SSM_LOADXF(0, 0);
        if (nch > 1) SSM_LOADXF(1, 1);
        SSM_PUBLISH(0);
        __builtin_amdgcn_s_setprio(3);
        for (int it = 0; it <= nch; it += 2) {
          if (it >= 1) SSM_SSTEP(1, it - 1);
          CH_BARRIER();
          if (it + 1 <= nch) { SSM_SSTEP(0, it); CH_BARRIER(); }
        }
        __builtin_amdgcn_s_setprio(0);
        if (seq < 16) {
          float* d = out_state + ((((size_t)seq * 2 + j) * 2 + dir) * 32 + head) * 8192 + ecol;
#pragma unroll
          for (int db = 0; db < 4; ++db)
#pragma unroll
            for (int r = 0; r < 16; ++r) d[(32 * db + (r & 3) + 8 * (r >> 2) + 4 * h) * 64] = S[db][r];
        }
      } else {
#define SSM_OSTEP(set, stepn) do { const int step = (stepn); \
          const int c = chunk0 + (dir ? nch - 1 - step : step), tok0 = c * 64; \
          const lds_u8* buf = lds + (step & 1) * SSM_BUF; const lds_u8* Qb = buf + SSM_OFF_Q; const lds_u8* Mb = buf + SSM_OFF_M; \
          bf16x8 Sb[8]; \
          _Pragma("unroll") for (int f = 0; f < 8; ++f) Sb[f] = *(const LAS bf16x8*)(sbw + (step & 1) * 16384 + f * 1024); \
          bf16_t* Yb = p.Pxbc + ((size_t)dir * T_TOK + tok0) * 2048 + head * 64 + ecol + 4 * h * 2048; \
          f32x16 Oa[2]; \
          _Pragma("unroll") for (int t = 0; t < 2; ++t) _Pragma("unroll") for (int r = 0; r < 16; ++r) Oa[t][r] = 0.f; \
          _Pragma("unroll") for (int sg = 0; sg < 2; ++sg) { bf16x8 qa[2][4]; \
            _Pragma("unroll") for (int t = 0; t < 2; ++t) _Pragma("unroll") for (int s2 = 0; s2 < 4; ++s2) qa[t][s2] = *(const LAS bf16x8*)(Qb + (32 * t + col) * 272 + 32 * (4 * sg + s2) + 16 * h); \
            _Pragma("unroll") for (int s2 = 0; s2 < 4; ++s2) { Oa[0] = MFMA32(qa[0][s2], Sb[4 * sg + s2], Oa[0]); Oa[1] = MFMA32(qa[1][s2], Sb[4 * sg + s2], Oa[1]); } } \
          { bf16x8 ma[2][4]; \
            _Pragma("unroll") for (int t = 0; t < 2; ++t) _Pragma("unroll") for (int s = 0; s < 4; ++s) ma[t][s] = *(const LAS bf16x8*)(Mb + (32 * t + col) * 144 + 32 * s + 16 * h); \
            _Pragma("unroll") for (int s = 0; s < 4; ++s) { Oa[0] = MFMA32(ma[0][s], xf[set][s], Oa[0]); Oa[1] = MFMA32(ma[1][s], xf[set][s], Oa[1]); } } \
          if (step + 2 < nch) SSM_LOADXF(set, step + 2); \
          _Pragma("unroll") for (int t = 0; t < 2; ++t) _Pragma("unroll") for (int r = 0; r < 16; r += 2) { \
            const unsigned pk = cvt2(Oa[t][r], Oa[t][r + 1]); \
            Yb[(size_t)(32 * t + (r & 3) + 8 * (r >> 2)) * 2048] = (bf16_t)(pk & 0xffffu); \
            Yb[(size_t)(32 * t + ((r + 1) & 3) + 8 * ((r + 1) >> 2)) * 2048] = (bf16_t)(pk >> 16); } } while (0)
        SSM_LOADXF(0, 0);
        if (nch > 1) SSM_LOADXF(1, 1);
        for (int it = 0; it <= nch; it += 2) {
          if (it >= 1) SSM_OSTEP(1, it - 1);
          CH_BARRIER();
          if (it + 1 <= nch) { SSM_OSTEP(0, it); CH_BARRIER(); }
        }
      }
    }
  }
}

__device__ __forceinline__ void ph_ssm_post(const P& p, int j) {
  const int wave = tidw(p.wq) >> 6, lane = tidw(p.wq) & 63;
  const int gw = blockIdx.x * 8 + wave, nwv = gridDim.x * 8;
  const bf16_t* Y = p.Pxbc;
  const float* nw = p.ssm_norm_w + (size_t)j * 2048; const float* dsk = p.ssm_d + j * 32;
  for (int it4 = gw; it4 < T_TOK * 2; it4 += nwv) {
    const int t = it4 >> 1, g0 = (it4 & 1) * 4;
    u32x2 yf[4], yb[4], z[4];
#pragma unroll
    for (int k = 0; k < 4; ++k) {
      const int c = (g0 + k) * 256 + lane * 4;
      yf[k] = *(const u32x2*)(Y + (size_t)t * 2048 + c);
      yb[k] = *(const u32x2*)(Y + ((size_t)T_TOK + t) * 2048 + c);
      z[k] = *(const u32x2*)(p.Pz + (size_t)t * 2048 + c);
    }
#pragma unroll
    for (int k = 0; k < 4; ++k) {
      const int c = (g0 + k) * 256 + lane * 4;
      float v[4];
      v[0] = (bflo(yf[k][0]) + bflo(yb[k][0])) * silu_f(bflo(z[k][0]));
      v[1] = (bfhi(yf[k][0]) + bfhi(yb[k][0])) * silu_f(bfhi(z[k][0]));
      v[2] = (bflo(yf[k][1]) + bflo(yb[k][1])) * silu_f(bflo(z[k][1]));
      v[3] = (bfhi(yf[k][1]) + bfhi(yb[k][1])) * silu_f(bfhi(z[k][1]));
      const float ss = wave_sum(v[0] * v[0] + v[1] * v[1] + v[2] * v[2] + v[3] * v[3]);
      const float rstd = rsqrtf(ss * (1.f / 256.f) + EPS);
      const f32x4 w = *(const f32x4*)(nw + c);
      u32x2 o; o[0] = pack2(v[0] * rstd * w[0], v[1] * rstd * w[1]); o[1] = pack2(v[2] * rstd * w[2], v[3] * rstd * w[3]);
      *(u32x2*)(p.H + (size_t)t * 2048 + c) = o;
    }
  }
}

__device__ __forceinline__ void ph_gla_pre(const P& p) {
  const int tid = tidw(p.wq);
  float* G = (float*)p.Pxbc;
  const int per = (T_TOK + (int)gridDim.x - 1) / (int)gridDim.x;
  const int tbeg = (int)blockIdx.x * per, tend = (tbeg + per < T_TOK) ? tbeg + per : T_TOK;
#pragma unroll 1
  for (int half = 0; half < 2; ++half) {
    const int idx = half * NT + tid, e = idx >> 9, kk = idx & 511;
    float w2[16];
#pragma unroll
    for (int r = 0; r < 16; ++r) w2[r] = p.gla_gate_w2[(size_t)e * 16 * 512 + r * 512 + kk];
    const float gb = p.gla_gate_b[e * 512 + kk];
    for (int t = tbeg; t < tend; t += 4) {
      f32x4 lr[4][4];
#pragma unroll
      for (int k = 0; k < 4; ++k)
#pragma unroll
        for (int q = 0; q < 4; ++q) lr[k][q] = *(const f32x4*)(p.small + (size_t)(t + k) * 64 + e * 16 + q * 4);
#pragma unroll
      for (int k = 0; k < 4; ++k) {
        float s = gb;
#pragma unroll
        for (int q = 0; q < 4; ++q) s += lr[k][q][0] * w2[4 * q] + lr[k][q][1] * w2[4 * q + 1] + lr[k][q][2] * w2[4 * q + 2] + lr[k][q][3] * w2[4 * q + 3];
        G[(size_t)(t + k) * 1024 + idx] = -softplus_f(-s) * (1.f / 16.f);
      }
    }
  }
}


template <int DIR>
__device__ __forceinline__ void gla_scan1(const bf16_t* Qr, const bf16_t* Kr, bf16_t* Qs, bf16_t* Ks, bf16_t* qpt, const float (&lgv)[32], float cs, int half, int d) {
  const int ib = DIR ? 63 - 32 * half : 32 * half;
  const bf16_t* qr = Qr + ib * 136 + d; const bf16_t* kr = Kr + ib * 136 + d;
  bf16_t* qs = Qs + (DIR * 64 + ib) * 136 + d; bf16_t* ks = Ks + (DIR * 64 + ib) * 136 + d; bf16_t* qg = qpt + ib * 128;
#pragma unroll
  for (int k = 0; k < 32; ++k) { const int o = DIR ? -k : k;
    cs += lgv[k];
    const float e = __expf(cs);
    const unsigned pk = cvt2(bf2f(qr[o * 136]) * e, bf2f(kr[o * 136]) * __builtin_amdgcn_rcpf(e));
    const bf16_t qb = (bf16_t)(pk & 0xffffu);
    qs[o * 136] = qb; qg[o * 128] = qb; ks[o * 136] = (bf16_t)(pk >> 16); }
}
template <int DIR>
__device__ __forceinline__ void gla_scan2(const bf16_t* Kr, bf16_t* Ks, const float (&lgv)[32], float cs, float cs_tot, int half, int d) {
  const int ib = DIR ? 63 - 32 * half : 32 * half;
  const bf16_t* kr = Kr + ib * 136 + d; bf16_t* ks = Ks + (DIR * 64 + ib) * 136 + d;
#pragma unroll
  for (int k = 0; k < 32; ++k) { const int o = DIR ? -k : k;
    cs += lgv[k];
    ks[o * 136] = f2bf(bf2f(kr[o * 136]) * __expf(cs_tot - cs)); }
}
template <int DIR>
__device__ __forceinline__ void gla_load_lg(const float* lgp  , float (&lga)[64]) {
#pragma unroll
  for (int s = 0; s < 64; ++s) lga[s] = lgp[(DIR ? -s : s) * 1024];
}
__device__ __forceinline__ void ph_gla_tiles(const P& p, unsigned char* shm) {
  const int tid = tidw(p.wq), wave = tid >> 6, lane = tid & 63;
  bf16_t* Qs = (bf16_t*)shm;
  bf16_t* Ks = Qs + 2 * 64 * 136;
  bf16_t* Vs = Ks + 2 * 64 * 136;
  bf16_t* Qr = Vs + 64 * 264;
  bf16_t* Kr = Qr + 64 * 136;
  const float* LG = (const float*)p.Pxbc;
  bf16_t* QP = p.H; bf16_t* KWT = p.H + (size_t)1536 * 8192; bf16_t* AI = p.H + (size_t)2 * 1536 * 8192;
  const int dir = __builtin_amdgcn_readfirstlane((tid >> 7) & 1), half = __builtin_amdgcn_readfirstlane(tid >> 8);
  for (int item = blockIdx.x; item < 192 * 4; item += gridDim.x) {
    const int c = item >> 2, hd = item & 3, tok0 = c * 64;
    int d = tid & 127; asm volatile("" : "+v"(d));
    float lgv[32]; float cs_start = 0.f, cs_tot = 0.f;
    {
      float lga[64];
      { const float* lgp = LG + (size_t)(tok0 + (dir ? 63 : 0)) * 1024 + dir * 512 + hd * 128 + d;
        if (dir) gla_load_lg<1>(lgp, lga); else gla_load_lg<0>(lgp, lga); }
      for (int q = tid; q < 2048; q += NT) { const int row = q >> 5, c16 = q & 31;
        *(u32x4*)(Vs + row * 264 + c16 * 8) = *(const u32x4*)(p.A + (size_t)(tok0 + row) * 2048 + 1024 + hd * 256 + c16 * 8); }
      for (int q = tid; q < 1024; q += NT) { const int row = q >> 4, c16 = q & 15;
        *(u32x4*)(Qr + row * 136 + c16 * 8) = *(const u32x4*)(p.A + (size_t)(tok0 + row) * 2048 + hd * 128 + c16 * 8);
        *(u32x4*)(Kr + row * 136 + c16 * 8) = *(const u32x4*)(p.A + (size_t)(tok0 + row) * 2048 + 512 + hd * 128 + c16 * 8); }
      float acc = 0.f;
#pragma unroll
      for (int s = 0; s < 64; ++s) { if (s == 32) cs_start = half ? acc : 0.f; acc += lga[s]; }
      cs_tot = acc;
#pragma unroll
      for (int k = 0; k < 32; ++k) lgv[k] = half ? lga[32 + k] : lga[k];
    }
    __syncthreads();
    {
      bf16_t* qpt = QP + (size_t)(item * 2 + dir) * 8192 + kperm(d);
      if (dir) gla_scan1<1>(Qr, Kr, Qs, Ks, qpt, lgv, cs_start, half, d); else gla_scan1<0>(Qr, Kr, Qs, Ks, qpt, lgv, cs_start, half, d);
      if (half == 0) p.VEC[(size_t)(item * 2 + dir) * 128 + d] = __expf(cs_tot);
    }
    __syncthreads();
    {
      const int dirw = wave >> 2, ti = (wave >> 1) & 1, tj = wave & 1, col = lane & 31, h = lane >> 5;
      f32x16 acc;
#pragma unroll
      for (int r = 0; r < 16; ++r) acc[r] = 0.f;
      const bf16_t* ap = Qs + (dirw * 64 + 32 * ti + col) * 136 + 8 * h;
      const bf16_t* bp = Ks + (dirw * 64 + 32 * tj + col) * 136 + 8 * h;
#pragma unroll
      for (int s = 0; s < 8; ++s) acc = MFMA32(*(const bf16x8*)(ap + 16 * s), *(const bf16x8*)(bp + 16 * s), acc);
      bf16_t* At = AI + (size_t)(item * 2 + dirw) * 4096;
      const int jj = 32 * tj + col;
#pragma unroll
      for (int r = 0; r < 16; ++r) { const int i = 32 * ti + (r & 3) + 8 * (r >> 2) + 4 * h;
        const bool keep = dirw ? (jj >= i) : (jj <= i);
        At[i * 64 + kperm(jj)] = keep ? f2bf(acc[r]) : (bf16_t)0; }
    }
    {
      bf16_t* VTt = p.BT + (size_t)item * 16384;
      for (int q = tid; q < 2048; q += NT) { const int e = q >> 3, cc = q & 7;
        unsigned short v[8];
#pragma unroll
        for (int qq = 0; qq < 8; ++qq) v[qq] = Vs[kperm(cc * 8 + qq) * 264 + e];
        u32x4 o = {(unsigned)v[0] | ((unsigned)v[1] << 16), (unsigned)v[2] | ((unsigned)v[3] << 16), (unsigned)v[4] | ((unsigned)v[5] << 16), (unsigned)v[6] | ((unsigned)v[7] << 16)};
        *(u32x4*)(VTt + e * 64 + cc * 8) = o; }
    }
    __syncthreads();
    if (dir) gla_scan2<1>(Kr, Ks, lgv, cs_start, cs_tot, half, d); else gla_scan2<0>(Kr, Ks, lgv, cs_start, cs_tot, half, d);
    __syncthreads();
    for (int q = tid; q < 2048; q += NT) { const int dirq = q >> 10, dd = (q >> 3) & 127, cc = q & 7;
      unsigned short v[8];
#pragma unroll
      for (int qq = 0; qq < 8; ++qq) v[qq] = Ks[(dirq * 64 + kperm(cc * 8 + qq)) * 136 + dd];
      u32x4 o = {(unsigned)v[0] | ((unsigned)v[1] << 16), (unsigned)v[2] | ((unsigned)v[3] << 16), (unsigned)v[4] | ((unsigned)v[5] << 16), (unsigned)v[6] | ((unsigned)v[7] << 16)};
      *(u32x4*)(KWT + (size_t)(item * 2 + dirq) * 8192 + dd * 64 + cc * 8) = o; }
    __syncthreads();
  }
}

#define GLA_OFF_Q 0
#define GLA_OFF_K 17408
#define GLA_OFF_A 35840
#define GLA_OFF_D 45056
#define GLA_BUF 45568
#define GLA_OFF_SB (2 * GLA_BUF)
__device__ __forceinline__ void ph_gla_chain(const P& p, lds_u8* lds) {
  const int tid = tidw(p.wq), wave = __builtin_amdgcn_readfirstlane(tid >> 6), lane = tid & 63, col = lane & 31, h = lane >> 5;
  float* out_state = p.out + (size_t)T_TOK * DM + 16777216;
  const bf16_t* QP = p.H; const bf16_t* KWT = p.H + (size_t)1536 * 8192; const bf16_t* AI = p.H + (size_t)2 * 1536 * 8192;
  const int nlat = 64, nitem = 576, G = (int)gridDim.x;
  const int stride = ((int)blockIdx.x < nlat) ? nitem : (G - nlat);
  for (int item = (int)blockIdx.x; item < nitem; item += stride) {
    int seq, dir, hd, quarter;
    if (item < 64) { const int x = item & 7, k = item >> 3, cmb = (k >> 2) * 8 + x; quarter = k & 3; seq = 16 + (cmb >> 3); dir = (cmb >> 2) & 1; hd = cmb & 3; }
    else { const int i2 = item - 64, x = i2 & 7, kk = i2 >> 3, cmb = (kk >> 2) * 8 + x; quarter = kk & 3; seq = cmb >> 3; dir = (cmb >> 2) & 1; hd = cmb & 3; }
    int chunk0, nch; if (seq < 16) { chunk0 = seq * 4; nch = 4; } else { chunk0 = 64 + (seq - 16) * 64; nch = 64; }
    if (wave >= 4) {
      const int ltid = tid - 256;
      const unsigned lo_t = (unsigned)(ltid * 16);
      u32x4 RQ[2][4], RK[2][4], RA[2][2], RD[2];
#define GLA_LLOAD(set, stepn) do { const int c_ = chunk0 + (dir ? nch - 1 - (stepn) : (stepn)); const size_t tix_ = (size_t)((c_ * 4 + hd) * 2 + dir); \
        const char* Qt_ = (const char*)(QP + tix_ * 8192); const char* Kt_ = (const char*)(KWT + tix_ * 8192); const char* At_ = (const char*)(AI + tix_ * 4096); \
        _Pragma("unroll") for (int i = 0; i < 4; ++i) { RQ[set][i] = *(const u32x4*)(Qt_ + i * 4096 + lo_t); RK[set][i] = *(const u32x4*)(Kt_ + i * 4096 + lo_t); } \
        _Pragma("unroll") for (int i = 0; i < 2; ++i) RA[set][i] = *(const u32x4*)(At_ + i * 4096 + lo_t); \
        if (ltid < 32) RD[set] = *(const u32x4*)(p.VEC + tix_ * 128 + ltid * 4); } while (0)
#define GLA_LWRITE(set, bufi) do { lds_u8* buf = lds + (bufi) * GLA_BUF; \
        _Pragma("unroll") for (int i = 0; i < 4; ++i) { const int q = ltid + 256 * i; \
          *(LAS u32x4*)(buf + GLA_OFF_Q + (q >> 4) * 272 + (q & 15) * 16) = RQ[set][i]; \
          *(LAS u32x4*)(buf + GLA_OFF_K + (q >> 3) * 144 + (q & 7) * 16) = RK[set][i]; } \
        _Pragma("unroll") for (int i = 0; i < 2; ++i) { const int q = ltid + 256 * i; *(LAS u32x4*)(buf + GLA_OFF_A + (q >> 3) * 144 + (q & 7) * 16) = RA[set][i]; } \
        if (ltid < 32) *(LAS u32x4*)(buf + GLA_OFF_D + ltid * 16) = RD[set]; } while (0)
      GLA_LLOAD(0, 0);
      if (nch > 1) GLA_LLOAD(1, 1);
      for (int it = 0; it <= nch; it += 2) {
        if (it < nch) GLA_LWRITE(0, 0);
        if (it + 2 < nch) GLA_LLOAD(0, it + 2);
        CH_BARRIER();
        if (it + 1 <= nch) {
          if (it + 1 < nch) GLA_LWRITE(1, 1);
          if (it + 3 < nch) GLA_LLOAD(1, it + 3);
          CH_BARRIER();
        }
      }
    } else {
      const int ph = wave & 1, ecol = (quarter * 2 + ph) * 32 + col;
      LAS unsigned char* sbw = (LAS unsigned char*)lds + GLA_OFF_SB + ph * 8192 + lane * 16;
      bf16x8 vf[2][4];
#define GLA_LOADVF(set, stepn) do { const int cx_ = chunk0 + (dir ? nch - 1 - (stepn) : (stepn)); \
        const bf16_t* Vt_ = p.BT + (size_t)(cx_ * 4 + hd) * 16384 + ecol * 64 + 8 * h; \
        _Pragma("unroll") for (int s = 0; s < 4; ++s) vf[set][s] = *(const bf16x8*)(Vt_ + 16 * s); } while (0)
      if (wave < 2) {
        f32x16 S[4];
        if (seq >= 16) {
          const float* s = p.state_gla + (((size_t)(seq - 16) * 2 + dir) * 4 + hd) * 32768 + ecol;
#pragma unroll
          for (int db = 0; db < 4; ++db)
#pragma unroll
            for (int r = 0; r < 16; ++r) S[db][r] = s[(32 * db + (r & 3) + 8 * (r >> 2) + 4 * h) * 256];
        } else {
#pragma unroll
          for (int db = 0; db < 4; ++db)
#pragma unroll
            for (int r = 0; r < 16; ++r) S[db][r] = 0.f;
        }
#define GLA_PUBLISH(slot) do { _Pragma("unroll") for (int db = 0; db < 4; ++db) { \
          *(LAS bf16x8*)(sbw + (slot) * 16384 + (2 * db) * 1024) = pack_half(S[db], 0); *(LAS bf16x8*)(sbw + (slot) * 16384 + (2 * db + 1) * 1024) = pack_half(S[db], 1); } } while (0)
#define GLA_SSTEP(set, stepn) do { const int step = (stepn); \
          const lds_u8* buf = lds + (step & 1) * GLA_BUF; const LAS float* dect = (const LAS float*)(buf + GLA_OFF_D); \
          _Pragma("unroll") for (int db = 0; db < 4; ++db) _Pragma("unroll") for (int q = 0; q < 4; ++q) { const f32x4 d4 = *(const LAS f32x4*)(dect + 32 * db + 8 * q + 4 * h); \
            _Pragma("unroll") for (int rr = 0; rr < 4; ++rr) S[db][4 * q + rr] *= d4[rr]; } \
          _Pragma("unroll") for (int sp = 0; sp < 2; ++sp) { bf16x8 kb[4][2]; \
            _Pragma("unroll") for (int db = 0; db < 4; ++db) _Pragma("unroll") for (int s2 = 0; s2 < 2; ++s2) \
              kb[db][s2] = *(const LAS bf16x8*)(buf + GLA_OFF_K + (32 * db + col) * 144 + 32 * (2 * sp + s2) + 16 * h); \
            _Pragma("unroll") for (int s2 = 0; s2 < 2; ++s2) _Pragma("unroll") for (int db = 0; db < 4; ++db) S[db] = MFMA32(kb[db][s2], vf[set][2 * sp + s2], S[db]); } \
          if (step + 2 < nch) GLA_LOADVF(set, step + 2); \
          if (step + 1 < nch) GLA_PUBLISH((step + 1) & 1); } while (0)
        GLA_LOADVF(0, 0);
        if (nch > 1) GLA_LOADVF(1, 1);
        GLA_PUBLISH(0);
        __builtin_amdgcn_s_setprio(3);
        for (int it = 0; it <= nch; it += 2) {
          if (it >= 1) GLA_SSTEP(1, it - 1);
          CH_BARRIER();
          if (it + 1 <= nch) { GLA_SSTEP(0, it); CH_BARRIER(); }
        }
        __builtin_amdgcn_s_setprio(0);
        if (seq < 16) {
          float* d_ = out_state + (((size_t)seq * 2 + dir) * 4 + hd) * 32768 + ecol;
#pragma unroll
          for (int db = 0; db < 4; ++db)
#pragma unroll
            for (int r = 0; r < 16; ++r) d_[(32 * db + (r & 3) + 8 * (r >> 2) + 4 * h) * 256] = S[db][r];
        }
      } else {
#define GLA_OSTEP(set, stepn) do { const int step = (stepn); \
          const int c = chunk0 + (dir ? nch - 1 - step : step), tok0 = c * 64; \
          const lds_u8* buf = lds + (step & 1) * GLA_BUF; \
          bf16x8 Sb[8]; \
          _Pragma("unroll") for (int f = 0; f < 8; ++f) Sb[f] = *(const LAS bf16x8*)(sbw + (step & 1) * 16384 + f * 1024); \
          bf16_t* Ob = p.Pxbc + (size_t)T_TOK * 2048 + ((size_t)dir * T_TOK + tok0) * 1024 + hd * 256 + ecol + 4 * h * 1024; \
          f32x16 Oa[2]; \
          _Pragma("unroll") for (int t = 0; t < 2; ++t) _Pragma("unroll") for (int r = 0; r < 16; ++r) Oa[t][r] = 0.f; \
          _Pragma("unroll") for (int sg = 0; sg < 2; ++sg) { bf16x8 qa[2][4]; \
            _Pragma("unroll") for (int t = 0; t < 2; ++t) _Pragma("unroll") for (int s2 = 0; s2 < 4; ++s2) qa[t][s2] = *(const LAS bf16x8*)(buf + GLA_OFF_Q + (32 * t + col) * 272 + 32 * (4 * sg + s2) + 16 * h); \
            _Pragma("unroll") for (int s2 = 0; s2 < 4; ++s2) { Oa[0] = MFMA32(qa[0][s2], Sb[4 * sg + s2], Oa[0]); Oa[1] = MFMA32(qa[1][s2], Sb[4 * sg + s2], Oa[1]); } } \
          { bf16x8 ma[2][4]; \
            _Pragma("unroll") for (int t = 0; t < 2; ++t) _Pragma("unroll") for (int s = 0; s < 4; ++s) ma[t][s] = *(const LAS bf16x8*)(buf + GLA_OFF_A + (32 * t + col) * 144 + 32 * s + 16 * h); \
            _Pragma("unroll") for (int s = 0; s < 4; ++s) { Oa[0] = MFMA32(ma[0][s], vf[set][s], Oa[0]); Oa[1] = MFMA32(ma[1][s], vf[set][s], Oa[1]); } } \
          if (step + 2 < nch) GLA_LOADVF(set, step + 2); \
          _Pragma("unroll") for (int t = 0; t < 2; ++t) _Pragma("unroll") for (int r = 0; r < 16; r += 2) { \
            const unsigned pk = cvt2(Oa[t][r], Oa[t][r + 1]); \
            Ob[(size_t)(32 * t + (r & 3) + 8 * (r >> 2)) * 1024] = (bf16_t)(pk & 0xffffu); \
            Ob[(size_t)(32 * t + ((r + 1) & 3) + 8 * ((r + 1) >> 2)) * 1024] = (bf16_t)(pk >> 16); } } while (0)
        GLA_LOADVF(0, 0);
        if (nch > 1) GLA_LOADVF(1, 1);
        for (int it = 0; it <= nch; it += 2) {
          if (it >= 1) GLA_OSTEP(1, it - 1);
          CH_BARRIER();
          if (it + 1 <= nch) { GLA_OSTEP(0, it); CH_BARRIER(); }
        }
      }
    }
  }
}

__device__ __forceinline__ void ph_headnorm_post(const P& p, const bf16_t* __restrict__ O, int nheads, const float* __restrict__ nw, const bf16_t* __restrict__ gate) {
  const int wave = tidw(p.wq) >> 6, lane = tidw(p.wq) & 63;
  const int gw = blockIdx.x * 8 + wave, nwv = gridDim.x * 8;
  const int C = nheads * 256, npt = nheads >> 2;
  const f32x4 w = *(const f32x4*)(nw + lane * 4);
  for (int it4 = gw; it4 < T_TOK * npt; it4 += nwv) {
    const int t = it4 / npt, h0 = (it4 % npt) * 4;
    u32x2 of[4], ob[4], z[4];
#pragma unroll
    for (int k = 0; k < 4; ++k) {
      const int c = (h0 + k) * 256 + lane * 4;
      of[k] = *(const u32x2*)(O + (size_t)t * C + c);
      ob[k] = *(const u32x2*)(O + ((size_t)T_TOK + t) * C + c);
      z[k] = *(const u32x2*)(gate + (size_t)t * C + c);
    }
#pragma unroll
    for (int k = 0; k < 4; ++k) {
      const int c = (h0 + k) * 256 + lane * 4;
      float v[4];
      v[0] = bflo(of[k][0]) + bflo(ob[k][0]); v[1] = bfhi(of[k][0]) + bfhi(ob[k][0]); v[2] = bflo(of[k][1]) + bflo(ob[k][1]); v[3] = bfhi(of[k][1]) + bfhi(ob[k][1]);
      const float ss = wave_sum(v[0] * v[0] + v[1] * v[1] + v[2] * v[2] + v[3] * v[3]);
      const float rstd = rsqrtf(ss * (1.f / 256.f) + EPS);
      u32x2 o;
      o[0] = pack2(v[0] * rstd * w[0] * silu_f(bflo(z[k][0])), v[1] * rstd * w[1] * silu_f(bfhi(z[k][0])));
      o[1] = pack2(v[2] * rstd * w[2] * silu_f(bflo(z[k][1])), v[3] * rstd * w[3] * silu_f(bfhi(z[k][1])));
      *(u32x2*)(p.H + (size_t)t * C + c) = o;
    }
  }
}

__device__ __forceinline__ void ph_gdn_pre(const P& p) {
  const int tid = tidw(p.wq);
  const float* cw = p.gdn_conv_w;
  const int per = (T_TOK + (int)gridDim.x - 1) / (int)gridDim.x;
  const int tbeg = (int)blockIdx.x * per, tend = (tbeg + per < T_TOK) ? tbeg + per : T_TOK;
  {
    const int c = tid * 8;
    float w[3][8];
#pragma unroll
    for (int k = 0; k < 3; ++k) { const f32x4 w0 = *(const f32x4*)(cw + k * 4096 + c), w1 = *(const f32x4*)(cw + k * 4096 + c + 4);
      w[k][0] = w0[0]; w[k][1] = w0[1]; w[k][2] = w0[2]; w[k][3] = w0[3]; w[k][4] = w1[0]; w[k][5] = w1[1]; w[k][6] = w1[2]; w[k][7] = w1[3]; }
    const u32x4 z4 = {0u, 0u, 0u, 0u};
    for (int t = tbeg; t < tend; t += 4) {
      int t0, L, cond; tok_info(t, t0, L, cond);
      const int pos = t - t0;
      const bf16_t* srcp = p.Pxbc + (size_t)t * 4096 + c;
      u32x4 X[6];
#pragma unroll
      for (int jx = 0; jx < 6; ++jx) X[jx] = (pos + jx - 1 >= 0 && pos + jx - 1 < L) ? *(const u32x4*)(srcp + (jx - 1) * 4096) : z4;
#pragma unroll
      for (int k = 0; k < 4; ++k) {
        float v[8];
#pragma unroll
        for (int q = 0; q < 4; ++q) {
          v[2 * q] = silu_f(w[0][2 * q] * bflo(X[k][q]) + w[1][2 * q] * bflo(X[k + 1][q]) + w[2][2 * q] * bflo(X[k + 2][q]));
          v[2 * q + 1] = silu_f(w[0][2 * q + 1] * bfhi(X[k][q]) + w[1][2 * q + 1] * bfhi(X[k + 1][q]) + w[2][2 * q + 1] * bfhi(X[k + 2][q]));
        }
        if (c < 2048) {
          float ss = 0.f;
#pragma unroll
          for (int q = 0; q < 8; ++q) ss += v[q] * v[q];
          ss += __shfl_xor(ss, 1); ss += __shfl_xor(ss, 2); ss += __shfl_xor(ss, 4); ss += __shfl_xor(ss, 8);
          float sc = rsqrtf(ss + 1e-6f);
          if (c < 1024) sc *= 0.08838834764831845f;
#pragma unroll
          for (int q = 0; q < 8; ++q) v[q] *= sc;
        }
        u32x4 o;
#pragma unroll
        for (int q = 0; q < 4; ++q) o[q] = pack2(v[2 * q], v[2 * q + 1]);
        *(u32x4*)(p.A + (size_t)(t + k) * 4096 + c) = o;
      }
    }
  }
  const int gtid = blockIdx.x * NT + tid, gsz = gridDim.x * NT;
  for (int it = gtid; it < T_TOK * 16; it += gsz) {
    const int t = it >> 4, dh = it & 15;
    const float a_raw = p.small[(size_t)t * 64 + dh], b_raw = p.small[(size_t)t * 64 + 16 + dh];
    const float logg = -__expf(p.gdn_a_log[dh]) * softplus_f(a_raw + p.gdn_dt_bias[dh]);
    p.small2[(size_t)t * 128 + dh] = logg;
    p.small2[(size_t)t * 128 + 16 + dh] = sigmoid_f(b_raw);
  }
}

template <int DIR>
__device__ __forceinline__ void gdn_solve(const float* Ms, const float* csb, bf16_t* Tt0, int wave, int lane) {
  const int part = lane >> 4, cidx = (wave & 3) * 16 + (lane & 15);
  const float* mb = Ms + DIR * 64 * 65 + (DIR ? -part : part);
  float Tr[16];
#pragma unroll
  for (int k = 0; k < 16; ++k) Tr[k] = 0.f;
#pragma unroll
  for (int s = 0; s < 64; ++s) {
    const int i = DIR ? 63 - s : s;
    float a0 = 0.f, a1 = 0.f, a2 = 0.f, a3 = 0.f;
#pragma unroll
    for (int k = 0; 4 * k < s; ++k) {
      const float mv = mb[i * 65 + (DIR ? 63 - 4 * k : 4 * k)];
      if ((k & 3) == 0) a0 -= mv * Tr[k]; else if ((k & 3) == 1) a1 -= mv * Tr[k]; else if ((k & 3) == 2) a2 -= mv * Tr[k]; else a3 -= mv * Tr[k];
    }
    float acc = (a0 + a1) + (a2 + a3);
    acc += __shfl_xor(acc, 16); acc += __shfl_xor(acc, 32);
    const float tv = ((cidx == i) ? 1.f : 0.f) + acc;
    Tr[s >> 2] = ((s & 3) == part) ? tv : Tr[s >> 2];
    if ((s & 3) == 3) asm volatile("" ::: "memory");
  }
  const float bl = csb[128 + DIR * 64 + cidx];
  bf16_t* Tt = Tt0 + kperm(cidx) + (DIR ? -part : part) * 64;
#pragma unroll
  for (int k = 0; k < 16; ++k) Tt[(DIR ? 63 - 4 * k : 4 * k) * 64] = f2bf(Tr[k] * bl);
}

#define GDN_MS 68
template <int DIR>
__device__ __forceinline__ void gdn_solve_col(const float* Ms, const float* csb, bf16_t* Tt0, int lane) {
  typedef float f32x2 __attribute__((ext_vector_type(2)));
  const float* mb = Ms + DIR * 64 * GDN_MS;
  f32x2 X[32];
#pragma unroll
  for (int k = 0; k < 32; ++k) X[k] = (f32x2){0.f, 0.f};
  f32x4 A[8], B[8], An[8];
#pragma unroll
  for (int s = 0; s < 64; ++s) {
    const int i = DIR ? 63 - s : s;
    const int ng = (s + 3) >> 2, nA = ng < 8 ? ng : 8, ngn = (s + 4) >> 2, nAn = (s + 1 < 64) ? (ngn < 8 ? ngn : 8) : 0;
#pragma unroll
    for (int k = 8; k < 16; ++k) if (k < ng) B[k - 8] = *(const f32x4*)(mb + i * GDN_MS + (DIR ? 60 - 4 * k : 4 * k));
    asm volatile("" ::: "memory");
    f32x2 a01 = {0.f, 0.f}, a23 = {0.f, 0.f};
#pragma unroll
    for (int k = 0; k < 8; ++k) if (k < nA) {
      const f32x2 mlo = DIR ? (f32x2){A[k][3], A[k][2]} : (f32x2){A[k][0], A[k][1]}, mhi = DIR ? (f32x2){A[k][1], A[k][0]} : (f32x2){A[k][2], A[k][3]};
      a01 -= mlo * X[2 * k]; a23 -= mhi * X[2 * k + 1];
    }
    {
      const int in = DIR ? 62 - s : s + 1;
#pragma unroll
      for (int k = 0; k < 8; ++k) if (k < nAn) An[k] = *(const f32x4*)(mb + in * GDN_MS + (DIR ? 60 - 4 * k : 4 * k));
    }
    asm volatile("" ::: "memory");
#pragma unroll
    for (int k = 8; k < 16; ++k) if (k < ng) {
      const f32x2 mlo = DIR ? (f32x2){B[k - 8][3], B[k - 8][2]} : (f32x2){B[k - 8][0], B[k - 8][1]}, mhi = DIR ? (f32x2){B[k - 8][1], B[k - 8][0]} : (f32x2){B[k - 8][2], B[k - 8][3]};
      a01 -= mlo * X[2 * k]; a23 -= mhi * X[2 * k + 1];
    }
    const f32x2 a = a01 + a23;
    X[s >> 1][s & 1] = ((lane == s) ? 1.f : 0.f) + (a[0] + a[1]);
#pragma unroll
    for (int k = 0; k < 8; ++k) if (k < nAn) A[k] = An[k];
  }
  const int cidx = DIR ? 63 - lane : lane;
  const float bl = csb[128 + DIR * 64 + cidx];
  bf16_t* Tt = Tt0 + kperm(cidx);
#pragma unroll
  for (int s = 0; s < 64; ++s) Tt[(DIR ? 63 - s : s) * 64] = f2bf(X[s >> 1][s & 1] * bl);
}

__device__ __forceinline__ void ph_gdn_tiles(const P& p, unsigned char* shm) {
  const int tid = tidw(p.wq), wave = tid >> 6, lane = tid & 63;
  float* KK = (float*)shm;
  float* QK = KK + 64 * GDN_MS;
  float* MsB = QK + 64 * GDN_MS;
  float* csb = MsB + 4 * 64 * GDN_MS;
  bf16_t* Kt = (bf16_t*)(csb + 1024);
  bf16_t* Qt = Kt + 64 * 136;
  bf16_t* TP = p.H; bf16_t* AI = p.H + (size_t)3072 * 4096;
  const float* cw = p.gdn_conv_w;
  const int cgi = tid & 63, to = tid >> 6;
  const int G = (int)gridDim.x;
#define GDN_SCAN(itm_, csbp_, dsel_) do { const int dir = (dsel_), tk = dir ? 63 - lane : lane; const size_t t = (size_t)((itm_) >> 3) * 64 + tk; const int dh = dir * 8 + ((itm_) & 7); \
      const float a_raw = p.small[t * 64 + dh], b_raw = p.small[t * 64 + 16 + dh]; \
      const float cs = wave_scan_incl(-__expf(p.gdn_a_log[dh]) * softplus_f(a_raw + p.gdn_dt_bias[dh])); \
      const float bt = sigmoid_f(b_raw); \
      (csbp_)[dir * 64 + tk] = cs; (csbp_)[128 + dir * 64 + tk] = bt; \
      p.VEC[(size_t)((itm_) * 2 + dir) * 64 + tk] = cs; } while (0)
  auto ai_gather = [&](int item, const float* csbc, int t2, int nthr) {
    for (int q = t2; q < 1024; q += nthr) {
      const int dir = q >> 9, i = (q >> 3) & 63, m = q & 7;
      const float ci = csbc[dir * 64 + i];
      float v[8];
#pragma unroll
      for (int e = 0; e < 8; ++e) {
        const int jx = kperm(8 * m + e);
        const bool incl = dir ? (jx >= i) : (jx <= i);
        v[e] = incl ? QK[i * GDN_MS + jx] * __expf(ci - csbc[dir * 64 + jx]) : 0.f;
      }
      const u32x4 o = {cvt2(v[0], v[1]), cvt2(v[2], v[3]), cvt2(v[4], v[5]), cvt2(v[6], v[7])};
      *(u32x4*)(AI + (size_t)(item * 2 + dir) * 4096 + i * 64 + 8 * m) = o;
    }
    for (int q = t2; q < 1024; q += nthr) { const int d = q >> 3, cc = q & 7;
      unsigned short v[8];
#pragma unroll
      for (int qq = 0; qq < 8; ++qq) v[qq] = Kt[kperm(cc * 8 + qq) * 136 + d];
      u32x4 o = {(unsigned)v[0] | ((unsigned)v[1] << 16), (unsigned)v[2] | ((unsigned)v[3] << 16), (unsigned)v[4] | ((unsigned)v[5] << 16), (unsigned)v[6] | ((unsigned)v[7] << 16)};
      *(u32x4*)(p.BT + (size_t)item * 8192 + d * 64 + cc * 8) = o; }
  };
  auto prefetch_rows = [&](int nxt, int l2) {
    const int tokn = (nxt >> 3) * 64, hdn = nxt & 7;
    const bf16_t* pa[5];
#pragma unroll
    for (int jj = 0; jj < 5; ++jj) {
      int idx = l2 + 128 * jj; idx = idx < 528 ? idx : 527;
      const int row = idx >> 3, seg = idx & 7;
      int tr = tokn - 1 + row; tr = tr < 0 ? 0 : (tr > T_TOK - 1 ? T_TOK - 1 : tr);
      const int eo = (seg < 2) ? (hdn * 128 + seg * 64) : ((seg < 4) ? (1024 + hdn * 128 + (seg - 2) * 64) : (2048 + hdn * 256 + (seg - 4) * 64));
      pa[jj] = p.Pxbc + (size_t)tr * 4096 + eo;
    }
    unsigned d0, d1, d2, d3, d4;
    asm volatile("global_load_dword %0, %5, off\n\tglobal_load_dword %1, %6, off\n\tglobal_load_dword %2, %7, off\n\tglobal_load_dword %3, %8, off\n\tglobal_load_dword %4, %9, off\n\ts_waitcnt vmcnt(0)"
                 : "=&v"(d0), "=&v"(d1), "=&v"(d2), "=&v"(d3), "=&v"(d4) : "v"(pa[0]), "v"(pa[1]), "v"(pa[2]), "v"(pa[3]), "v"(pa[4]) : "memory");
  };
  if (wave >= 6) {
    if ((int)blockIdx.x < 192 * 8) GDN_SCAN((int)blockIdx.x, csb, wave - 6);
    if ((int)blockIdx.x + G < 192 * 8) GDN_SCAN((int)blockIdx.x + G, csb + 256, wave - 6);
  }
  int itn = 0;
  for (int item0 = blockIdx.x; item0 < 192 * 8; item0 += 2 * G, ++itn) {
    float* csbp = csb + (itn & 1) * 512; float* csbn = csb + ((itn + 1) & 1) * 512;
    const bool has_b = item0 + G < 192 * 8;
#pragma nounroll
    for (int e = 0; e < 2; ++e) {
      if (e == 1 && !has_b) break;
      const int item = item0 + e * G;
      const int c = item >> 3, hd = item & 7, tok0 = c * 64;
      float* Ms = MsB + e * 2 * 64 * GDN_MS; const float* csbc = csbp + e * 256;
      {
        const int chg = (cgi < 16) ? (hd * 128 + cgi * 8) : ((cgi < 32) ? (1024 + hd * 128 + (cgi - 16) * 8) : (2048 + hd * 256 + (cgi - 32) * 8));
        float w[3][8];
#pragma unroll
        for (int k = 0; k < 3; ++k) { const f32x4 w0 = *(const f32x4*)(cw + k * 4096 + chg), w1 = *(const f32x4*)(cw + k * 4096 + chg + 4);
          w[k][0] = w0[0]; w[k][1] = w0[1]; w[k][2] = w0[2]; w[k][3] = w0[3]; w[k][4] = w1[0]; w[k][5] = w1[1]; w[k][6] = w1[2]; w[k][7] = w1[3]; }
        int t0, L, cond; tok_info(tok0, t0, L, cond);
        const int posb = tok0 - t0 + 8 * to - 1;
        const bf16_t* srcp = p.Pxbc + (size_t)(tok0 + 8 * to - 1) * 4096 + chg;
        const u32x4 z4 = {0u, 0u, 0u, 0u};
        u32x4 X[10];
#pragma unroll
        for (int r = 0; r < 10; ++r) X[r] = (posb + r >= 0 && posb + r < L) ? *(const u32x4*)(srcp + (size_t)r * 4096) : z4;
#pragma unroll
        for (int k = 0; k < 8; ++k) {
          float v[8];
#pragma unroll
          for (int q = 0; q < 4; ++q) {
            v[2 * q] = silu_f(w[0][2 * q] * bflo(X[k][q]) + w[1][2 * q] * bflo(X[k + 1][q]) + w[2][2 * q] * bflo(X[k + 2][q]));
            v[2 * q + 1] = silu_f(w[0][2 * q + 1] * bfhi(X[k][q]) + w[1][2 * q + 1] * bfhi(X[k + 1][q]) + w[2][2 * q + 1] * bfhi(X[k + 2][q]));
          }
          if (cgi < 32) {
            float ss = 0.f;
#pragma unroll
            for (int q = 0; q < 8; ++q) ss += v[q] * v[q];
            ss = row16_allsum(ss);
            float sc = rsqrtf(ss + 1e-6f);
            if (cgi < 16) sc *= 0.08838834764831845f;
#pragma unroll
            for (int q = 0; q < 8; ++q) v[q] *= sc;
          }
          u32x4 o;
#pragma unroll
          for (int q = 0; q < 4; ++q) o[q] = pack2(v[2 * q], v[2 * q + 1]);
          *(u32x4*)(p.A + (size_t)(tok0 + 8 * to + k) * 4096 + chg) = o;
          if (cgi < 16) *(u32x4*)(Qt + (8 * to + k) * 136 + cgi * 8) = o;
          else if (cgi < 32) *(u32x4*)(Kt + (8 * to + k) * 136 + (cgi - 16) * 8) = o;
        }
      }
      __syncthreads();
      {
        const int which = wave >> 2, ti = (wave >> 1) & 1, tj = wave & 1, col = lane & 31, h = lane >> 5;
        f32x16 acc;
#pragma unroll
        for (int r = 0; r < 16; ++r) acc[r] = 0.f;
        const bf16_t* ap = (which ? Qt : Kt) + (32 * ti + col) * 136 + 8 * h;
        const bf16_t* bp = Kt + (32 * tj + col) * 136 + 8 * h;
#pragma unroll
        for (int s = 0; s < 8; ++s) acc = MFMA32(*(const bf16x8*)(ap + 16 * s), *(const bf16x8*)(bp + 16 * s), acc);
        float* dst = which ? QK : KK;
#pragma unroll
        for (int r = 0; r < 16; ++r) dst[(32 * ti + (r & 3) + 8 * (r >> 2) + 4 * h) * GDN_MS + 32 * tj + col] = acc[r];
      }
      __syncthreads();
      for (int idx = tid; idx < 2 * 4096; idx += NT) {
        const int dir = idx >> 12, i = (idx >> 6) & 63, jx = idx & 63;
        const float ci = csbc[dir * 64 + i], cj = csbc[dir * 64 + jx];
        const bool before = dir ? (jx > i) : (jx < i);
        Ms[(dir * 64 + i) * GDN_MS + jx] = before ? csbc[128 + dir * 64 + i] * KK[i * GDN_MS + jx] * __expf(ci - cj) : 0.f;
      }
      __syncthreads();
      if (e == 0 && has_b) {
        ai_gather(item, csbc, tid, NT);
        __syncthreads();
      }
    }
    const int last = has_b ? 1 : 0;
    if (wave < 4) {
      const int e = wave >> 1;
      if (e <= last) {
        const float* Ms = MsB + e * 2 * 64 * GDN_MS; const float* csbc = csbp + e * 256; const int item = item0 + e * G;
        __builtin_amdgcn_s_setprio(3);
        if (wave & 1) gdn_solve_col<1>(Ms, csbc, TP + (size_t)(item * 2 + 1) * 4096, lane);
        else gdn_solve_col<0>(Ms, csbc, TP + (size_t)(item * 2) * 4096, lane);
        __builtin_amdgcn_s_setprio(0);
      }
    } else if (wave < 6) {
      ai_gather(item0 + last * G, csbp + last * 256, tid - 256, 128);
    } else {
      const int n0 = item0 + 2 * G, n1 = n0 + G;
      if (n0 < 192 * 8) { GDN_SCAN(n0, csbn, wave - 6); prefetch_rows(n0, tid - 384); }
      if (n1 < 192 * 8) { GDN_SCAN(n1, csbn + 256, wave - 6); prefetch_rows(n1, tid - 384); }
    }
    __syncthreads();
  }
}

#define GDN_OFF_K 0
#define GDN_OFF_Q 17408
#define GDN_OFF_KT 34816
#define GDN_OFF_T 53248
#define GDN_OFF_A 62464
#define GDN_OFF_CS 71680
#define GDN_BUF 71936
__device__ __forceinline__ void ph_gdn_chain(const P& p, lds_u8* lds) {
  const int tid = tidw(p.wq), wave = __builtin_amdgcn_readfirstlane(tid >> 6), lane = tid & 63, col = lane & 31, h = lane >> 5;
  const bool consumer = wave < 4;
  const int ltid = tid - 256;
  float* out_state = p.out + (size_t)T_TOK * DM + 16777216 + 4194304;
  const bf16_t* TP = p.H; const bf16_t* AI = p.H + (size_t)3072 * 4096;
  const int nlat = 64, nitem = 576, G = (int)gridDim.x;
  const int stride = ((int)blockIdx.x < nlat) ? nitem : (G - nlat);
  for (int item = (int)blockIdx.x; item < nitem; item += stride) {
    int seq, dir, hd, half;
    if (item < 64) { const int x = item & 7, k = item >> 3, cmb = (k >> 1) * 8 + x; half = k & 1; seq = 16 + (cmb >> 4); dir = (cmb >> 3) & 1; hd = cmb & 7; }
    else { const int i2 = item - 64, x = i2 & 7, kk = i2 >> 3, cmb = (kk >> 1) * 8 + x; half = kk & 1; seq = cmb >> 4; dir = (cmb >> 3) & 1; hd = cmb & 7; }
    int chunk0, nch; if (seq < 16) { chunk0 = seq * 4; nch = 4; } else { chunk0 = 64 + (seq - 16) * 64; nch = 64; }
    if (!consumer) {
      const int lrow = ltid >> 4, lc16 = ltid & 15, lc8 = ltid & 7;
      u32x4 RK[2][4], RQ[2][4], RKT[2][4], RT[2][2], RA[2][2]; float RC[2][13];
      const unsigned lo_kq = (unsigned)(((ltid >> 4) * 4096 + (ltid & 15) * 8) * 2), lo_t = (unsigned)(ltid * 16), lo_c = (unsigned)(lrow * 4), lo_c8 = (unsigned)((16 * (lc8 >> 1) + 4 * (lc8 & 1)) * 4);
#define GDN_LLOAD(set, stepn) do { const int c_ = chunk0 + (dir ? nch - 1 - (stepn) : (stepn)); const size_t tix_ = (size_t)((c_ * 8 + hd) * 2 + dir); \
        const char* qb_ = (const char*)(p.A + (size_t)c_ * 64 * 4096 + hd * 128); const char* kb_ = qb_ + 2048; \
        const char* KTt_ = (const char*)(p.BT + (size_t)(c_ * 8 + hd) * 8192); const char* Tt_ = (const char*)(TP + tix_ * 4096); const char* At_ = (const char*)(AI + tix_ * 4096); \
        const char* cs_ = (const char*)(p.VEC + tix_ * 64); \
        _Pragma("unroll") for (int i = 0; i < 4; ++i) { \
          RK[set][i] = *(const u32x4*)(kb_ + i * 131072 + lo_kq); RQ[set][i] = *(const u32x4*)(qb_ + i * 131072 + lo_kq); \
          RKT[set][i] = *(const u32x4*)(KTt_ + i * 4096 + lo_t); RC[set][1 + i] = *(const float*)(cs_ + i * 64 + lo_c); } \
        _Pragma("unroll") for (int i = 0; i < 2; ++i) { RT[set][i] = *(const u32x4*)(Tt_ + i * 4096 + lo_t); RA[set][i] = *(const u32x4*)(At_ + i * 4096 + lo_t); } \
        RC[set][0] = *(const float*)(cs_ + (dir ? 0 : 252)); \
        { const f32x4 a_ = *(const f32x4*)(cs_ + lo_c8), b_ = *(const f32x4*)(cs_ + 32 + lo_c8); \
          RC[set][5] = a_[0]; RC[set][6] = a_[1]; RC[set][7] = a_[2]; RC[set][8] = a_[3]; RC[set][9] = b_[0]; RC[set][10] = b_[1]; RC[set][11] = b_[2]; RC[set][12] = b_[3]; } } while (0)
#define GDN_LWRITE(set, bufi) do { lds_u8* buf = lds + (bufi) * GDN_BUF; \
        const float cs_tot = RC[set][0]; float ks[8]; \
        _Pragma("unroll") for (int e = 0; e < 8; ++e) ks[e] = __expf(cs_tot - RC[set][5 + e]); \
        const int p0 = grp_pos_bytes(2 * lc16), p1 = grp_pos_bytes(2 * lc16 + 1); \
        _Pragma("unroll") for (int i = 0; i < 4; ++i) { \
          const float ec = __expf(RC[set][1 + i]); const int row = lrow + 16 * i; \
          const u32x4 kk = scale8(RK[set][i], -ec, -ec, -ec, -ec, -ec, -ec, -ec, -ec); \
          const u32x4 qq = scale8(RQ[set][i], ec, ec, ec, ec, ec, ec, ec, ec); \
          *(LAS u32x2*)(buf + GDN_OFF_K + row * 272 + p0) = (u32x2){kk[0], kk[1]}; \
          *(LAS u32x2*)(buf + GDN_OFF_K + row * 272 + p1) = (u32x2){kk[2], kk[3]}; \
          *(LAS u32x2*)(buf + GDN_OFF_Q + row * 272 + p0) = (u32x2){qq[0], qq[1]}; \
          *(LAS u32x2*)(buf + GDN_OFF_Q + row * 272 + p1) = (u32x2){qq[2], qq[3]}; \
          const int q = ltid + 256 * i; \
          *(LAS u32x4*)(buf + GDN_OFF_KT + (q >> 3) * 144 + (q & 7) * 16) = scale8(RKT[set][i], ks[0], ks[1], ks[2], ks[3], ks[4], ks[5], ks[6], ks[7]); } \
        _Pragma("unroll") for (int i = 0; i < 2; ++i) { const int q = ltid + 256 * i; \
          *(LAS u32x4*)(buf + GDN_OFF_T + (q >> 3) * 144 + (q & 7) * 16) = RT[set][i]; \
          *(LAS u32x4*)(buf + GDN_OFF_A + (q >> 3) * 144 + (q & 7) * 16) = RA[set][i]; } \
        if (ltid == 0) *(LAS float*)(buf + GDN_OFF_CS) = __expf(cs_tot); } while (0)
      GDN_LLOAD(0, 0);
      if (nch > 1) GDN_LLOAD(1, 1);
      for (int it = 0; it <= nch; it += 2) {
        if (it < nch) GDN_LWRITE(0, 0);
        if (it + 2 < nch) GDN_LLOAD(0, it + 2);
        CH_BARRIER();
        if (it + 1 <= nch) {
          if (it + 1 < nch) GDN_LWRITE(1, 1);
          if (it + 3 < nch) GDN_LLOAD(1, it + 3);
          CH_BARRIER();
        }
      }
    } else {
      const int ecol = (half * 4 + (wave & 3)) * 32 + col;
      f32x16 S[4];
      f32x16 XX[2];
      if (seq >= 16) {
        const float* s = p.state_gdn + (((size_t)(seq - 16) * 2 + dir) * 8 + hd) * 32768 + ecol;
#pragma unroll
        for (int db = 0; db < 4; ++db)
#pragma unroll
          for (int r = 0; r < 16; ++r) S[db][r] = s[(32 * db + (r & 3) + 8 * (r >> 2) + 4 * h) * 256];
      } else {
#pragma unroll
        for (int db = 0; db < 4; ++db)
#pragma unroll
          for (int r = 0; r < 16; ++r) S[db][r] = 0.f;
      }
      bf16x8 vr[2][2];
      const int vcol0 = 2048 + hd * 256 + (half * 4 + (wave & 3)) * 32 + 8 * h;
      {
        const int c0 = chunk0 + (dir ? nch - 1 : 0);
#pragma unroll
        for (int t = 0; t < 2; ++t)
#pragma unroll
          for (int s = 0; s < 2; ++s) vr[t][s] = *(const bf16x8*)(p.A + (size_t)(c0 * 64 + 32 * t + col) * 4096 + vcol0 + 16 * s);
      }
      __builtin_amdgcn_s_setprio(3);
      for (int it = 0; it <= nch; ++it) {
        if (it >= 1) {
          const int step = it - 1;
        const int c = chunk0 + (dir ? nch - 1 - step : step), tok0 = c * 64;
        const lds_u8* buf = lds + (step & 1) * GDN_BUF;
        bf16_t* Ob = p.Pxbc + ((size_t)dir * T_TOK + tok0) * 2048 + hd * 256 + 4 * h * 2048 + ecol;
        bf16x8 Sb[8];
#pragma unroll
        for (int db = 0; db < 4; ++db) { Sb[2 * db] = pack_half(S[db], 0); Sb[2 * db + 1] = pack_half(S[db], 1); }
        f32x16 Q1[2];
#pragma unroll
        for (int t = 0; t < 2; ++t)
#pragma unroll
          for (int r = 0; r < 16; ++r) { Q1[t][r] = 0.f; XX[t][r] = 0.f; }
#pragma unroll
        for (int sg = 0; sg < 4; ++sg) {
          bf16x8 ka[2][2], qa[2][2];
#pragma unroll
          for (int t = 0; t < 2; ++t)
#pragma unroll
            for (int s2 = 0; s2 < 2; ++s2) {
              ka[t][s2] = *(const LAS bf16x8*)(buf + GDN_OFF_K + (32 * t + col) * 272 + 32 * (2 * sg + s2) + 16 * h);
              qa[t][s2] = *(const LAS bf16x8*)(buf + GDN_OFF_Q + (32 * t + col) * 272 + 32 * (2 * sg + s2) + 16 * h);
            }
#pragma unroll
          for (int s2 = 0; s2 < 2; ++s2) {
            XX[0] = MFMA32(ka[0][s2], Sb[2 * sg + s2], XX[0]);
            XX[1] = MFMA32(ka[1][s2], Sb[2 * sg + s2], XX[1]);
            Q1[0] = MFMA32(qa[0][s2], Sb[2 * sg + s2], Q1[0]);
            Q1[1] = MFMA32(qa[1][s2], Sb[2 * sg + s2], Q1[1]);
          }
        }
        { int cx = col - 8 * h; asm volatile("" : "+v"(cx));
#pragma unroll
          for (int s = 0; s < 2; ++s) { u32x4 u;
#pragma unroll
            for (int q = 0; q < 4; ++q) { const int k0 = 16 * s + 2 * q; u[q] = ((cx == k0) ? 0x3F80u : 0u) | ((cx == k0 + 1) ? 0x3F800000u : 0u); }
            const bf16x8 Id = __builtin_bit_cast(bf16x8, u);
            XX[0] = MFMA32(vr[0][s], Id, XX[0]); XX[1] = MFMA32(vr[1][s], Id, XX[1]); } }
        bf16x8 Xb[4];
#pragma unroll
        for (int t = 0; t < 2; ++t) { Xb[2 * t] = pack_half(XX[t], 0); Xb[2 * t + 1] = pack_half(XX[t], 1); }
        f32x16 Vn[2];
        {
          bf16x8 ta[2][4];
#pragma unroll
          for (int t = 0; t < 2; ++t) {
#pragma unroll
            for (int r = 0; r < 16; ++r) Vn[t][r] = 0.f;
#pragma unroll
            for (int s = 0; s < 4; ++s) ta[t][s] = *(const LAS bf16x8*)(buf + GDN_OFF_T + (32 * t + col) * 144 + 32 * s + 16 * h);
          }
#pragma unroll
          for (int s = 0; s < 4; ++s) { Vn[0] = MFMA32(ta[0][s], Xb[s], Vn[0]); Vn[1] = MFMA32(ta[1][s], Xb[s], Vn[1]); }
        }
        bf16x8 Vnb[4];
#pragma unroll
        for (int t = 0; t < 2; ++t) { Vnb[2 * t] = pack_half(Vn[t], 0); Vnb[2 * t + 1] = pack_half(Vn[t], 1); }
        {
          bf16x8 aa[2][4];
#pragma unroll
          for (int t = 0; t < 2; ++t)
#pragma unroll
            for (int s = 0; s < 4; ++s) aa[t][s] = *(const LAS bf16x8*)(buf + GDN_OFF_A + (32 * t + col) * 144 + 32 * s + 16 * h);
#pragma unroll
          for (int s = 0; s < 4; ++s) { Q1[0] = MFMA32(aa[0][s], Vnb[s], Q1[0]); Q1[1] = MFMA32(aa[1][s], Vnb[s], Q1[1]); }
        }
#pragma unroll
        for (int t = 0; t < 2; ++t) {
#pragma unroll
          for (int r = 0; r < 16; r += 2) {
            const unsigned pk = cvt2(Q1[t][r], Q1[t][r + 1]);
            Ob[(size_t)(32 * t + (r & 3) + 8 * (r >> 2)) * 2048] = (bf16_t)(pk & 0xffffu);
            Ob[(size_t)(32 * t + ((r + 1) & 3) + 8 * ((r + 1) >> 2)) * 2048] = (bf16_t)(pk >> 16);
          }
        }
        if (step + 1 < nch) {
          const int cn = chunk0 + (dir ? nch - 2 - step : step + 1);
#pragma unroll
          for (int t = 0; t < 2; ++t)
#pragma unroll
            for (int s = 0; s < 2; ++s) vr[t][s] = *(const bf16x8*)(p.A + (size_t)(cn * 64 + 32 * t + col) * 4096 + vcol0 + 16 * s);
        }
        const float dec = *(const __attribute__((address_space(3))) float*)(buf + GDN_OFF_CS);
#pragma unroll
        for (int db = 0; db < 4; ++db)
#pragma unroll
          for (int r = 0; r < 16; ++r) S[db][r] *= dec;
#pragma unroll
        for (int sp = 0; sp < 2; ++sp) {
          bf16x8 kb[4][2];
#pragma unroll
          for (int db = 0; db < 4; ++db)
#pragma unroll
            for (int s2 = 0; s2 < 2; ++s2) kb[db][s2] = *(const LAS bf16x8*)(buf + GDN_OFF_KT + (32 * db + col) * 144 + 32 * (2 * sp + s2) + 16 * h);
#pragma unroll
          for (int s2 = 0; s2 < 2; ++s2)
#pragma unroll
            for (int db = 0; db < 4; ++db) S[db] = MFMA32(kb[db][s2], Vnb[2 * sp + s2], S[db]);
        }
        }
        CH_BARRIER();
      }
      __builtin_amdgcn_s_setprio(0);
      if (seq < 16) {
        float* d_ = out_state + (((size_t)seq * 2 + dir) * 8 + hd) * 32768 + ecol;
#pragma unroll
        for (int db = 0; db < 4; ++db)
#pragma unroll
          for (int r = 0; r < 16; ++r) d_[(32 * db + (r & 3) + 8 * (r >> 2) + 4 * h) * 256] = S[db][r];
      }
    }
  }
}

__device__ __forceinline__ void ph_ffn_glu(const P& p, int layer, unsigned char* shm) {
  const int tid = tidw(p.wq);
  const bf16_t* Pa = p.Pz; const bf16_t* Pv = p.Pz + (size_t)T_TOK * DFF;
  const float* cw = p.ffn_conv_w + (size_t)layer * 9 * DFF; const float* cb = p.ffn_conv_b + (size_t)layer * DFF;
  float* wl = (float*)shm;
  for (int i = tid; i < 9 * DFF / 4; i += NT) *(f32x4*)(wl + i * 4) = *(const f32x4*)(cw + i * 4);
  for (int i = tid; i < DFF / 4; i += NT) *(f32x4*)(wl + 9 * DFF + i * 4) = *(const f32x4*)(cb + i * 4);
  __syncthreads();
  const int ngrp = T_TOK / 4, per = (ngrp + (int)gridDim.x - 1) / (int)gridDim.x;
  const int gbeg = (int)blockIdx.x * per, gend = (gbeg + per < ngrp) ? gbeg + per : ngrp;
  const int nitems = (gend - gbeg) * (DFF / 8);
  const u32x4 z4 = {0u, 0u, 0u, 0u};
  for (int it = tid; it < nitems; it += NT) {
    const int gi = gbeg + it / (DFF / 8), c = (it % (DFF / 8)) * 8;
    const int t = gi * 4;
    const bool lat = t >= T_CTX;
    const int pos = lat ? ((t - T_CTX) & 4095) : (t & 255);
    const int W = lat ? 64 : 256;
    const int col = lat ? (pos & 63) : pos, row = lat ? (pos >> 6) : 0;
    u32x4 A[3][6], vv[4];
#pragma unroll
    for (int iy = 0; iy < 3; ++iy) {
      const bool rok = lat ? (row + iy - 1 >= 0 && row + iy - 1 < 64) : (iy == 1);
#pragma unroll
      for (int jx = 0; jx < 6; ++jx) {
        const int cc = col + jx - 1;
        A[iy][jx] = (rok && cc >= 0 && cc < W) ? *(const u32x4*)(Pa + (size_t)(t + (iy - 1) * 64 + jx - 1) * DFF + c) : z4;
      }
    }
#pragma unroll
    for (int k = 0; k < 4; ++k) vv[k] = *(const u32x4*)(Pv + (size_t)(t + k) * DFF + c);
    float acc[4][8];
    { const f32x4 b0 = *(const f32x4*)(wl + 9 * DFF + c), b1 = *(const f32x4*)(wl + 9 * DFF + c + 4);
#pragma unroll
      for (int k = 0; k < 4; ++k) { acc[k][0] = b0[0]; acc[k][1] = b0[1]; acc[k][2] = b0[2]; acc[k][3] = b0[3]; acc[k][4] = b1[0]; acc[k][5] = b1[1]; acc[k][6] = b1[2]; acc[k][7] = b1[3]; } }
#pragma unroll
    for (int iy = 0; iy < 3; ++iy)
#pragma unroll
      for (int jx = 0; jx < 3; ++jx) {
        const f32x4 w0 = *(const f32x4*)(wl + (iy * 3 + jx) * DFF + c), w1 = *(const f32x4*)(wl + (iy * 3 + jx) * DFF + c + 4);
#pragma unroll
        for (int k = 0; k < 4; ++k) {
          const u32x4 a = A[iy][k + jx];
          acc[k][0] += w0[0] * bflo(a[0]); acc[k][1] += w0[1] * bfhi(a[0]); acc[k][2] += w0[2] * bflo(a[1]); acc[k][3] += w0[3] * bfhi(a[1]);
          acc[k][4] += w1[0] * bflo(a[2]); acc[k][5] += w1[1] * bfhi(a[2]); acc[k][6] += w1[2] * bflo(a[3]); acc[k][7] += w1[3] * bfhi(a[3]);
        }
      }
#pragma unroll
    for (int k = 0; k < 4; ++k) {
      u32x4 o;
#pragma unroll
      for (int q = 0; q < 4; ++q) o[q] = pack2(silu_f(acc[k][2 * q]) * bflo(vv[k][q]), silu_f(acc[k][2 * q + 1]) * bfhi(vv[k][q]));
      *(u32x4*)(p.H + (size_t)(t + k) * DFF + c) = o;
    }
  }
  __syncthreads();
}

__device__ __forceinline__ void ph_final_norm(const P& p) {
  const int wave = tidw(p.wq) >> 6, lane = tidw(p.wq) & 63;
  const int gw = blockIdx.x * 8 + wave, nwv = gridDim.x * 8;
  for (int tb = gw; tb < T_TOK; tb += 3 * nwv) {
    f32x4 v[3][4]; float ss[3];
#pragma unroll
    for (int j = 0; j < 3; ++j) {
      const int t = tb + j * nwv; ss[j] = 0.f;
      if (t < T_TOK) {
        const float* xr = p.out + (size_t)t * DM;
#pragma unroll
        for (int i = 0; i < 4; ++i) v[j][i] = *(const f32x4*)(xr + i * 256 + lane * 4);
      }
    }
#pragma unroll
    for (int j = 0; j < 3; ++j) {
      const int t = tb + j * nwv;
      if (t < T_TOK) {
#pragma unroll
        for (int i = 0; i < 4; ++i) ss[j] += v[j][i][0] * v[j][i][0] + v[j][i][1] * v[j][i][1] + v[j][i][2] * v[j][i][2] + v[j][i][3] * v[j][i][3];
        const float rstd = rsqrtf(wave_sum(ss[j]) * (1.f / DM) + EPS);
        float* xr = p.out + (size_t)t * DM;
#pragma unroll
        for (int i = 0; i < 4; ++i) {
          const f32x4 w = *(const f32x4*)(p.final_norm_w + i * 256 + lane * 4);
          f32x4 o = v[j][i] * rstd * w;
          *(f32x4*)(xr + i * 256 + lane * 4) = o;
        }
      }
    }
  }
}

#define XB_TMO      128
#define XB_XCNT(j)  (256  + 64 * (j))
#define XB_XSUB(j)  (1280 + 64 * (j))
#define XB_XGEN(j)  (2304 + 64 * (j))
#define XB_TOP      3328
#define XB_TOPGEN   3392
#define XCD_BAR_WORDS 3456
#define XB_SPIN_CAP (1u << 18)


__device__ __forceinline__ unsigned xb_ld(unsigned* p)              { return __hip_atomic_load(p, __ATOMIC_RELAXED, __HIP_MEMORY_SCOPE_AGENT); }
__device__ __forceinline__ unsigned xb_add(unsigned* p, unsigned v) { return __hip_atomic_fetch_add(p, v, __ATOMIC_RELAXED, __HIP_MEMORY_SCOPE_AGENT); }
__device__ __forceinline__ unsigned xb_xcc_id() { return (unsigned)__builtin_amdgcn_s_getreg((3 << 11) | 20) & 0xFu; }
#define XB_SPIN(cond, bar) do { unsigned _sp = 0; while (cond) { __builtin_amdgcn_s_sleep(1); \
    if ((++_sp & 255u) == 0u) { if (xb_ld(&(bar)[XB_TMO])) break; if (_sp > XB_SPIN_CAP) { atomicAdd(&(bar)[XB_TMO], 1u); break; } } } } while (0)

struct XcdBarrier {
    unsigned* bar; unsigned x;
    volatile LAS unsigned* st;
};

__device__ __forceinline__ XcdBarrier xcd_barrier_post(unsigned* bar, volatile LAS unsigned* st) {
    XcdBarrier b; b.bar = bar; b.x = xb_xcc_id(); b.st = st;
    if (threadIdx.x == 0) (void)xb_add(&bar[XB_XCNT(b.x)], 1u);
    return b;
}
__device__ __forceinline__ void xcd_barrier_complete(unsigned* bar, unsigned x, unsigned& nloc, unsigned& nx) {
    const unsigned G = gridDim.x * gridDim.y * gridDim.z;
    unsigned sum, cnt, mine, sp = 0u;
    for (;;) {
        sum = 0u; cnt = 0u; mine = 0u;
#pragma unroll
        for (unsigned j = 0; j < 16; ++j) { const unsigned c = xb_ld(&bar[XB_XCNT(j)]); sum += c; cnt += (c > 0u) ? 1u : 0u; mine = (j == x) ? c : mine; }
        if (sum == G) break;
        __builtin_amdgcn_s_sleep(1);
        if ((++sp & 255u) == 0u) { if (xb_ld(&bar[XB_TMO])) break; if (sp > XB_SPIN_CAP) { atomicAdd(&bar[XB_TMO], 1u); break; } }
    }
    nloc = mine > 0u ? mine : 1u; nx = cnt > 0u ? cnt : 1u;
}

__device__ __forceinline__ void xcd_barrier(const XcdBarrier& b) {
    asm volatile("s_waitcnt vmcnt(0)" ::: "memory");
    __syncthreads();
    if (threadIdx.x == 0) {
        unsigned* bar = b.bar;
        __builtin_amdgcn_s_waitcnt(0);
        unsigned nloc = b.st[0], nx = b.st[1];
        if (nloc == 0u) { xcd_barrier_complete(bar, b.x, nloc, nx); b.st[0] = nloc; b.st[1] = nx; }
        const unsigned old = xb_add(&bar[XB_XSUB(b.x)], 1u);
        const unsigned gen = old / nloc;
        if (old + 1u == (gen + 1u) * nloc) {
            __builtin_amdgcn_fence(__ATOMIC_RELEASE, "agent");
            asm volatile("s_waitcnt vmcnt(0)" ::: "memory");
            const unsigned og = xb_add(&bar[XB_TOP], 1u);
            const unsigned tg = og / nx;
            if (og + 1u == (tg + 1u) * nx) xb_add(&bar[XB_TOPGEN], 1u);
            else XB_SPIN(xb_ld(&bar[XB_TOPGEN]) == tg, bar);
            __builtin_amdgcn_fence(__ATOMIC_ACQUIRE, "agent");
            xb_add(&bar[XB_XGEN(b.x)], 1u);
            asm volatile("s_waitcnt vmcnt(0)" ::: "memory");
        } else {
            XB_SPIN(xb_ld(&bar[XB_XGEN(b.x)]) == gen, bar);
            __builtin_amdgcn_fence(__ATOMIC_ACQUIRE, "agent");
            asm volatile("s_waitcnt vmcnt(0)" ::: "memory");
        }
    }
    __syncthreads();
}

typedef const __attribute__((address_space(4))) P* kargp_t;
__device__ __forceinline__ kargp_t getP() {
  kargp_t k = (kargp_t)__builtin_amdgcn_kernarg_segment_ptr();
  asm volatile("" : "+s"(k));
  return k;
}
#if defined(__HIP_DEVICE_COMPILE__)
#define LP() P p = *getP(); p.wq = widx_k
#else
#define LP() P p = p_arg; p.wq = widx_k
#endif

#define GSYNC() do { LP(); XcdBarrier b_; b_.bar = p.bar; b_.x = xb_xcc_id(); b_.st = (volatile LAS unsigned*)(lds + LDS_BYTES - 16); xcd_barrier(b_); } while (0)
__global__ void __launch_bounds__(NT) fwd_megakernel(P p_arg) {
  const int widx_k = __builtin_amdgcn_readfirstlane((int)(threadIdx.x >> 6));
  extern __shared__ __attribute__((aligned(16))) unsigned char shm[];
  float* tile = (float*)shm;
  lds_u8* lds = (lds_u8*)shm;

  volatile LAS unsigned* xst = (volatile LAS unsigned*)(lds + LDS_BYTES - 16);
  if (threadIdx.x == 0) { xst[0] = 0u; xst[1] = 0u; xst[2] = 0u; xst[3] = 0u; }
  __syncthreads();
  { LP(); (void)xcd_barrier_post(p.bar, xst); }
  { LP(); ph_ada_direct(p, 0, 1, shm, (int)blockIdx.x, (int)gridDim.x); }
  { LP(); ph_convert(p, 0, 1, tile, (int)blockIdx.x, (int)gridDim.x); }
  GSYNC();

  {
    constexpr int layer = 0; constexpr int kind = layer % 3, j = layer / 3;
    if constexpr (layer == 0) { { LP(); ph_norm_mod<true>(p, p.norm_mix_w + layer * DM, p.mod + (size_t)layer * 3 * 6144, 0, 1024, p.H); }
      GSYNC(); }
    if constexpr (kind == 0) {
      { LP(); gemm_phase8(lds, layer == 0 ? p.H : p.A, p.Win, T_TOK, 6400, DM, EpiSsmIn{p.Pz, p.Pxbc, p.small}, p.wq); }
      if constexpr (layer == 0) { LP(); const int g_ = (int)gridDim.x, b0_ = (g_ >= 192) ? 176 : 0; if ((int)blockIdx.x >= b0_) { ph_convert(p, 0, 2, tile, (int)blockIdx.x - b0_, g_ - b0_); ph_ada_direct(p, 1, 2, shm, (int)blockIdx.x - b0_, g_ - b0_); } }
      GSYNC();
      { LP(); ph_ssm_tiles(p, j, shm); }
      GSYNC();
      { LP(); ph_ssm_chain(p, j, lds); }
      { LP(); if ((int)blockIdx.x >= 128) ph_convert(p, layer, 8, tile, (int)blockIdx.x - 128, (int)gridDim.x - 128); }
      GSYNC();
      { LP(); ph_ssm_post(p, j); }
      GSYNC();
      { LP(); gemm_phase_residnorm192<false>(lds, p.H, p.Wout, 2048, p.out, p.mod + (size_t)layer * 3 * 6144 + 2048, p.adap, p.bar + XCD_BAR_WORDS + (layer * 2) * 4096,
                                             p.norm_ffn_w + layer * DM, p.mod + (size_t)layer * 3 * 6144, 3072, 4096, p.A, p.wq); }
    } else if constexpr (kind == 1) {
      { LP(); gemm_phase8(lds, p.Pxbc + (size_t)T_TOK * 2048, p.Win, T_TOK, 4096, DM, EpiGlaIn{p.A, p.Pz, (float*)p.Pxbc, p.gla_gate_b}, p.wq); }
      GSYNC();
      { LP(); ph_gla_tiles(p, shm); }
      GSYNC();
      { LP(); ph_gla_chain(p, lds); }
      { LP(); if ((int)blockIdx.x >= 64) ph_convert(p, layer, 8, tile, (int)blockIdx.x - 64, (int)gridDim.x - 64); }
      GSYNC();
      { LP(); ph_headnorm_post(p, p.Pxbc + (size_t)T_TOK * 2048, 4, p.gla_norm_w, p.Pz); }
      GSYNC();
      { LP(); gemm_phase_residnorm192<false>(lds, p.H, p.Wout, 1024, p.out, p.mod + (size_t)layer * 3 * 6144 + 2048, p.adap, p.bar + XCD_BAR_WORDS + (layer * 2) * 4096,
                                             p.norm_ffn_w + layer * DM, p.mod + (size_t)layer * 3 * 6144, 3072, 4096, p.A, p.wq); }
    } else {
      { LP(); gemm_phase8(lds, p.A, p.Win, T_TOK, 6400, DM, EpiGdnIn{p.Pz, p.Pxbc, p.small}, p.wq); }
      GSYNC();
      { LP(); ph_gdn_tiles(p, shm); }
      GSYNC();
      { LP(); ph_gdn_chain(p, lds); }
      { LP(); if ((int)blockIdx.x >= 64) ph_convert(p, layer, 8, tile, (int)blockIdx.x - 64, (int)gridDim.x - 64); }
      GSYNC();
      { LP(); ph_headnorm_post(p, p.Pxbc, 8, p.gdn_norm_w, p.Pz); }
      GSYNC();
      { LP(); gemm_phase_residnorm192<false>(lds, p.H, p.Wout, 2048, p.out, p.mod + (size_t)layer * 3 * 6144 + 2048, p.adap, p.bar + XCD_BAR_WORDS + (layer * 2) * 4096,
                                             p.norm_ffn_w + layer * DM, p.mod + (size_t)layer * 3 * 6144, 3072, 4096, p.A, p.wq); }
    }
    GSYNC();
    { LP(); gemm_phase8(lds, p.A, p.Wfi, T_TOK, 5632, DM, EpiFfnIn{p.Pz, p.Pz + (size_t)T_TOK * DFF}, p.wq); }
    { LP(); const int g_ = (int)gridDim.x, b0_ = (g_ >= 64) ? 32 : 0;
      if ((int)blockIdx.x >= b0_) { ph_convert(p, layer, 16, tile, (int)blockIdx.x - b0_, g_ - b0_); if (layer < 3) ph_convert(p, layer + 1, 3, tile, (int)blockIdx.x - b0_, g_ - b0_);
                                    if (layer < 2) ph_ada_direct(p, layer + 2, layer + 3, shm, (int)blockIdx.x - b0_, g_ - b0_); } }
    GSYNC();
    { LP(); ph_ffn_glu(p, layer, shm); }
    GSYNC();
    if constexpr (layer < 3) { LP(); gemm_phase_residnorm192<false>(lds, p.H, p.Wfo, DFF, p.out, p.mod + (size_t)layer * 3 * 6144 + 5120, p.adap, p.bar + XCD_BAR_WORDS + (layer * 2 + 1) * 4096,
                                             p.norm_mix_w + (layer + 1) * DM, p.mod + (size_t)(layer + 1) * 3 * 6144, 0, 1024, ((layer + 1) % 3 == 1) ? p.Pxbc + (size_t)T_TOK * 2048 : p.A, p.wq); }
    else { LP(); gemm_phase_residnorm192<true>(lds, p.H, p.Wfo, DFF, p.out, p.mod + (size_t)layer * 3 * 6144 + 5120, p.adap, p.bar + XCD_BAR_WORDS + (layer * 2 + 1) * 4096,
                                             p.final_norm_w, nullptr, 0, 0, nullptr, p.wq); }
    if constexpr (layer < 3) GSYNC();
    }
  {
    constexpr int layer = 1; constexpr int kind = layer % 3, j = layer / 3;
    if constexpr (layer == 0) { { LP(); ph_norm_mod<true>(p, p.norm_mix_w + layer * DM, p.mod + (size_t)layer * 3 * 6144, 0, 1024, p.H); }
      GSYNC(); }
    if constexpr (kind == 0) {
      { LP(); gemm_phase8(lds, layer == 0 ? p.H : p.A, p.Win, T_TOK, 6400, DM, EpiSsmIn{p.Pz, p.Pxbc, p.small}, p.wq); }
      if constexpr (layer == 0) { LP(); const int g_ = (int)gridDim.x, b0_ = (g_ >= 192) ? 176 : 0; if ((int)blockIdx.x >= b0_) { ph_convert(p, 0, 2, tile, (int)blockIdx.x - b0_, g_ - b0_); ph_ada_direct(p, 1, 2, shm, (int)blockIdx.x - b0_, g_ - b0_); } }
      GSYNC();
      { LP(); ph_ssm_tiles(p, j, shm); }
      GSYNC();
      { LP(); ph_ssm_chain(p, j, lds); }
      { LP(); if ((int)blockIdx.x >= 128) ph_convert(p, layer, 8, tile, (int)blockIdx.x - 128, (int)gridDim.x - 128); }
      GSYNC();
      { LP(); ph_ssm_post(p, j); }
      GSYNC();
      { LP(); gemm_phase_residnorm192<false>(lds, p.H, p.Wout, 2048, p.out, p.mod + (size_t)layer * 3 * 6144 + 2048, p.adap, p.bar + XCD_BAR_WORDS + (layer * 2) * 4096,
                                             p.norm_ffn_w + layer * DM, p.mod + (size_t)layer * 3 * 6144, 3072, 4096, p.A, p.wq); }
    } else if constexpr (kind == 1) {
      { LP(); gemm_phase8(lds, p.Pxbc + (size_t)T_TOK * 2048, p.Win, T_TOK, 4096, DM, EpiGlaIn{p.A, p.Pz, (float*)p.Pxbc, p.gla_gate_b}, p.wq); }
      GSYNC();
      { LP(); ph_gla_tiles(p, shm); }
      GSYNC();
      { LP(); ph_gla_chain(p, lds); }
      { LP(); if ((int)blockIdx.x >= 64) ph_convert(p, layer, 8, tile, (int)blockIdx.x - 64, (int)gridDim.x - 64); }
      GSYNC();
      { LP(); ph_headnorm_post(p, p.Pxbc + (size_t)T_TOK * 2048, 4, p.gla_norm_w, p.Pz); }
      GSYNC();
      { LP(); gemm_phase_residnorm192<false>(lds, p.H, p.Wout, 1024, p.out, p.mod + (size_t)layer * 3 * 6144 + 2048, p.adap, p.bar + XCD_BAR_WORDS + (layer * 2) * 4096,
                                             p.norm_ffn_w + layer * DM, p.mod + (size_t)layer * 3 * 6144, 3072, 4096, p.A, p.wq); }
    } else {
      { LP(); gemm_phase8(lds, p.A, p.Win, T_TOK, 6400, DM, EpiGdnIn{p.Pz, p.Pxbc, p.small}, p.wq); }
      GSYNC();
      { LP(); ph_gdn_tiles(p, shm); }
      GSYNC();
      { LP(); ph_gdn_chain(p, lds); }
      { LP(); if ((int)blockIdx.x >= 64) ph_convert(p, layer, 8, tile, (int)blockIdx.x - 64, (int)gridDim.x - 64); }
      GSYNC();
      { LP(); ph_headnorm_post(p, p.Pxbc, 8, p.gdn_norm_w, p.Pz); }
      GSYNC();
      { LP(); gemm_phase_residnorm192<false>(lds, p.H, p.Wout, 2048, p.out, p.mod + (size_t)layer * 3 * 6144 + 2048, p.adap, p.bar + XCD_BAR_WORDS + (layer * 2) * 4096,
                                             p.norm_ffn_w + layer * DM, p.mod + (size_t)layer * 3 * 6144, 3072, 4096, p.A, p.wq); }
    }
    GSYNC();
    { LP(); gemm_phase8(lds, p.A, p.Wfi, T_TOK, 5632, DM, EpiFfnIn{p.Pz, p.Pz + (size_t)T_TOK * DFF}, p.wq); }
    { LP(); const int g_ = (int)gridDim.x, b0_ = (g_ >= 64) ? 32 : 0;
      if ((int)blockIdx.x >= b0_) { ph_convert(p, layer, 16, tile, (int)blockIdx.x - b0_, g_ - b0_); if (layer < 3) ph_convert(p, layer + 1, 3, tile, (int)blockIdx.x - b0_, g_ - b0_);
                                    if (layer < 2) ph_ada_direct(p, layer + 2, layer + 3, shm, (int)blockIdx.x - b0_, g_ - b0_); } }
    GSYNC();
    { LP(); ph_ffn_glu(p, layer, shm); }
    GSYNC();
    if constexpr (layer < 3) { LP(); gemm_phase_residnorm192<false>(lds, p.H, p.Wfo, DFF, p.out, p.mod + (size_t)layer * 3 * 6144 + 5120, p.adap, p.bar + XCD_BAR_WORDS + (layer * 2 + 1) * 4096,
                                             p.norm_mix_w + (layer + 1) * DM, p.mod + (size_t)(layer + 1) * 3 * 6144, 0, 1024, ((layer + 1) % 3 == 1) ? p.Pxbc + (size_t)T_TOK * 2048 : p.A, p.wq); }
    else { LP(); gemm_phase_residnorm192<true>(lds, p.H, p.Wfo, DFF, p.out, p.mod + (size_t)layer * 3 * 6144 + 5120, p.adap, p.bar + XCD_BAR_WORDS + (layer * 2 + 1) * 4096,
                                             p.final_norm_w, nullptr, 0, 0, nullptr, p.wq); }
    if constexpr (layer < 3) GSYNC();
    }
  {
    constexpr int layer = 2; constexpr int kind = layer % 3, j = layer / 3;
    if constexpr (layer == 0) { { LP(); ph_norm_mod<true>(p, p.norm_mix_w + layer * DM, p.mod + (size_t)layer * 3 * 6144, 0, 1024, p.H); }
      GSYNC(); }
    if constexpr (kind == 0) {
      { LP(); gemm_phase8(lds, layer == 0 ? p.H : p.A, p.Win, T_TOK, 6400, DM, EpiSsmIn{p.Pz, p.Pxbc, p.small}, p.wq); }
      if constexpr (layer == 0) { LP(); const int g_ = (int)gridDim.x, b0_ = (g_ >= 192) ? 176 : 0; if ((int)blockIdx.x >= b0_) { ph_convert(p, 0, 2, tile, (int)blockIdx.x - b0_, g_ - b0_); ph_ada_direct(p, 1, 2, shm, (int)blockIdx.x - b0_, g_ - b0_); } }
      GSYNC();
      { LP(); ph_ssm_tiles(p, j, shm); }
      GSYNC();
      { LP(); ph_ssm_chain(p, j, lds); }
      { LP(); if ((int)blockIdx.x >= 128) ph_convert(p, layer, 8, tile, (int)blockIdx.x - 128, (int)gridDim.x - 128); }
      GSYNC();
      { LP(); ph_ssm_post(p, j); }
      GSYNC();
      { LP(); gemm_phase_residnorm192<false>(lds, p.H, p.Wout, 2048, p.out, p.mod + (size_t)layer * 3 * 6144 + 2048, p.adap, p.bar + XCD_BAR_WORDS + (layer * 2) * 4096,
                                             p.norm_ffn_w + layer * DM, p.mod + (size_t)layer * 3 * 6144, 3072, 4096, p.A, p.wq); }
    } else if constexpr (kind == 1) {
      { LP(); gemm_phase8(lds, p.Pxbc + (size_t)T_TOK * 2048, p.Win, T_TOK, 4096, DM, EpiGlaIn{p.A, p.Pz, (float*)p.Pxbc, p.gla_gate_b}, p.wq); }
      GSYNC();
      { LP(); ph_gla_tiles(p, shm); }
      GSYNC();
      { LP(); ph_gla_chain(p, lds); }
      { LP(); if ((int)blockIdx.x >= 64) ph_convert(p, layer, 8, tile, (int)blockIdx.x - 64, (int)gridDim.x - 64); }
      GSYNC();
      { LP(); ph_headnorm_post(p, p.Pxbc + (size_t)T_TOK * 2048, 4, p.gla_norm_w, p.Pz); }
      GSYNC();
      { LP(); gemm_phase_residnorm192<false>(lds, p.H, p.Wout, 1024, p.out, p.mod + (size_t)layer * 3 * 6144 + 2048, p.adap, p.bar + XCD_BAR_WORDS + (layer * 2) * 4096,
                                             p.norm_ffn_w + layer * DM, p.mod + (size_t)layer * 3 * 6144, 3072, 4096, p.A, p.wq); }
    } else {
      { LP(); gemm_phase8(lds, p.A, p.Win, T_TOK, 6400, DM, EpiGdnIn{p.Pz, p.Pxbc, p.small}, p.wq); }
      GSYNC();
      { LP(); ph_gdn_tiles(p, shm); }
      GSYNC();
      { LP(); ph_gdn_chain(p, lds); }
      { LP(); if ((int)blockIdx.x >= 64) ph_convert(p, layer, 8, tile, (int)blockIdx.x - 64, (int)gridDim.x - 64); }
      GSYNC();
      { LP(); ph_headnorm_post(p, p.Pxbc, 8, p.gdn_norm_w, p.Pz); }
      GSYNC();
      { LP(); gemm_phase_residnorm192<false>(lds, p.H, p.Wout, 2048, p.out, p.mod + (size_t)layer * 3 * 6144 + 2048, p.adap, p.bar + XCD_BAR_WORDS + (layer * 2) * 4096,
                                             p.norm_ffn_w + layer * DM, p.mod + (size_t)layer * 3 * 6144, 3072, 4096, p.A, p.wq); }
    }
    GSYNC();
    { LP(); gemm_phase8(lds, p.A, p.Wfi, T_TOK, 5632, DM, EpiFfnIn{p.Pz, p.Pz + (size_t)T_TOK * DFF}, p.wq); }
    { LP(); const int g_ = (int)gridDim.x, b0_ = (g_ >= 64) ? 32 : 0;
      if ((int)blockIdx.x >= b0_) { ph_convert(p, layer, 16, tile, (int)blockIdx.x - b0_, g_ - b0_); if (layer < 3) ph_convert(p, layer + 1, 3, tile, (int)blockIdx.x - b0_, g_ - b0_);
                                    if (layer < 2) ph_ada_direct(p, layer + 2, layer + 3, shm, (int)blockIdx.x - b0_, g_ - b0_); } }
    GSYNC();
    { LP(); ph_ffn_glu(p, layer, shm); }
    GSYNC();
    if constexpr (layer < 3) { LP(); gemm_phase_residnorm192<false>(lds, p.H, p.Wfo, DFF, p.out, p.mod + (size_t)layer * 3 * 6144 + 5120, p.adap, p.bar + XCD_BAR_WORDS + (layer * 2 + 1) * 4096,
                                             p.norm_mix_w + (layer + 1) * DM, p.mod + (size_t)(layer + 1) * 3 * 6144, 0, 1024, ((layer + 1) % 3 == 1) ? p.Pxbc + (size_t)T_TOK * 2048 : p.A, p.wq); }
    else { LP(); gemm_phase_residnorm192<true>(lds, p.H, p.Wfo, DFF, p.out, p.mod + (size_t)layer * 3 * 6144 + 5120, p.adap, p.bar + XCD_BAR_WORDS + (layer * 2 + 1) * 4096,
                                             p.final_norm_w, nullptr, 0, 0, nullptr, p.wq); }
    if constexpr (layer < 3) GSYNC();
    }
  {
    constexpr int layer = 3; constexpr int kind = layer % 3, j = layer / 3;
    if constexpr (layer == 0) { { LP(); ph_norm_mod<true>(p, p.norm_mix_w + layer * DM, p.mod + (size_t)layer * 3 * 6144, 0, 1024, p.H); }
      GSYNC(); }
    if constexpr (kind == 0) {
      { LP(); gemm_phase8(lds, layer == 0 ? p.H : p.A, p.Win, T_TOK, 6400, DM, EpiSsmIn{p.Pz, p.Pxbc, p.small}, p.wq); }
      if constexpr (layer == 0) { LP(); const int g_ = (int)gridDim.x, b0_ = (g_ >= 192) ? 176 : 0; if ((int)blockIdx.x >= b0_) { ph_convert(p, 0, 2, tile, (int)blockIdx.x - b0_, g_ - b0_); ph_ada_direct(p, 1, 2, shm, (int)blockIdx.x - b0_, g_ - b0_); } }
      GSYNC();
      { LP(); ph_ssm_tiles(p, j, shm); }
      GSYNC();
      { LP(); ph_ssm_chain(p, j, lds); }
      { LP(); if ((int)blockIdx.x >= 128) ph_convert(p, layer, 8, tile, (int)blockIdx.x - 128, (int)gridDim.x - 128); }
      GSYNC();
      { LP(); ph_ssm_post(p, j); }
      GSYNC();
      { LP(); gemm_phase_residnorm192<false>(lds, p.H, p.Wout, 2048, p.out, p.mod + (size_t)layer * 3 * 6144 + 2048, p.adap, p.bar + XCD_BAR_WORDS + (layer * 2) * 4096,
                                             p.norm_ffn_w + layer * DM, p.mod + (size_t)layer * 3 * 6144, 3072, 4096, p.A, p.wq); }
    } else if constexpr (kind == 1) {
      { LP(); gemm_phase8(lds, p.Pxbc + (size_t)T_TOK * 2048, p.Win, T_TOK, 4096, DM, EpiGlaIn{p.A, p.Pz, (float*)p.Pxbc, p.gla_gate_b}, p.wq); }
      GSYNC();
      { LP(); ph_gla_tiles(p, shm); }
      GSYNC();
      { LP(); ph_gla_chain(p, lds); }
      { LP(); if ((int)blockIdx.x >= 64) ph_convert(p, layer, 8, tile, (int)blockIdx.x - 64, (int)gridDim.x - 64); }
      GSYNC();
      { LP(); ph_headnorm_post(p, p.Pxbc + (size_t)T_TOK * 2048, 4, p.gla_norm_w, p.Pz); }
      GSYNC();
      { LP(); gemm_phase_residnorm192<false>(lds, p.H, p.Wout, 1024, p.out, p.mod + (size_t)layer * 3 * 6144 + 2048, p.adap, p.bar + XCD_BAR_WORDS + (layer * 2) * 4096,
                                             p.norm_ffn_w + layer * DM, p.mod + (size_t)layer * 3 * 6144, 3072, 4096, p.A, p.wq); }
    } else {
      { LP(); gemm_phase8(lds, p.A, p.Win, T_TOK, 6400, DM, EpiGdnIn{p.Pz, p.Pxbc, p.small}, p.wq); }
      GSYNC();
      { LP(); ph_gdn_tiles(p, shm); }
      GSYNC();
      { LP(); ph_gdn_chain(p, lds); }
      { LP(); if ((int)blockIdx.x >= 64) ph_convert(p, layer, 8, tile, (int)blockIdx.x - 64, (int)gridDim.x - 64); }
      GSYNC();
      { LP(); ph_headnorm_post(p, p.Pxbc, 8, p.gdn_norm_w, p.Pz); }
      GSYNC();
      { LP(); gemm_phase_residnorm192<false>(lds, p.H, p.Wout, 2048, p.out, p.mod + (size_t)layer * 3 * 6144 + 2048, p.adap, p.bar + XCD_BAR_WORDS + (layer * 2) * 4096,
                                             p.norm_ffn_w + layer * DM, p.mod + (size_t)layer * 3 * 6144, 3072, 4096, p.A, p.wq); }
    }
    GSYNC();
    { LP(); gemm_phase8(lds, p.A, p.Wfi, T_TOK, 5632, DM, EpiFfnIn{p.Pz, p.Pz + (size_t)T_TOK * DFF}, p.wq); }
    { LP(); const int g_ = (int)gridDim.x, b0_ = (g_ >= 64) ? 32 : 0;
      if ((int)blockIdx.x >= b0_) { ph_convert(p, layer, 16, tile, (int)blockIdx.x - b0_, g_ - b0_); if (layer < 3) ph_convert(p, layer + 1, 3, tile, (int)blockIdx.x - b0_, g_ - b0_);
                                    if (layer < 2) ph_ada_direct(p, layer + 2, layer + 3, shm, (int)blockIdx.x - b0_, g_ - b0_); } }
    GSYNC();
    { LP(); ph_ffn_glu(p, layer, shm); }
    GSYNC();
    if constexpr (layer < 3) { LP(); gemm_phase_residnorm192<false>(lds, p.H, p.Wfo, DFF, p.out, p.mod + (size_t)layer * 3 * 6144 + 5120, p.adap, p.bar + XCD_BAR_WORDS + (layer * 2 + 1) * 4096,
                                             p.norm_mix_w + (layer + 1) * DM, p.mod + (size_t)(layer + 1) * 3 * 6144, 0, 1024, ((layer + 1) % 3 == 1) ? p.Pxbc + (size_t)T_TOK * 2048 : p.A, p.wq); }
    else { LP(); gemm_phase_residnorm192<true>(lds, p.H, p.Wfo, DFF, p.out, p.mod + (size_t)layer * 3 * 6144 + 5120, p.adap, p.bar + XCD_BAR_WORDS + (layer * 2 + 1) * 4096,
                                             p.final_norm_w, nullptr, 0, 0, nullptr, p.wq); }
    if constexpr (layer < 3) GSYNC();
    }

}

extern "C" void kernel_launch(void* const* d_in, const int* in_sizes, int n_in, void* d_out, int out_size, void* d_ws, size_t ws_size, hipStream_t stream) {
  P p{};
  const float** pp = (const float**)&p;
  for (int i = 0; i < 36; ++i) pp[i] = (const float*)d_in[i];
  p.out = (float*)d_out;
  char* w = (char*)d_ws; size_t off = 0;
  auto take = [&](size_t bytes) { char* r = w + off; off += (bytes + 255) & ~(size_t)255; return r; };
  p.Win = (bf16_t*)take((size_t)6400 * 1024 * 2);
  p.Wout = (bf16_t*)take((size_t)1024 * 2048 * 2);
  p.Wfi = (bf16_t*)take((size_t)5632 * 1024 * 2);
  p.Wfo = (bf16_t*)take((size_t)1024 * 2816 * 2);
  p.H = (bf16_t*)take((size_t)T_TOK * 2816 * 2);
  p.Pz = (bf16_t*)take((size_t)T_TOK * 2048 * 2);
  p.Pxbc = (bf16_t*)take((size_t)T_TOK * 4096 * 2);
  p.A = (bf16_t*)take((size_t)T_TOK * 4096 * 2);
  p.small = (float*)take((size_t)T_TOK * 64 * 4);
  p.small2 = (float*)take((size_t)T_TOK * 128 * 4);
  p.adap = (float*)take((size_t)16 * 4 * 3 * 6144 * 4);
  p.mod = (float*)take((size_t)4 * 3 * 6144 * 4);
  p.XT = p.H; p.Gm = p.H + (size_t)192 * 32 * 4096;
  p.BT = (bf16_t*)take((size_t)192 * 8 * 8192 * 2);
  p.VEC = (float*)take((size_t)192 * 64 * 192 * 4);
  p.bar = (unsigned*)take((size_t)(XCD_BAR_WORDS + 8 * 4096) * 4);
  if (off > ws_size) { fprintf(stderr, "workspace too small: need %zu have %zu\n", off, ws_size); return; }
  static int grid_blocks = 0;
  if (!grid_blocks) {
    int dev = 0, cus = 0, per_cu = 0;
    (void)hipGetDevice(&dev);
    (void)hipDeviceGetAttribute(&cus, hipDeviceAttributeMultiprocessorCount, dev);
    if (hipFuncSetAttribute((const void*)fwd_megakernel, hipFuncAttributeMaxDynamicSharedMemorySize, LDS_BYTES) != hipSuccess) { fprintf(stderr, "hipFuncSetAttribute failed\n"); return; }
    (void)hipOccupancyMaxActiveBlocksPerMultiprocessor(&per_cu, fwd_megakernel, NT, LDS_BYTES);
    if (per_cu < 1) { fprintf(stderr, "occupancy query returned %d\n", per_cu); return; }
    grid_blocks = cus;
  }
  if (hipMemsetAsync(p.bar, 0, (size_t)(XCD_BAR_WORDS + 8 * 4096) * 4, stream) != hipSuccess) { fprintf(stderr, "memset failed\n"); return; }
  void* args[] = {&p};
  hipError_t e = hipLaunchCooperativeKernel((void*)fwd_megakernel, dim3(grid_blocks), dim3(NT), args, LDS_BYTES, stream);
  if (e != hipSuccess) fprintf(stderr, "cooperative launch failed: %s (grid %d)\n", hipGetErrorString(e), grid_blocks);
}
```
